# Optimizing an MI355X kernel written in HIP

```python
import math
import jax, jax.numpy as jnp
from jax import lax
import numpy as np

D_MODEL = 2048
BATCH = 8
SEQ = 2048
DEPTH = 4

GRID_W = 64
CTX_LEN = 256
N_MIXERS = 2
N_FOURIER_LAYERS = (DEPTH + 1) // 2
N_SSD_LAYERS = DEPTH // 2
FOURIER_GROUPS = 8
SSD_EXPAND = 2
SSD_D_INNER = SSD_EXPAND * D_MODEL
SSD_HEAD_DIM = 64
SSD_HEADS = SSD_D_INNER // SSD_HEAD_DIM
SSD_GROUPS = 8
SSD_STATE = 128
SSD_CONV = 3
SSD_CHUNK = 128
SSD_GN = SSD_GROUPS * SSD_STATE
SSD_STATE_COLS = SSD_D_INNER + SSD_GN + 2 * SSD_HEADS
SSD_IN_DIM = SSD_STATE_COLS + SSD_GN + SSD_D_INNER
SSD_CONV_DIM = SSD_D_INNER + 2 * SSD_GN
D_FF = 5632
FFN_CONV = 3
EPS = 1e-6
MOD_SCALE = 0.5
DT_MIN = 1e-3
DT_MAX = 1e-1
A_MIN = 1.0
A_MAX = 16.0

kernel_name = "hybrid_fourier_ssd_dit_trunk"


def rmsnorm(x, g):
    xf = x.astype(jnp.float32)
    y = xf * lax.rsqrt(jnp.mean(xf * xf, axis=-1, keepdims=True) + EPS)
    return (y * g.astype(jnp.float32)).astype(x.dtype)


def modulate(h, shift, scale):
    return h * (1 + scale) + shift


def dwconv1d(u, w, b):
    K = w.shape[0]
    pad = K // 2
    L = u.shape[1]
    up = jnp.pad(u, ((0, 0), (pad, pad), (0, 0)))
    out = up[:, 0:L] * w[0]
    for k in range(1, K):
        out = out + up[:, k:k + L] * w[k]
    return out + b


def dwconv2d_grid(u, w, b):
    Bsz, L, C = u.shape
    rows = L // GRID_W
    kh, kw = w.shape[0], w.shape[1]
    g = jnp.pad(u.reshape(Bsz, rows, GRID_W, C), ((0, 0), (kh // 2, kh // 2), (kw // 2, kw // 2), (0, 0)))
    out = b
    for i in range(kh):
        for j in range(kw):
            out = out + g[:, i:i + rows, j:j + GRID_W] * w[i, j]
    return out.reshape(Bsz, L, C)


def fourier_mix(h, w):
    Bsz, L, D = h.shape
    hg = h.astype(jnp.float32).reshape(Bsz, L, FOURIER_GROUPS, D // FOURIER_GROUPS)
    f = jnp.fft.fft2(hg, axes=(1, 3), norm="ortho").real
    return f.reshape(Bsz, L, D).astype(h.dtype) @ w


def conv_ffn(h, w_up, w_down, conv_fn):
    gate, val = jnp.split(h @ w_up, 2, axis=-1)
    return (jax.nn.silu(conv_fn(gate)) * val) @ w_down


def ssd_chunked(xs, dt, a, bm, cm, h0, with_output):
    f32 = jnp.float32
    Bsz, L, H, P = xs.shape
    G, N = bm.shape[-2], bm.shape[-1]
    R = H // G
    nc = L // SSD_CHUNK
    dtc = dt.astype(f32).reshape(Bsz, nc, SSD_CHUNK, G, R)
    xdt = xs.astype(f32).reshape(Bsz, nc, SSD_CHUNK, G, R, P) * dtc[..., None]
    acs = jnp.cumsum(dtc * a.astype(f32).reshape(G, R), axis=2)
    bmc = bm.astype(f32).reshape(Bsz, nc, SSD_CHUNK, G, N)
    decay_to_end = jnp.exp(acs[:, :, -1:] - acs)
    states = jnp.einsum('bcsgn,bcsgr,bcsgrp->bcgrpn', bmc, decay_to_end, xdt)

    def step(h, inp):
        s, d = inp
        return h * jnp.exp(d)[..., None, None] + s, h

    h_init = h0.astype(f32).reshape(Bsz, G, R, P, N)
    final, h_in = lax.scan(step, h_init, (jnp.moveaxis(states, 1, 0), jnp.moveaxis(acs[:, :, -1], 1, 0)))
    final = final.reshape(Bsz, H, P, N)
    if not with_output:
        return None, final
    h_in = jnp.moveaxis(h_in, 0, 1)
    cmc = cm.astype(f32).reshape(Bsz, nc, SSD_CHUNK, G, N)
    acs_t = jnp.moveaxis(acs, 2, -1)
    seg = acs_t[..., :, None] - acs_t[..., None, :]
    lower = jnp.tril(jnp.ones((SSD_CHUNK, SSD_CHUNK), dtype=bool))
    decay = jnp.exp(jnp.where(lower, seg, -jnp.inf))
    scores = jnp.einsum('bclgn,bcsgn->bcgls', cmc, bmc)
    y_diag = jnp.einsum('bcgls,bcgrls,bcsgrp->bclgrp', scores, decay, xdt)
    y_off = jnp.einsum('bclgn,bcgrpn,bclgr->bclgrp', cmc, h_in, jnp.exp(acs))
    return (y_diag + y_off).reshape(Bsz, L, H, P), final


def ssd_branch_inputs(h, w_in, conv_w, conv_b, full):
    Bsz, L, _ = h.shape
    xb_dim = SSD_D_INNER + SSD_GN
    p = h @ (w_in if full else w_in[:, :SSD_STATE_COLS])
    xb = jax.nn.silu(dwconv1d(p[..., :xb_dim], conv_w[:, :xb_dim], conv_b[:xb_dim]))
    xs = xb[..., :SSD_D_INNER].reshape(Bsz, L, SSD_HEADS, SSD_HEAD_DIM)
    bm = xb[..., SSD_D_INNER:].reshape(Bsz, L, SSD_GROUPS, SSD_STATE)
    dt_raw = p[..., xb_dim:SSD_STATE_COLS].reshape(Bsz, L, 2, SSD_HEADS)
    if not full:
        return xs, bm, dt_raw, None, None
    cpre = p[..., SSD_STATE_COLS:SSD_STATE_COLS + SSD_GN]
    cm = jax.nn.silu(dwconv1d(cpre, conv_w[:, xb_dim:], conv_b[xb_dim:])).reshape(Bsz, L, SSD_GROUPS, SSD_STATE)
    z = p[..., SSD_STATE_COLS + SSD_GN:]
    return xs, bm, dt_raw, cm, z


def bidir_ssd(xs, bm, cm, dt_raw, dt_bias, a_log, d_skip, h0_fwd, h0_bwd, with_output):
    f32 = jnp.float32
    dt = jax.nn.softplus(dt_raw.astype(f32) + dt_bias.astype(f32))
    a = -jnp.exp(a_log.astype(f32))

    def rev(t):
        return None if t is None else jnp.flip(t, axis=1)

    y_f, h_f = ssd_chunked(xs, dt[:, :, 0], a[0], bm, cm, h0_fwd, with_output)
    y_b, h_b = ssd_chunked(rev(xs), rev(dt[:, :, 1]), a[1], rev(bm), rev(cm), h0_bwd, with_output)
    if not with_output:
        return None, h_f, h_b
    skip = (d_skip[0] + d_skip[1]).astype(f32)[:, None] * xs.astype(f32)
    return y_f + rev(y_b) + skip, h_f, h_b


def ssd_gated_out(y, z, norm_g, w_out):
    Bsz, L = y.shape[0], y.shape[1]
    g = y.reshape(Bsz, L, SSD_GROUPS, SSD_D_INNER // SSD_GROUPS) * jax.nn.silu(
        z.astype(jnp.float32)).reshape(Bsz, L, SSD_GROUPS, SSD_D_INNER // SSD_GROUPS)
    g = g * lax.rsqrt(jnp.mean(g * g, axis=-1, keepdims=True) + EPS)
    g = g.reshape(Bsz, L, SSD_D_INNER) * norm_g.astype(jnp.float32)
    return g.astype(z.dtype) @ w_out


def ssd_mixer(a_lat, a_ctx, w_in, conv_w, conv_b, dt_bias, a_log, d_skip, norm_g, w_out, ctx_out):
    Bsz = a_lat.shape[0]
    zeros = jnp.zeros((Bsz, SSD_HEADS, SSD_HEAD_DIM, SSD_STATE), jnp.float32)
    cx, cb, cdt, cc, cz = ssd_branch_inputs(a_ctx, w_in, conv_w, conv_b, ctx_out)
    y_ctx, h_f, h_b = bidir_ssd(cx, cb, cc, cdt, dt_bias, a_log, d_skip, zeros, zeros, ctx_out)
    lx, lb, ldt, lc, lz = ssd_branch_inputs(a_lat, w_in, conv_w, conv_b, True)
    y_lat, _, _ = bidir_ssd(lx, lb, lc, ldt, dt_bias, a_log, d_skip, h_f, h_b, True)
    out_lat = ssd_gated_out(y_lat, lz, norm_g, w_out)
    out_ctx = ssd_gated_out(y_ctx, cz, norm_g, w_out) if ctx_out else None
    return out_lat, out_ctx


def setup_inputs(seed: int = 0) -> dict:
    key = jax.random.key(seed)
    ks = jax.random.split(key, 24)
    f32 = jnp.float32
    n_a, n_b = N_FOURIER_LAYERS, N_SSD_LAYERS

    def dense(k, shape, fan_in, scale=1.0):
        return jax.random.normal(k, shape, f32) * (scale * fan_in ** -0.5)

    def gain(k, shape):
        return 1.0 + 0.05 * jax.random.normal(k, shape, f32)

    def small(k, shape):
        return 0.02 * jax.random.normal(k, shape, f32)

    dt = jnp.exp(jax.random.uniform(ks[13], (n_b, 2, SSD_HEADS), f32, math.log(DT_MIN), math.log(DT_MAX)))
    dt_bias = dt + jnp.log(-jnp.expm1(-dt))
    a_log = jnp.log(jax.random.uniform(ks[14], (n_b, 2, SSD_HEADS), f32, A_MIN, A_MAX))
    return {
        "x": jax.random.normal(ks[0], (BATCH, SEQ, D_MODEL), f32),
        "c": jax.random.normal(ks[1], (BATCH, D_MODEL), f32),
        "ctx": jax.random.normal(ks[2], (BATCH, CTX_LEN, D_MODEL), f32),
        "c_ctx": jax.random.normal(ks[3], (D_MODEL,), f32),
        "w_mod": dense(ks[4], (DEPTH, D_MODEL, 6 * D_MODEL), D_MODEL, MOD_SCALE),
        "b_mod": small(ks[5], (DEPTH, 6 * D_MODEL)),
        "norm_mix_g": gain(ks[6], (DEPTH, D_MODEL)),
        "norm_ffn_g": gain(ks[7], (DEPTH, D_MODEL)),
        "four_w": dense(ks[8], (n_a, D_MODEL, D_MODEL), D_MODEL),
        "ssd_w_in": dense(ks[9], (n_b, D_MODEL, SSD_IN_DIM), D_MODEL),
        "ssd_conv_w": dense(ks[10], (n_b, SSD_CONV, SSD_CONV_DIM), SSD_CONV),
        "ssd_conv_b": small(ks[11], (n_b, SSD_CONV_DIM)),
        "ssd_dt_bias": dt_bias,
        "ssd_a_log": a_log,
        "ssd_d": 1.0 + 0.1 * jax.random.normal(ks[12], (n_b, 2, SSD_HEADS), f32),
        "ssd_norm_g": gain(ks[15], (n_b, SSD_D_INNER)),
        "ssd_w_out": dense(ks[16], (n_b, SSD_D_INNER, D_MODEL), SSD_D_INNER),
        "ffn_w_up": dense(ks[17], (DEPTH, D_MODEL, 2 * D_FF), D_MODEL),
        "ffn_conv_w": dense(ks[18], (DEPTH, FFN_CONV, FFN_CONV, D_FF), FFN_CONV * FFN_CONV),
        "ffn_conv_b": small(ks[19], (DEPTH, D_FF)),
        "ffn_w_down": dense(ks[20], (DEPTH, D_FF, D_MODEL), D_FF),
        "final_g": gain(ks[21], (D_MODEL,)),
    }


def reference(x, c, ctx, c_ctx, w_mod, b_mod, norm_mix_g, norm_ffn_g, four_w, ssd_w_in, ssd_conv_w,
              ssd_conv_b, ssd_dt_bias, ssd_a_log, ssd_d, ssd_norm_g, ssd_w_out, ffn_w_up, ffn_conv_w,
              ffn_conv_b, ffn_w_down, final_g):
    s_lat = jax.nn.silu(c)
    s_ctx = jax.nn.silu(c_ctx)
    for i in range(DEPTH):
        last = i == DEPTH - 1
        is_ssd = (i % N_MIXERS) == 1
        j = i // N_MIXERS
        sh1, sc1, g1, sh2, sc2, g2 = jnp.split((s_lat @ w_mod[i] + b_mod[i])[:, None, :], 6, axis=-1)
        a_lat = modulate(rmsnorm(x, norm_mix_g[i]), sh1, sc1)
        if (not last) or is_ssd:
            n_cols = 2 * D_MODEL if last else 6 * D_MODEL
            m_ctx = jnp.split(s_ctx @ w_mod[i][:, :n_cols] + b_mod[i][:n_cols], n_cols // D_MODEL)
            a_ctx = modulate(rmsnorm(ctx, norm_mix_g[i]), m_ctx[0], m_ctx[1])
        if is_ssd:
            y_lat, y_ctx = ssd_mixer(a_lat, a_ctx, ssd_w_in[j], ssd_conv_w[j], ssd_conv_b[j], ssd_dt_bias[j],
                                     ssd_a_log[j], ssd_d[j], ssd_norm_g[j], ssd_w_out[j], not last)
        else:
            y_lat = fourier_mix(a_lat, four_w[j])
            y_ctx = None if last else fourier_mix(a_ctx, four_w[j])
        x = x + g1 * y_lat
        b_lat = modulate(rmsnorm(x, norm_ffn_g[i]), sh2, sc2)
        x = x + g2 * conv_ffn(b_lat, ffn_w_up[i], ffn_w_down[i],
                              lambda u: dwconv2d_grid(u, ffn_conv_w[i], ffn_conv_b[i]))
        if not last:
            ctx = ctx + m_ctx[2] * y_ctx
            b_ctx = modulate(rmsnorm(ctx, norm_ffn_g[i]), m_ctx[3], m_ctx[4])
            ctx = ctx + m_ctx[5] * conv_ffn(b_ctx, ffn_w_up[i], ffn_w_down[i],
                                            lambda u: dwconv1d(u, ffn_conv_w[i][FFN_CONV // 2], ffn_conv_b[i]))
    return rmsnorm(x, final_g)
```

```cpp
#include <hip/hip_runtime.h>
#include <cstdio>
#include <cstdint>

#define LAS __attribute__((address_space(3)))
#define GAS __attribute__((address_space(1)))
typedef unsigned short bf16_t;
typedef short bf16x8 __attribute__((ext_vector_type(8)));
typedef float f32x4 __attribute__((ext_vector_type(4)));
typedef float f32x2 __attribute__((ext_vector_type(2)));
typedef unsigned u32x4 __attribute__((ext_vector_type(4)));
typedef unsigned u32x2 __attribute__((ext_vector_type(2)));

#ifndef MK_N_LAUNCHES
#define MK_N_LAUNCHES 1
#endif

constexpr int D = 2048, NB = 8, LSEQ = 2048, LCTX = 256, DEPTH = 4;
constexpr int MLAT = NB * LSEQ, MCTX = NB * LCTX, MALL = MLAT + MCTX;
constexpr int DFF = 5632, DI = 4096, GNW = 1024, NH = 64, NS = 128;
constexpr int XBC = DI + 2 * GNW;
constexpr int INW = 10368, INP = 10496;
constexpr int MODW = 6 * D;
constexpr float EPS = 1e-6f;
constexpr float LOG2E = 1.4426950408889634f;

constexpr size_t MiB = 1u << 20;
constexpr size_t WS_CTL = 0, CTL_ZERO_BYTES = 1 * MiB;
constexpr size_t WS_MOD = 1 * MiB;
constexpr size_t WS_W1 = 3 * MiB;
constexpr size_t WS_W2C = 3 * MiB + 512 * 1024;
constexpr size_t WS_W2 = 4 * MiB;
constexpr size_t WS_WFOUR = 20 * MiB;
constexpr size_t WS_WIN = 36 * MiB;
constexpr size_t WS_WOUT = 118 * MiB;
constexpr size_t WS_WUP = 150 * MiB;
constexpr size_t WS_WDN = 326 * MiB;
constexpr size_t WS_XC = 414 * MiB;
constexpr size_t WS_A = 430 * MiB;
constexpr size_t WS_R = 502 * MiB;
constexpr size_t WS_MODP = WS_R;
constexpr size_t WS_GATE = WS_R, WS_VAL = WS_R + 198 * MiB;
constexpr size_t WS_PQT = WS_R, WS_PQTC = WS_R + 128 * MiB, WS_F = WS_R + 144 * MiB;
constexpr size_t WS_VT = WS_R + 216 * MiB;
constexpr size_t WS_XBCP = WS_R;
constexpr size_t WS_Z = WS_R + 216 * MiB;
constexpr size_t WS_DT = WS_R + 360 * MiB;
constexpr size_t WS_XST = WS_R + 369 * MiB;
constexpr size_t WS_BM = WS_R + 513 * MiB;
constexpr size_t WS_BMT = WS_R + 549 * MiB;
constexpr size_t WS_CM = WS_R + 585 * MiB;
constexpr size_t WS_YB = WS_R + 621 * MiB;
constexpr size_t WS_Y = WS_R + 621 * MiB;
constexpr size_t WS_PART = WS_R + 700 * MiB;
constexpr size_t WS_END = WS_R + 765 * MiB;
constexpr int CW_BAR = 4096;

constexpr int RING_BYTES = 131072;
constexpr int LDSCTL_OFF = RING_BYTES, MISC_OFF = LDSCTL_OFF + 320;
constexpr int LDS_BYTES = 147456;
constexpr int NWAVES = 8;

typedef __bf16 bf16x2_t __attribute__((ext_vector_type(2)));
__device__ __forceinline__ unsigned cvt_pk_bf16(float lo, float hi) { const f32x2 v = {lo, hi}; return __builtin_bit_cast(unsigned, __builtin_convertvector(v, bf16x2_t)); }
__device__ __forceinline__ float bf_lo(unsigned u) { return __uint_as_float(u << 16); }
__device__ __forceinline__ float bf_hi(unsigned u) { return __uint_as_float(u & 0xffff0000u); }
__device__ __forceinline__ float silu_f(float v) { return v / (1.0f + __expf(-v)); }
__device__ __forceinline__ float wave_sum(float v, int lane) {
#pragma unroll
    for (int o = 1; o < 64; o <<= 1) v += __builtin_bit_cast(float, __builtin_amdgcn_ds_bpermute((lane ^ o) << 2, __builtin_bit_cast(int, v)));
    return v;
}
__device__ __forceinline__ int fresh_lane() { int l; asm volatile("v_mbcnt_lo_u32_b32 %0, -1, 0\n\tv_mbcnt_hi_u32_b32 %0, -1, %0" : "=v"(l)); return l; }
#define LDS_WAIT() asm volatile("s_waitcnt lgkmcnt(0)" ::: "memory")
#define VM_WAIT() asm volatile("s_waitcnt vmcnt(0)" ::: "memory")

namespace pg8 {
constexpr int BM = 256, BK = 64, HALF = 128, HTB = HALF * BK * 2, STAGE_BYTES = 8 * HTB, NXCD = 8, WGM = 8;
__host__ __device__ __forceinline__ int lds_byte(int r, int c) { const int st = (r >> 4) * 2 + (c >> 5), rr = r & 15, cc = c & 31, ob = rr * 64 + cc * 2; return st * 1024 + (ob ^ (((ob >> 9) & 1) << 5)); }
__host__ __device__ __forceinline__ void stage_rc(int b, int& R, int& C) { const int st = b / 1024, sb = b % 1024, swz = sb ^ (((sb >> 9) & 1) << 5); R = (st >> 1) * 16 + swz / 64; C = (st & 1) * 32 + (swz % 64) / 2; }
__host__ __device__ __forceinline__ int perm32(int rho) { const int n = rho >> 4, i = rho & 15; return 8 * (i >> 2) + 4 * n + (i & 3); }

struct Unit { int pm, pn, kq; };

template <int NN> __device__ __forceinline__ void tile_of_id(int wgid, int nM, int& pm, int& pn) {
    const int nwg = nM * NN;
    { const int q = nwg / NXCD, r = nwg % NXCD, xcd = wgid % NXCD, off = wgid / NXCD; wgid = (xcd < r ? xcd * (q + 1) : r * (q + 1) + (xcd - r) * q) + off; }
    const int nig = WGM * NN, gid = wgid / nig, fm = gid * WGM, gsz = (nM - fm) < WGM ? (nM - fm) : WGM;
    pm = fm + ((wgid % nig) % gsz); pn = (wgid % nig) / gsz;
}
template <int NN> __device__ __forceinline__ bool tile2d(int i, int nM, Unit& u) {
    const long L = (long)i * (int)gridDim.x + (int)blockIdx.x; if (L >= nM * NN) return false;
    tile_of_id<NN>((int)L, nM, u.pm, u.pn); u.kq = -1; return true;
}

struct EpiTile {
    static constexpr bool PERM = true;
    template <class Sched> __device__ __forceinline__ void operator()(const f32x4 (&acc)[2][2][4][2], const Unit& u, const Sched& S, int wr, int wc, int fr, int fq) const {
        const int rl0 = wr * 64 + fr, cl0 = wc * 32 + 8 * fq;
        char* uo; int ldo, kind; S.out(u, uo, ldo, kind);
        asm volatile("" : "+s"(ldo));
        if (kind == 0) {
            bf16_t* base = (bf16_t*)uo;
#pragma unroll
            for (int ai = 0; ai < 2; ++ai)
#pragma unroll
                for (int m = 0; m < 4; ++m) { bf16_t* rowp = base + (size_t)(rl0 + ai * HALF + m * 16) * ldo + cl0;
#pragma unroll
                    for (int bj = 0; bj < 2; ++bj) { const f32x4 v0 = acc[ai][bj][m][0], v1 = acc[ai][bj][m][1];
                        u32x4 w; w.x = cvt_pk_bf16(v0[0], v0[1]); w.y = cvt_pk_bf16(v0[2], v0[3]); w.z = cvt_pk_bf16(v1[0], v1[1]); w.w = cvt_pk_bf16(v1[2], v1[3]);
                        *(u32x4*)(rowp + bj * HALF) = w; } }
        } else {
            float* base = (float*)uo;
#pragma unroll
            for (int ai = 0; ai < 2; ++ai)
#pragma unroll
                for (int m = 0; m < 4; ++m) { float* rowp = base + (size_t)(rl0 + ai * HALF + m * 16) * ldo + cl0;
                    *(f32x4*)(rowp) = acc[ai][0][m][0]; *(f32x4*)(rowp + 4) = acc[ai][0][m][1];
                    if (kind == 2) { *(f32x4*)(rowp + HALF) = acc[ai][1][m][0]; *(f32x4*)(rowp + HALF + 4) = acc[ai][1][m][1]; } }
        }
    }
};
template <class Epi, class Sched, bool ALIGN_EPI>
__device__ __forceinline__ void gemm_phase(LAS unsigned char* lds, const int wid, const int lda_, const int ldb_, const int K_, const Sched& S, const Epi& E) {
    int lda = lda_, ldb = ldb_; (void)K_; asm volatile("" : "+s"(lda), "+s"(ldb));
    const int lane = fresh_lane(), tid = wid * 64 + lane;
    const int wr = wid >> 2, wc = wid & 3, fr = lane & 15, fq = lane >> 4;
    unsigned voffA[2], voffB[2];
#pragma unroll
    for (int i = 0; i < 2; ++i) { int R, C; stage_rc(tid * 16 + i * 8192, R, C); const int Rb = Epi::PERM ? ((R & ~31) + perm32(R & 31)) : R;
        voffA[i] = (unsigned)(R * lda + C) * 2u; voffB[i] = (unsigned)(Rb * ldb + C) * 2u; }
    const size_t kstep = (size_t)(BK * 2);
    const size_t hstepA = (size_t)HALF * lda * 2, hstepB = (size_t)HALF * ldb * 2;
    const unsigned ldsw = (unsigned)wid * 1024u;
    const int aoff = lds_byte(wr * 64 + fr, fq * 8), boff = lds_byte(wc * 32 + fr, fq * 8);
#define PG8_SA(b, h) (((b) * 2 + (h)) * HTB)
#define PG8_SB(b, h) ((4 + (b) * 2 + (h)) * HTB)
#define PG8_STAGE(bufoff, gbase, voff) do { _Pragma("unroll") for (int _i = 0; _i < 2; ++_i) \
        __builtin_amdgcn_global_load_lds((const unsigned*)((const char*)(gbase) + (voff)[_i]), (LAS unsigned*)(lds + (bufoff) + ldsw + _i * 8192), 16, 0, 0); } while (0)
#define PG8_LDA(dst, b, h) do { _Pragma("unroll") for (int m = 0; m < 4; ++m) _Pragma("unroll") for (int k = 0; k < 2; ++k) dst[m][k] = *(const LAS bf16x8*)(lds + PG8_SA(b, h) + aoff + m * 2048 + k * 1024); } while (0)
#define PG8_LDB(dst, b, h) do { _Pragma("unroll") for (int n = 0; n < 2; ++n) _Pragma("unroll") for (int k = 0; k < 2; ++k) dst[n][k] = *(const LAS bf16x8*)(lds + PG8_SB(b, h) + boff + n * 2048 + k * 1024); } while (0)
#define PG8_MMA(ai, bj, At, Bt) do { __builtin_amdgcn_s_setprio(1); _Pragma("unroll") for (int m = 0; m < 4; ++m) _Pragma("unroll") for (int n = 0; n < 2; ++n) _Pragma("unroll") for (int k = 0; k < 2; ++k) \
        acc[ai][bj][m][n] = __builtin_amdgcn_mfma_f32_16x16x32_bf16(Bt[n][k], At[m][k], acc[ai][bj][m][n], 0, 0, 0); __builtin_amdgcn_s_setprio(0); } while (0)
#define PG8_WAIT_V(n) asm volatile("s_waitcnt vmcnt(" #n ")" ::: "memory")
#define PG8_WAIT_L(n) asm volatile("s_waitcnt lgkmcnt(" #n ")" ::: "memory")
#define PG8_BAR __builtin_amdgcn_s_barrier()
#define PG8_SCHED __builtin_amdgcn_sched_barrier(0)
    Unit cur, nxt; int ui = 0;
    if (!S.next(0, cur)) return;
    f32x4 acc[2][2][4][2];
#pragma unroll
    for (int a = 0; a < 2; ++a)
#pragma unroll
        for (int b = 0; b < 2; ++b)
#pragma unroll
            for (int m = 0; m < 4; ++m)
#pragma unroll
                for (int n = 0; n < 2; ++n) acc[a][b][m][n] = (f32x4){0.f, 0.f, 0.f, 0.f};
    bf16x8 At[4][2], B0[2][2], B1[2][2];
    const char* cA = S.a(cur); const char* cB = S.b(cur);
    PG8_STAGE(PG8_SB(0, 0), cB, voffB); PG8_STAGE(PG8_SB(0, 1), cB + hstepB, voffB); PG8_STAGE(PG8_SA(0, 0), cA, voffA); PG8_STAGE(PG8_SA(0, 1), cA + hstepA, voffA);
    if (wr == 1) PG8_BAR;
    PG8_WAIT_V(2); PG8_BAR;
    PG8_STAGE(PG8_SB(1, 0), cB + kstep, voffB); PG8_STAGE(PG8_SA(1, 0), cA + kstep, voffA); PG8_STAGE(PG8_SB(1, 1), cB + hstepB + kstep, voffB);
    PG8_WAIT_V(6); PG8_BAR;
    for (;;) {
        const bool has_next = S.next(ui + 1, nxt);
        const int nt = S.nt(cur);
        const char* nA = has_next ? S.a(nxt) : cA; const char* nB = has_next ? S.b(nxt) : cB;
#pragma unroll 1
        for (int t = 0; t < nt; t += 2) {
            const bool last = (t == nt - 2);
            const char* a1 = cA + (size_t)(t + 1) * kstep;
            const char* a2 = last ? nA : cA + (size_t)(t + 2) * kstep; const char* b2 = last ? nB : cB + (size_t)(t + 2) * kstep;
            const char* a3 = a2 + kstep; const char* b3 = b2 + kstep;
            PG8_LDB(B0, 0, 0); PG8_LDB(B1, 0, 1); PG8_SCHED; PG8_LDA(At, 0, 0); PG8_STAGE(PG8_SA(1, 1), a1 + hstepA, voffA);
            PG8_WAIT_V(8); PG8_WAIT_L(0); PG8_BAR; PG8_MMA(0, 0, At, B0); PG8_MMA(0, 1, At, B1); PG8_BAR; PG8_SCHED;
            PG8_LDA(At, 0, 1); PG8_STAGE(PG8_SB(0, 0), b2, voffB); PG8_STAGE(PG8_SB(0, 1), b2 + hstepB, voffB); PG8_STAGE(PG8_SA(0, 0), a2, voffA);
            PG8_WAIT_V(8); PG8_WAIT_L(0); PG8_BAR; PG8_MMA(1, 0, At, B0); PG8_MMA(1, 1, At, B1); PG8_BAR; PG8_SCHED;
            PG8_LDB(B0, 1, 0); PG8_LDB(B1, 1, 1); PG8_SCHED; PG8_LDA(At, 1, 0); PG8_STAGE(PG8_SA(0, 1), a2 + hstepA, voffA);
            PG8_WAIT_V(8); PG8_WAIT_L(0); PG8_BAR; PG8_MMA(0, 0, At, B0); PG8_MMA(0, 1, At, B1); PG8_BAR; PG8_SCHED;
            PG8_LDA(At, 1, 1); PG8_STAGE(PG8_SB(1, 0), b3, voffB); PG8_STAGE(PG8_SB(1, 1), b3 + hstepB, voffB); PG8_STAGE(PG8_SA(1, 0), a3, voffA);
            PG8_WAIT_V(8); PG8_WAIT_L(0); PG8_BAR; PG8_MMA(1, 0, At, B0); PG8_MMA(1, 1, At, B1); PG8_BAR; PG8_SCHED;
        }
        if constexpr (ALIGN_EPI) { if (wr == 0) PG8_BAR; }
        E(acc, cur, S, wr, wc, fr, fq);
        if (!has_next) break;
#pragma unroll
        for (int a = 0; a < 2; ++a)
#pragma unroll
            for (int b = 0; b < 2; ++b)
#pragma unroll
                for (int m = 0; m < 4; ++m)
#pragma unroll
                    for (int n = 0; n < 2; ++n) acc[a][b][m][n] = (f32x4){0.f, 0.f, 0.f, 0.f};
        cur = nxt; cA = nA; cB = nB; ++ui;
        if constexpr (ALIGN_EPI) { if (wr == 1) PG8_BAR; }
    }
    PG8_WAIT_V(0);
    if constexpr (!ALIGN_EPI) { if (wr == 0) PG8_BAR; }
    PG8_BAR;
#undef PG8_SA
#undef PG8_SB
#undef PG8_STAGE
#undef PG8_LDA
#undef PG8_LDB
#undef PG8_MMA
#undef PG8_WAIT_V
#undef PG8_WAIT_L
#undef PG8_BAR
#undef PG8_SCHED
}
}

#define XB_TMO      128
#define XB_XCNT(j)  (256  + 64 * (j))
#define XB_XSUB(j)  (1280 + 64 * (j))
#define XB_XGEN(j)  (2304 + 64 * (j))
#define XB_TOP      3328
#define XB_TOPGEN   3392
#define XCD_BAR_WORDS 3456
#define XB_SPIN_CAP (1u << 18)
__device__ __forceinline__ unsigned xb_ld(unsigned* p)              { return __hip_atomic_load(p, __ATOMIC_RELAXED, __HIP_MEMORY_SCOPE_AGENT); }
__device__ __forceinline__ unsigned xb_add(unsigned* p, unsigned v) { return __hip_atomic_fetch_add(p, v, __ATOMIC_RELAXED, __HIP_MEMORY_SCOPE_AGENT); }
__device__ __forceinline__ unsigned xb_xcc_id() { return (unsigned)__builtin_amdgcn_s_getreg((3 << 11) | 20) & 0xFu; }
#define XB_SPIN(cond, bar) do { unsigned _sp = 0; while (cond) { __builtin_amdgcn_s_sleep(1); \
    if ((++_sp & 255u) == 0u) { if (xb_ld(&(bar)[XB_TMO])) break; if (_sp > XB_SPIN_CAP) { atomicAdd(&(bar)[XB_TMO], 1u); break; } } } } while (0)
struct XcdBarrier { unsigned* bar; unsigned x; volatile LAS unsigned* st; };
__device__ __forceinline__ XcdBarrier xcd_barrier_post(unsigned* bar, volatile LAS unsigned* st) {
    XcdBarrier b; b.bar = bar; b.x = xb_xcc_id(); b.st = st;
    if (threadIdx.x == 0) (void)xb_add(&bar[XB_XCNT(b.x)], 1u);
    return b;
}
__device__ __forceinline__ void xcd_barrier_complete(unsigned* bar, unsigned x, unsigned& nloc, unsigned& nx) {
    const unsigned G = gridDim.x * gridDim.y * gridDim.z;
    unsigned sum, cnt, mine, sp = 0u;
    for (;;) {
        sum = 0u; cnt = 0u; mine = 0u;
#pragma unroll
        for (unsigned j = 0; j < 16; ++j) { const unsigned c = xb_ld(&bar[XB_XCNT(j)]); sum += c; cnt += (c > 0u) ? 1u : 0u; mine = (j == x) ? c : mine; }
        if (sum == G) break;
        __builtin_amdgcn_s_sleep(1);
        if ((++sp & 255u) == 0u) { if (xb_ld(&bar[XB_TMO])) break; if (sp > XB_SPIN_CAP) { atomicAdd(&bar[XB_TMO], 1u); break; } }
    }
    nloc = mine > 0u ? mine : 1u; nx = cnt > 0u ? cnt : 1u;
}
__device__ __forceinline__ void xcd_barrier(const XcdBarrier& b, const bool leader  ) {
    asm volatile("s_waitcnt vmcnt(0)" ::: "memory");
    __syncthreads();
    if (leader) {
        unsigned* bar = b.bar;
        __builtin_amdgcn_s_waitcnt(0);
        unsigned nloc = b.st[0], nx = b.st[1];
        if (nloc == 0u) { xcd_barrier_complete(bar, b.x, nloc, nx); b.st[0] = nloc; b.st[1] = nx; }
        const unsigned old = xb_add(&bar[XB_XSUB(b.x)], 1u);
        const unsigned gen = old / nloc;
        if (old + 1u == (gen + 1u) * nloc) {
            __builtin_amdgcn_fence(__ATOMIC_RELEASE, "agent");
            asm volatile("s_waitcnt vmcnt(0)" ::: "memory");
            const unsigned og = xb_add(&bar[XB_TOP], 1u);
            const unsigned tg = og / nx;
            if (og + 1u == (tg + 1u) * nx) xb_add(&bar[XB_TOPGEN], 1u);
            else XB_SPIN(xb_ld(&bar[XB_TOPGEN]) == tg, bar);
            __builtin_amdgcn_fence(__ATOMIC_ACQUIRE, "agent");
            xb_add(&bar[XB_XGEN(b.x)], 1u);
            asm volatile("s_waitcnt vmcnt(0)" ::: "memory");
        } else {
            XB_SPIN(xb_ld(&bar[XB_XGEN(b.x)]) == gen, bar);
            __builtin_amdgcn_fence(__ATOMIC_ACQUIRE, "agent");
            asm volatile("s_waitcnt vmcnt(0)" ::: "memory");
        }
    }
    __syncthreads();
}

struct Args { const float* in[22]; float* out; unsigned char* ws; int ph_lo, ph_hi; };
struct Frame {
    LAS unsigned char* lds;
    int tid, lane, wave, G;
    const float* const* in;
    float* out; unsigned char* ws;
};
enum { I_X = 0, I_C, I_CTX, I_CCTX, I_WMOD, I_BMOD, I_NMIX, I_NFFN, I_FOURW, I_WIN, I_CONVW, I_CONVB, I_DTB, I_ALOG, I_DSK, I_SNG, I_WOUT, I_WUP, I_FCW, I_FCB, I_WDN, I_FING };

__device__ __forceinline__ void fresh_ids(Frame& F) { F.lane = fresh_lane(); F.tid = F.wave * 64 + F.lane; }

template <int K_> struct SchedAB {
    unsigned char* ws; size_t aoff, boff; int has_ctx;
    static constexpr int KT = K_ / 64;
    __device__ __forceinline__ bool next(int i, pg8::Unit& u) const {
        const int L = i * (int)gridDim.x + (int)blockIdx.x;
        if (L < 512) { pg8::tile_of_id<8>(L, 64, u.pm, u.pn); u.kq = -1; return true; }
        if (!has_ctx || L >= 768) return false;
        const int c2 = L - 512, ct = c2 >> 2; u.kq = c2 & 3; u.pm = 64 + (ct >> 3); u.pn = ct & 7; return true; }
    __device__ __forceinline__ int nt(const pg8::Unit& u) const { return u.kq < 0 ? KT : KT / 4; }
    __device__ __forceinline__ void out(const pg8::Unit& u, char*& o, int& ldo, int& kind) const { ldo = D;
        if (u.kq < 0) { o = (char*)ws + WS_Y + ((size_t)u.pm * 256 * D + (size_t)u.pn * 256) * 2; kind = 0; }
        else { o = (char*)ws + WS_PART + (((size_t)u.kq * MCTX + (size_t)(u.pm - 64) * 256) * D + (size_t)u.pn * 256) * 4; kind = 2; } }
    __device__ __forceinline__ const char* a(const pg8::Unit& u) const { return (const char*)ws + aoff + (size_t)u.pm * 256 * K_ * 2 + (u.kq < 0 ? 0 : u.kq * (K_ / 4) * 2); }
    __device__ __forceinline__ const char* b(const pg8::Unit& u) const { return (const char*)ws + boff + (size_t)u.pn * 256 * K_ * 2 + (u.kq < 0 ? 0 : u.kq * (K_ / 4) * 2); }
};
struct SchedUp {
    unsigned char* ws; size_t boff; int nM;
    __device__ __forceinline__ int nt(const pg8::Unit&) const { return D / 64; }
    __device__ __forceinline__ bool next(int i, pg8::Unit& u) const { return pg8::tile2d<44>(i, nM, u); }
    __device__ __forceinline__ const char* a(const pg8::Unit& u) const { return (const char*)ws + WS_A + (size_t)u.pm * 256 * D * 2; }
    __device__ __forceinline__ const char* b(const pg8::Unit& u) const { return (const char*)ws + boff + (size_t)u.pn * 256 * D * 2; }
    __device__ __forceinline__ void out(const pg8::Unit& u, char*& o, int& ldo, int& kind) const {
        o = (char*)ws + (u.pn < 22 ? WS_GATE + (size_t)u.pn * 512 : WS_VAL + (size_t)(u.pn - 22) * 512) + (size_t)u.pm * 256 * DFF * 2; ldo = DFF; kind = 0; }
};
struct SchedIn {
    unsigned char* ws; size_t boff; int last;
    __device__ __forceinline__ int nt(const pg8::Unit&) const { return D / 64; }
    __device__ __forceinline__ bool next(int i, pg8::Unit& u) const {
        const int L = i * (int)gridDim.x + (int)blockIdx.x; u.kq = -1;
        if (L < 64 * 41) { pg8::tile_of_id<41>(L, 64, u.pm, u.pn); return true; }
        const int c2 = L - 64 * 41, nct = last ? 21 : 41; if (c2 >= 8 * nct) return false;
        u.pm = 64 + (c2 & 7); const int t = c2 >> 3; u.pn = (last && t >= 20) ? 40 : t; return true; }
    __device__ __forceinline__ const char* a(const pg8::Unit& u) const { return (const char*)ws + WS_A + (size_t)u.pm * 256 * D * 2; }
    __device__ __forceinline__ const char* b(const pg8::Unit& u) const { return (const char*)ws + boff + (size_t)u.pn * 256 * D * 2; }
    __device__ __forceinline__ void out(const pg8::Unit& u, char*& o, int& ldo, int& kind) const {
        if (u.pn < 24) { o = (char*)ws + WS_XBCP + ((size_t)u.pm * 256 * XBC + (size_t)u.pn * 256) * 2; ldo = XBC; kind = 0; }
        else if (u.pn < 40) { o = (char*)ws + WS_Z + ((size_t)u.pm * 256 * DI + (size_t)(u.pn - 24) * 256) * 2; ldo = DI; kind = 0; }
        else { o = (char*)ws + WS_DT + (size_t)u.pm * 256 * 128 * 4; ldo = 128; kind = 1; } }
};
struct SchedF1 {
    unsigned char* ws;
    __device__ __forceinline__ int nt(const pg8::Unit&) const { return 4; }
    __device__ __forceinline__ bool next(int i, pg8::Unit& u) const { return pg8::tile2d<72>(i, 16, u); }
    __device__ __forceinline__ const char* a(const pg8::Unit& u) const { return (const char*)ws + WS_W1 + (size_t)(u.pm & 1) * 256 * 256 * 2; }
    __device__ __forceinline__ const char* b(const pg8::Unit& u) const { return (const char*)ws + WS_A + ((size_t)u.pn * 256 * D + (size_t)(u.pm >> 1) * 256) * 2; }
    __device__ __forceinline__ void out(const pg8::Unit& u, char*& o, int& ldo, int& kind) const { const int g = u.pm >> 1, cs = u.pm & 1;
        if (u.pn < 64) { const int b = u.pn >> 3, p0 = (u.pn & 7) * 256; o = (char*)ws + WS_PQT + (((size_t)(b * 2048 + g * 256)) * 4096 + (size_t)cs * 2048 + p0) * 2; ldo = 4096; }
        else { const int b = u.pn - 64; o = (char*)ws + WS_PQTC + (((size_t)(b * 2048 + g * 256)) * 512 + (size_t)cs * 256) * 2; ldo = 512; }
        kind = 0; }
};
struct SchedF2 {
    unsigned char* ws;
    __device__ __forceinline__ int total() const { return 576; }
    __device__ __forceinline__ int nt(const pg8::Unit&) const { return 8; }
    __device__ __forceinline__ bool next(int i, pg8::Unit& u) const {
        const int L = i * (int)gridDim.x + (int)blockIdx.x; u.kq = -1;
        if (L < 512) { pg8::tile_of_id<8>(L, 64, u.pm, u.pn); return true; }
        if (L >= 576) return false;
        u.pm = 64 + ((L - 512) & 7); u.pn = (L - 512) >> 3; return true; }
    __device__ __forceinline__ const char* a(const pg8::Unit& u) const { return (const char*)ws + (u.pm < 64 ? WS_W2 : WS_W2C); }
    __device__ __forceinline__ const char* b(const pg8::Unit& u) const { return u.pm < 64 ? (const char*)ws + WS_VT + ((size_t)u.pm * 2048 + (size_t)u.pn * 256) * 512 * 2
                                                                                           : (const char*)ws + WS_PQTC + ((size_t)((u.pm - 64) * 2048 + u.pn * 256)) * 512 * 2; }
    __device__ __forceinline__ void out(const pg8::Unit& u, char*& o, int& ldo, int& kind) const { kind = 0;
        if (u.pm < 64) { o = (char*)ws + WS_F + (((size_t)((u.pm >> 3) * 2048 + (u.pm & 7))) * D + (size_t)u.pn * 256) * 2; ldo = 8 * D; }
        else { o = (char*)ws + WS_F + (((size_t)(MLAT + (u.pm - 64) * 256)) * D + (size_t)u.pn * 256) * 2; ldo = D; } }
};

__device__ __forceinline__ void p0_transpose_item(const float* W, int K, int N, bf16_t* WT, int k0, int n0, int drow0, LAS float* scr, int lane) {
    const int kk = lane >> 3, nq = (lane & 7) * 4;
    f32x4 v[8];
#pragma unroll
    for (int i = 0; i < 8; ++i) v[i] = *(const f32x4*)(W + (size_t)(k0 + 8 * i + kk) * N + n0 + nq);
#pragma unroll
    for (int i = 0; i < 8; ++i) { LAS float* d = scr + (8 * i + kk) * 33 + nq; d[0] = v[i].x; d[1] = v[i].y; d[2] = v[i].z; d[3] = v[i].w; }
    LDS_WAIT(); asm volatile("" ::: "memory");
    const int c = lane & 7;
#pragma unroll
    for (int j = 0; j < 4; ++j) { const int n = (lane >> 3) + 8 * j; const LAS float* s = scr + (8 * c) * 33 + n;
        u32x4 o; o.x = cvt_pk_bf16(s[0 * 33], s[1 * 33]); o.y = cvt_pk_bf16(s[2 * 33], s[3 * 33]); o.z = cvt_pk_bf16(s[4 * 33], s[5 * 33]); o.w = cvt_pk_bf16(s[6 * 33], s[7 * 33]);
        *(u32x4*)(WT + (size_t)(drow0 + n) * K + k0 + 8 * c) = o; }
    LDS_WAIT(); asm volatile("" ::: "memory");
}
__device__ __forceinline__ int win_dst_row(int n0) { return n0 < 5120 ? n0 : (n0 < 5248 ? 10240 + (n0 - 5120) : n0 - 128); }

__device__ __forceinline__ void p0_prologue(Frame& F) {
    fresh_ids(F);
    LAS float* scr = (LAS float*)(F.lds + F.wave * 16384);
    const int gw = blockIdx.x * NWAVES + F.wave, NGW = F.G * NWAVES, lane = F.lane;
    unsigned char* ws = F.ws;
    {
        constexpr int NCG = MODW / 256, NKS = 8, NIT = DEPTH * NCG * NKS;
        const float* c = F.in[I_C]; const float* cc = F.in[I_CCTX]; const float* wm = F.in[I_WMOD];
        float* modp = (float*)(ws + WS_MODP);
        for (int it = gw; it < NIT; it += NGW) {
            const int ks = it % NKS, cg = (it / NKS) % NCG, L = it / (NKS * NCG), k0 = ks * 256;
            for (int e = lane; e < 9 * 256; e += 64) { const int k = e & 255, b = e >> 8; const float v = (b < 8) ? c[b * D + k0 + k] : cc[k0 + k]; scr[k * 12 + b] = silu_f(v); }
            LDS_WAIT(); asm volatile("" ::: "memory");
            f32x4 acc[9];
#pragma unroll
            for (int b = 0; b < 9; ++b) acc[b] = (f32x4){0.f, 0.f, 0.f, 0.f};
            const float* wp = wm + ((size_t)L * D + k0) * MODW + cg * 256 + lane * 4;
#pragma unroll 8
            for (int k = 0; k < 256; ++k) {
                const f32x4 wv = *(const f32x4*)(wp + (size_t)k * MODW);
                const f32x4 s0 = *(const LAS f32x4*)(scr + k * 12), s1 = *(const LAS f32x4*)(scr + k * 12 + 4); const float s2 = scr[k * 12 + 8];
                acc[0] += wv * s0[0]; acc[1] += wv * s0[1]; acc[2] += wv * s0[2]; acc[3] += wv * s0[3];
                acc[4] += wv * s1[0]; acc[5] += wv * s1[1]; acc[6] += wv * s1[2]; acc[7] += wv * s1[3]; acc[8] += wv * s2;
            }
#pragma unroll
            for (int b = 0; b < 9; ++b) *(f32x4*)(modp + (((size_t)ks * DEPTH + L) * 9 + b) * MODW + cg * 256 + lane * 4) = acc[b];
            LDS_WAIT(); asm volatile("" ::: "memory");
        }
    }
    {
        constexpr int I_F = (D / 64) * (D / 32);
        constexpr int I_I = (D / 64) * (INW / 32);
        constexpr int I_O = (DI / 64) * (D / 32);
        constexpr int I_U = (D / 64) * (2 * DFF / 32);
        constexpr int I_D = (DFF / 64) * (D / 32);
        constexpr int NIT = 2 * I_F + 2 * I_I + 2 * I_O + 4 * I_U + 4 * I_D;
        for (int it = gw; it < NIT; it += NGW) {
            int r = it;
            if (r < 2 * I_F) { const int j = r / I_F; r -= j * I_F; const int nblk = D / 32, kb = r / nblk, nb = r % nblk;
                p0_transpose_item(F.in[I_FOURW] + (size_t)j * D * D, D, D, (bf16_t*)(ws + WS_WFOUR) + (size_t)j * D * D, 64 * kb, 32 * nb, 32 * nb, scr, lane); continue; } r -= 2 * I_F;
            if (r < 2 * I_I) { const int j = r / I_I; r -= j * I_I; const int nblk = INW / 32, kb = r / nblk, nb = r % nblk;
                p0_transpose_item(F.in[I_WIN] + (size_t)j * D * INW, D, INW, (bf16_t*)(ws + WS_WIN) + (size_t)j * INP * D, 64 * kb, 32 * nb, win_dst_row(32 * nb), scr, lane); continue; } r -= 2 * I_I;
            if (r < 2 * I_O) { const int j = r / I_O; r -= j * I_O; const int nblk = D / 32, kb = r / nblk, nb = r % nblk;
                p0_transpose_item(F.in[I_WOUT] + (size_t)j * DI * D, DI, D, (bf16_t*)(ws + WS_WOUT) + (size_t)j * D * DI, 64 * kb, 32 * nb, 32 * nb, scr, lane); continue; } r -= 2 * I_O;
            if (r < 4 * I_U) { const int j = r / I_U; r -= j * I_U; const int nblk = 2 * DFF / 32, kb = r / nblk, nb = r % nblk;
                p0_transpose_item(F.in[I_WUP] + (size_t)j * D * 2 * DFF, D, 2 * DFF, (bf16_t*)(ws + WS_WUP) + (size_t)j * 2 * DFF * D, 64 * kb, 32 * nb, 32 * nb, scr, lane); continue; } r -= 4 * I_U;
            { const int j = r / I_D; r -= j * I_D; const int nblk = D / 32, kb = r / nblk, nb = r % nblk;
                p0_transpose_item(F.in[I_WDN] + (size_t)j * DFF * D, DFF, D, (bf16_t*)(ws + WS_WDN) + (size_t)j * D * DFF, 64 * kb, 32 * nb, 32 * nb, scr, lane); }
        }
    }
    const size_t gt = (size_t)blockIdx.x * 512 + F.tid, NT = (size_t)F.G * 512;
    for (size_t i = gt; i < (size_t)2 * 128 * D / 8; i += NT) { const size_t j = i / (128 * D / 8), e = i % (128 * D / 8);
        *(u32x4*)((bf16_t*)(ws + WS_WIN) + ((size_t)j * INP + INW) * D + e * 8) = (u32x4){0u, 0u, 0u, 0u}; }
    {
        bf16_t* W1 = (bf16_t*)(ws + WS_W1);
        for (size_t i = gt; i < (size_t)512 * 256 / 2; i += NT) { const int m = (int)(i / 128), c0 = (int)(i % 128) * 2; float v[2];
#pragma unroll
            for (int e = 0; e < 2; ++e) { const int idx = ((m & 255) * (c0 + e)) & 255; const float a = (float)idx * (1.0f / 128.0f); v[e] = (m < 256) ? cospif(a) : sinpif(a); }
            *(unsigned*)(W1 + (size_t)m * 256 + c0) = cvt_pk_bf16(v[0], v[1]); }
        bf16_t* W2c = (bf16_t*)(ws + WS_W2C);
        for (size_t i = gt; i < (size_t)256 * 512 / 2; i += NT) { const int k1 = (int)(i / 256), c0 = (int)(i % 256) * 2; float v[2];
#pragma unroll
            for (int e = 0; e < 2; ++e) { const int cc = c0 + e, l = cc & 255; const int idx = (k1 * l) & 255; const float a = (float)idx * (1.0f / 128.0f); v[e] = ((cc < 256) ? cospif(a) : -sinpif(a)) * (1.0f / 256.0f); }
            *(unsigned*)(W2c + (size_t)k1 * 512 + c0) = cvt_pk_bf16(v[0], v[1]); }
        bf16_t* W2 = (bf16_t*)(ws + WS_W2); const float sc = 0.0013810679320049757f;
        for (size_t i = gt; i < (size_t)256 * 512 / 2; i += NT) { const int k2 = (int)(i / 256), c0 = (int)(i % 256) * 2; float v[2];
#pragma unroll
            for (int e = 0; e < 2; ++e) { const int cc = c0 + e, l = cc & 255; const int idx = (k2 * l) & 255; const float a = (float)idx * (1.0f / 128.0f); v[e] = ((cc < 256) ? cospif(a) : sinpif(a)) * sc; }
            *(unsigned*)(W2 + (size_t)k2 * 512 + c0) = cvt_pk_bf16(v[0], v[1]); }
    }
}
__device__ __forceinline__ void p0b_modreduce(Frame& F) {
    fresh_ids(F);
    const size_t gt = (size_t)blockIdx.x * 512 + F.tid, NT = (size_t)F.G * 512;
    const float* modp = (const float*)(F.ws + WS_MODP); float* mod = (float*)(F.ws + WS_MOD); const float* bm = F.in[I_BMOD];
    constexpr size_t PER = (size_t)DEPTH * 9 * MODW;
    for (size_t i = gt; i < PER / 4; i += NT) { const size_t e = i * 4; const int n = (int)(e % MODW), L = (int)(e / ((size_t)9 * MODW));
        f32x4 s = *(const f32x4*)(bm + (size_t)L * MODW + n);
#pragma unroll
        for (int ks = 0; ks < 8; ++ks) s += *(const f32x4*)(modp + (size_t)ks * PER + e);
        *(f32x4*)(mod + e) = s; }
}

__device__ __forceinline__ void norm_mod_phase(Frame& F, int L, const float* gvec, int sh_chunk, int nrows, const float* pg, const float* xlat, const float* xctx) {
    fresh_ids(F);
    const int gw = blockIdx.x * NWAVES + F.wave, NGW = F.G * NWAVES, lane = F.lane;
    const float* mod = (const float*)(F.ws + WS_MOD) + (size_t)L * 9 * MODW; bf16_t* A = (bf16_t*)(F.ws + WS_A);
    for (int r = gw; r < nrows; r += NGW) {
        const int bidx = r < MLAT ? (r >> 11) : 8;
        const f32x4* xr = (const f32x4*)(r < MLAT ? xlat + (size_t)r * D : xctx + (size_t)(r - MLAT) * D) + lane;
        f32x4 v[8]; float ss = 0.f;
#pragma unroll
        for (int j = 0; j < 8; ++j) v[j] = xr[64 * j];
        if (pg != nullptr && r < MLAT) {
            const u32x2* yp = (const u32x2*)((const bf16_t*)(F.ws + WS_Y) + (size_t)r * D) + lane; const f32x4* gq = (const f32x4*)(pg + (size_t)bidx * MODW) + lane; f32x4* xw_ = (f32x4*)(F.out + (size_t)r * D) + lane;
#pragma unroll
            for (int j = 0; j < 8; ++j) { const u32x2 yy = yp[64 * j]; const f32x4 y4 = {bf_lo(yy.x), bf_hi(yy.x), bf_lo(yy.y), bf_hi(yy.y)}; v[j] += gq[64 * j] * y4; xw_[64 * j] = v[j]; }
        }
        if (pg != nullptr && r >= MLAT) {
            const f32x4* pp = (const f32x4*)((const float*)(F.ws + WS_PART) + (size_t)(r - MLAT) * D) + lane; const f32x4* gq = (const f32x4*)(pg + (size_t)8 * MODW) + lane; f32x4* xw_ = (f32x4*)((float*)(F.ws + WS_XC) + (size_t)(r - MLAT) * D) + lane;
#pragma unroll
            for (int j = 0; j < 8; ++j) { const f32x4 p = (pp[64 * j] + pp[64 * j + (size_t)MCTX * D / 4]) + (pp[64 * j + (size_t)2 * MCTX * D / 4] + pp[64 * j + (size_t)3 * MCTX * D / 4]); v[j] += gq[64 * j] * p; xw_[64 * j] = v[j]; }
        }
#pragma unroll
        for (int j = 0; j < 8; ++j) ss += (v[j].x * v[j].x + v[j].y * v[j].y) + (v[j].z * v[j].z + v[j].w * v[j].w);
        const float rstd = rsqrtf(wave_sum(ss, lane) * (1.0f / D) + EPS);
        const f32x4* gp = (const f32x4*)gvec + lane; const f32x4* shp = (const f32x4*)(mod + (size_t)bidx * MODW + sh_chunk * D) + lane; const f32x4* scp = shp + D / 4;
        u32x2* o = (u32x2*)(A + (size_t)r * D) + lane;
#pragma unroll
        for (int j = 0; j < 8; ++j) { const f32x4 g = gp[64 * j], sh = shp[64 * j], sc = scp[64 * j]; const f32x4 y = v[j] * rstd * g * (sc + 1.0f) + sh;
            u32x2 w; w.x = cvt_pk_bf16(y.x, y.y); w.y = cvt_pk_bf16(y.z, y.w); o[64 * j] = w; }
    }
}
__device__ __forceinline__ void final_norm_phase(Frame& F) {
    fresh_ids(F);
    const int gw = blockIdx.x * NWAVES + F.wave, NGW = F.G * NWAVES, lane = F.lane;
    const f32x4* gp = (const f32x4*)F.in[I_FING] + lane;
    for (int r = gw; r < MLAT; r += NGW) {
        f32x4* xr = (f32x4*)(F.out + (size_t)r * D) + lane;
        const u32x2* yp = (const u32x2*)((const bf16_t*)(F.ws + WS_Y) + (size_t)r * D) + lane; const f32x4* gq = (const f32x4*)((const float*)(F.ws + WS_MOD) + ((size_t)(DEPTH - 1) * 9 + (r >> 11)) * MODW + 5 * D) + lane;
        f32x4 v[8]; float ss = 0.f;
#pragma unroll
        for (int j = 0; j < 8; ++j) { const u32x2 yy = yp[64 * j]; const f32x4 y4 = {bf_lo(yy.x), bf_hi(yy.x), bf_lo(yy.y), bf_hi(yy.y)}; v[j] = xr[64 * j] + gq[64 * j] * y4;
            ss += (v[j].x * v[j].x + v[j].y * v[j].y) + (v[j].z * v[j].z + v[j].w * v[j].w); }
        const float rstd = rsqrtf(wave_sum(ss, lane) * (1.0f / D) + EPS);
#pragma unroll
        for (int j = 0; j < 8; ++j) xr[64 * j] = v[j] * rstd * gp[64 * j];
    }
}

__device__ __forceinline__ void unpack8(const u32x4 w, float (&f)[8]) {
    f[0] = bf_lo(w.x); f[1] = bf_hi(w.x); f[2] = bf_lo(w.y); f[3] = bf_hi(w.y); f[4] = bf_lo(w.z); f[5] = bf_hi(w.z); f[6] = bf_lo(w.w); f[7] = bf_hi(w.w);
}
__device__ __forceinline__ u32x4 pack8(const float (&f)[8]) { u32x4 w; w.x = cvt_pk_bf16(f[0], f[1]); w.y = cvt_pk_bf16(f[2], f[3]); w.z = cvt_pk_bf16(f[4], f[5]); w.w = cvt_pk_bf16(f[6], f[7]); return w; }

__device__ __forceinline__ void fft8_phase(Frame& F) {
    fresh_ids(F);
    const int gw = blockIdx.x * NWAVES + F.wave, NGW = F.G * NWAVES, lane = F.lane;
    const bf16_t* pqt = (const bf16_t*)(F.ws + WS_PQT); bf16_t* vt = (bf16_t*)(F.ws + WS_VT);
    float twc[8][4], tws[8][4];
#pragma unroll
    for (int k1 = 0; k1 < 8; ++k1)
#pragma unroll
        for (int e = 0; e < 4; ++e) { const int idx = (4 * lane + e) * k1; const float a = (float)idx * (1.0f / 1024.0f); twc[k1][e] = cospif(a); tws[k1][e] = sinpif(a); }
    constexpr float R2 = 0.70710678118654752f;
    for (int row = gw; row < NB * D; row += NGW) {
        const bf16_t* src = pqt + (size_t)row * 4096 + 4 * lane;
        u32x2 rp[8], rq[8];
#pragma unroll
        for (int l1 = 0; l1 < 8; ++l1) { rp[l1] = *(const u32x2*)(src + 256 * l1); rq[l1] = *(const u32x2*)(src + 2048 + 256 * l1); }
        const int b = row >> 11, n = row & 2047;
        bf16_t* dst = vt + (((size_t)b * 8) * 2048 + n) * 512 + 4 * lane;
        float vr[8][4], vi[8][4];
#pragma unroll
        for (int e = 0; e < 4; ++e) {
            float xr[8], xi[8];
#pragma unroll
            for (int l1 = 0; l1 < 8; ++l1) { const unsigned wp = (e < 2) ? rp[l1].x : rp[l1].y, wq = (e < 2) ? rq[l1].x : rq[l1].y; xr[l1] = (e & 1) ? bf_hi(wp) : bf_lo(wp); xi[l1] = -((e & 1) ? bf_hi(wq) : bf_lo(wq)); }
            const float a0r = xr[0] + xr[4], a0i = xi[0] + xi[4], a1r = xr[0] - xr[4], a1i = xi[0] - xi[4], a2r = xr[2] + xr[6], a2i = xi[2] + xi[6], a3r = xr[2] - xr[6], a3i = xi[2] - xi[6];
            const float a4r = xr[1] + xr[5], a4i = xi[1] + xi[5], a5r = xr[1] - xr[5], a5i = xi[1] - xi[5], a6r = xr[3] + xr[7], a6i = xi[3] + xi[7], a7r = xr[3] - xr[7], a7i = xi[3] - xi[7];
            const float b0r = a0r + a2r, b0i = a0i + a2i, b2r = a0r - a2r, b2i = a0i - a2i, b1r = a1r + a3i, b1i = a1i - a3r, b3r = a1r - a3i, b3i = a1i + a3r;
            const float c0r = a4r + a6r, c0i = a4i + a6i, c2r = a4r - a6r, c2i = a4i - a6i, c1r = a5r + a7i, c1i = a5i - a7r, c3r = a5r - a7i, c3i = a5i + a7r;
            const float d1r = (c1r + c1i) * R2, d1i = (c1i - c1r) * R2, d2r = c2i, d2i = -c2r, d3r = (c3i - c3r) * R2, d3i = -(c3r + c3i) * R2;
            float yr[8], yi[8];
            yr[0] = b0r + c0r; yi[0] = b0i + c0i; yr[4] = b0r - c0r; yi[4] = b0i - c0i;
            yr[1] = b1r + d1r; yi[1] = b1i + d1i; yr[5] = b1r - d1r; yi[5] = b1i - d1i;
            yr[2] = b2r + d2r; yi[2] = b2i + d2i; yr[6] = b2r - d2r; yi[6] = b2i - d2i;
            yr[3] = b3r + d3r; yi[3] = b3i + d3i; yr[7] = b3r - d3r; yi[7] = b3i - d3i;
#pragma unroll
            for (int k1 = 0; k1 < 8; ++k1) { const float c = twc[k1][e], sn = tws[k1][e]; vr[k1][e] = yr[k1] * c + yi[k1] * sn; vi[k1][e] = yi[k1] * c - yr[k1] * sn; }
        }
#pragma unroll
        for (int k1 = 0; k1 < 8; ++k1) { u32x2 o; o.x = cvt_pk_bf16(vr[k1][0], vr[k1][1]); o.y = cvt_pk_bf16(vr[k1][2], vr[k1][3]); *(u32x2*)(dst + (size_t)k1 * 2048 * 512) = o;
            u32x2 p; p.x = cvt_pk_bf16(vi[k1][0], vi[k1][1]); p.y = cvt_pk_bf16(vi[k1][2], vi[k1][3]); *(u32x2*)(dst + (size_t)k1 * 2048 * 512 + 256) = p; }
    }
}

__device__ __forceinline__ void ssd_conv_phase(Frame& F, int j, bool skip_ctx_c) {
    fresh_ids(F);
    const int gw = blockIdx.x * NWAVES + F.wave, NGW = F.G * NWAVES, lane = F.lane, cq = lane & 7, tq = lane >> 3;
    const bf16_t* pre = (const bf16_t*)(F.ws + WS_XBCP);
    const float* cw = F.in[I_CONVW] + (size_t)j * 3 * XBC; const float* cb_ = F.in[I_CONVB] + (size_t)j * XBC;
    bf16_t* xst = (bf16_t*)(F.ws + WS_XST); bf16_t* bm = (bf16_t*)(F.ws + WS_BM); bf16_t* bmt = (bf16_t*)(F.ws + WS_BMT); bf16_t* cm = (bf16_t*)(F.ws + WS_CM);
    constexpr int NTB = MALL / 64, NCB = XBC / 64;
    for (int job = gw; job < NTB * NCB; job += NGW) {
        const int cb = job % NCB, tb = job / NCB;
        const int rb = tb * 64;
        if (skip_ctx_c && rb >= MLAT && cb >= 80) continue;
        int seq0, T, sb;
        if (rb < MLAT) { sb = rb >> 11; seq0 = sb << 11; T = LSEQ; } else { sb = (rb - MLAT) >> 8; seq0 = MLAT + (sb << 8); T = LCTX; }
        const int tl = rb - seq0 + tq * 8;
        const int c0 = cb * 64 + cq * 8;
        float w0[8], w1[8], w2[8], bi[8];
        { const f32x4* p = (const f32x4*)(cw + c0); const f32x4 a = p[0], b = p[1]; w0[0] = a.x; w0[1] = a.y; w0[2] = a.z; w0[3] = a.w; w0[4] = b.x; w0[5] = b.y; w0[6] = b.z; w0[7] = b.w; }
        { const f32x4* p = (const f32x4*)(cw + XBC + c0); const f32x4 a = p[0], b = p[1]; w1[0] = a.x; w1[1] = a.y; w1[2] = a.z; w1[3] = a.w; w1[4] = b.x; w1[5] = b.y; w1[6] = b.z; w1[7] = b.w; }
        { const f32x4* p = (const f32x4*)(cw + 2 * XBC + c0); const f32x4 a = p[0], b = p[1]; w2[0] = a.x; w2[1] = a.y; w2[2] = a.z; w2[3] = a.w; w2[4] = b.x; w2[5] = b.y; w2[6] = b.z; w2[7] = b.w; }
        { const f32x4* p = (const f32x4*)(cb_ + c0); const f32x4 a = p[0], b = p[1]; bi[0] = a.x; bi[1] = a.y; bi[2] = a.z; bi[3] = a.w; bi[4] = b.x; bi[5] = b.y; bi[6] = b.z; bi[7] = b.w; }
        u32x4 raw[10];
#pragma unroll
        for (int i = 0; i < 10; ++i) { const int tt = tl - 1 + i; raw[i] = (tt >= 0 && tt < T) ? *(const u32x4*)(pre + (size_t)(seq0 + tt) * XBC + c0) : (u32x4){0u, 0u, 0u, 0u}; }
        float o[8][8];
        { float pa[8], pb[8], pc[8]; unpack8(raw[0], pa); unpack8(raw[1], pb);
#pragma unroll
          for (int i = 0; i < 8; ++i) { unpack8(raw[i + 2], pc);
#pragma unroll
              for (int c = 0; c < 8; ++c) o[i][c] = silu_f(bi[c] + w0[c] * pa[c] + w1[c] * pb[c] + w2[c] * pc[c]);
#pragma unroll
              for (int c = 0; c < 8; ++c) { pa[c] = pb[c]; pb[c] = pc[c]; } } }
        if (cb < 64) {
            bf16_t* dst = (rb < MLAT) ? xst + ((size_t)sb * DI + c0) * LSEQ + tl : xst + (size_t)NB * DI * LSEQ + ((size_t)sb * DI + c0) * LCTX + tl;
#pragma unroll
            for (int c = 0; c < 8; ++c) { float t8[8];
#pragma unroll
                for (int i = 0; i < 8; ++i) t8[i] = o[i][c];
                *(u32x4*)(dst + (size_t)c * T) = pack8(t8); }
        } else if (cb < 80) {
            const int cc = c0 - DI;
#pragma unroll
            for (int i = 0; i < 8; ++i) *(u32x4*)(bm + (size_t)(seq0 + tl + i) * GNW + cc) = pack8(o[i]);
            bf16_t* dst = (rb < MLAT) ? bmt + ((size_t)sb * GNW + cc) * LSEQ + tl : bmt + (size_t)NB * GNW * LSEQ + ((size_t)sb * GNW + cc) * LCTX + tl;
#pragma unroll
            for (int c = 0; c < 8; ++c) { float t8[8];
#pragma unroll
                for (int i = 0; i < 8; ++i) t8[i] = o[i][c];
                *(u32x4*)(dst + (size_t)c * T) = pack8(t8); }
        } else {
            const int cc = c0 - DI - GNW;
#pragma unroll
            for (int i = 0; i < 8; ++i) *(u32x4*)(cm + (size_t)(seq0 + tl + i) * GNW + cc) = pack8(o[i]);
        }
    }
}

__device__ __forceinline__ void ffn_conv_phase(Frame& F, int L, int nrows, bool probe_alt = false) {
    fresh_ids(F);
    const int gw = blockIdx.x * NWAVES + F.wave, NGW = F.G * NWAVES;
    const bf16_t* gate = (const bf16_t*)(F.ws + WS_GATE); bf16_t* val = (bf16_t*)(F.ws + WS_VAL);
    const float* cw = F.in[I_FCW] + (size_t)L * 9 * DFF; const float* cb_ = F.in[I_FCB] + (size_t)L * DFF;
    const int NTB = nrows / 64; constexpr int NCB = DFF / 64;
    for (int job = gw; job < NTB * NCB; job += NGW) {
        const int lane = fresh_lane(), cq = lane & 7, tq = lane >> 3;
        const int cb = job / NTB, tb = job % NTB;
        const int rb = tb * 64, c0 = cb * 64 + cq * 8;
        const bool lat = rb < MLAT;
        const int gr = lat ? (tb & 31) : 0, base = lat ? (rb - gr * 64) : (MLAT + (((rb - MLAT) >> 8) << 8)), q = lat ? 0 : (((rb - MLAT) >> 6) & 3);
        u32x4 raw[3][10], rv[8];
#define FFN_LOAD_ROW(dr) do { const bool rowok_ = lat ? (gr + (dr) - 1 >= 0 && gr + (dr) - 1 < 32) : ((dr) == 1); const int rbase_ = lat ? base + (gr + (dr) - 1) * 64 : base + q * 64; \
            _Pragma("unroll") for (int i_ = 0; i_ < 10; ++i_) { const int col_ = tq * 8 - 1 + i_; const bool ok_ = rowok_ && (lat ? (col_ >= 0 && col_ < 64) : (q * 64 + col_ >= 0 && q * 64 + col_ < LCTX)); \
                raw[dr][i_] = ok_ ? *(const u32x4*)(gate + (size_t)(rbase_ + col_) * DFF + c0) : (u32x4){0u, 0u, 0u, 0u}; } } while (0)
#define FFN_ACC_ROW(dr) do { float w_[3][8]; \
            _Pragma("unroll") for (int dc_ = 0; dc_ < 3; ++dc_) { const f32x4* p_ = (const f32x4*)(cw + (size_t)((dr) * 3 + dc_) * DFF + c0); const f32x4 a_ = p_[0], b_ = p_[1]; \
                w_[dc_][0] = a_.x; w_[dc_][1] = a_.y; w_[dc_][2] = a_.z; w_[dc_][3] = a_.w; w_[dc_][4] = b_.x; w_[dc_][5] = b_.y; w_[dc_][6] = b_.z; w_[dc_][7] = b_.w; } \
            float pa_[8], pb_[8], pc_[8]; unpack8(raw[dr][0], pa_); unpack8(raw[dr][1], pb_); \
            _Pragma("unroll") for (int i_ = 0; i_ < 8; ++i_) { unpack8(raw[dr][i_ + 2], pc_); \
                _Pragma("unroll") for (int c_ = 0; c_ < 8; ++c_) acc[i_][c_] += w_[0][c_] * pa_[c_] + w_[1][c_] * pb_[c_] + w_[2][c_] * pc_[c_]; \
                _Pragma("unroll") for (int c_ = 0; c_ < 8; ++c_) { pa_[c_] = pb_[c_]; pb_[c_] = pc_[c_]; } } } while (0)
        FFN_LOAD_ROW(0); FFN_LOAD_ROW(1);
        float acc[8][8];
        { const f32x4* p = (const f32x4*)(cb_ + c0); const f32x4 a = p[0], b = p[1];
#pragma unroll
          for (int i = 0; i < 8; ++i) { acc[i][0] = a.x; acc[i][1] = a.y; acc[i][2] = a.z; acc[i][3] = a.w; acc[i][4] = b.x; acc[i][5] = b.y; acc[i][6] = b.z; acc[i][7] = b.w; } }
        FFN_ACC_ROW(0);
        asm volatile("" ::: "memory");
        FFN_LOAD_ROW(2);
#pragma unroll
        for (int i = 0; i < 8; ++i) rv[i] = *(const u32x4*)(val + (size_t)(rb + tq * 8 + i) * DFF + c0);
        FFN_ACC_ROW(1);
        FFN_ACC_ROW(2);
#undef FFN_LOAD_ROW
#undef FFN_ACC_ROW
#pragma unroll
        for (int i = 0; i < 8; ++i) { bf16_t* vp = val + (size_t)(rb + tq * 8 + i) * DFF + c0; float v[8]; unpack8(rv[i], v);
#pragma unroll
            for (int c = 0; c < 8; ++c) v[c] *= silu_f(acc[i][c]);
            *(u32x4*)(probe_alt ? vp + (size_t)202 * MiB / 2 : vp) = pack8(v); }
    }
}

__device__ __forceinline__ void ssd_gate_norm_phase(Frame& F, int j, int nrows) {
    fresh_ids(F);
    const int gw = blockIdx.x * NWAVES + F.wave, NGW = F.G * NWAVES, lane = F.lane;
    bf16_t* yf = (bf16_t*)(F.ws + WS_XBCP); const bf16_t* yb = (const bf16_t*)(F.ws + WS_YB); const bf16_t* z = (const bf16_t*)(F.ws + WS_Z);
    const float* ng = F.in[I_SNG] + (size_t)j * DI;
    for (int r = gw; r < nrows; r += NGW) {
#pragma unroll 4
        for (int g = 0; g < 8; ++g) { const size_t off = (size_t)r * DI + g * 512 + lane * 8;
            float a[8], b[8], zz[8]; unpack8(*(const u32x4*)(yf + off), a); unpack8(*(const u32x4*)(yb + off), b); unpack8(*(const u32x4*)(z + off), zz);
            float ss = 0.f;
#pragma unroll
            for (int c = 0; c < 8; ++c) { a[c] = (a[c] + b[c]) * silu_f(zz[c]); ss += a[c] * a[c]; }
            const float rs = rsqrtf(wave_sum(ss, lane) * (1.0f / 512.0f) + EPS);
            const f32x4* gp = (const f32x4*)(ng + g * 512 + lane * 8); const f32x4 g0 = gp[0], g1 = gp[1];
            a[0] *= rs * g0.x; a[1] *= rs * g0.y; a[2] *= rs * g0.z; a[3] *= rs * g0.w; a[4] *= rs * g1.x; a[5] *= rs * g1.y; a[6] *= rs * g1.z; a[7] *= rs * g1.w;
            *(u32x4*)(yf + off) = pack8(a); }
    }
}

__device__ __forceinline__ float softplus_f(float x) { return x > 20.f ? x : log1pf(expf(x)); }
__device__ __forceinline__ float incl_scan64(float v, int lane) {
#pragma unroll
    for (int o = 1; o < 64; o <<= 1) { const float t = __builtin_bit_cast(float, __builtin_amdgcn_ds_bpermute(((lane - o) & 63) << 2, __builtin_bit_cast(int, v))); if (lane >= o) v += t; }
    return v;
}
template <int MODE> __device__ __forceinline__ void ssd_scan_phase(Frame& F, int j, bool ctx_out) {
    fresh_ids(F);
    const int w = F.wave;
    LAS unsigned char* CS = F.lds; LAS unsigned char* BS = F.lds + 32768; LAS unsigned char* GS = F.lds + 65536;
    LAS float* tab = (LAS float*)(F.lds + 98304 + w * 2048);
    const bf16_t* cm = (const bf16_t*)(F.ws + WS_CM); const bf16_t* bm = (const bf16_t*)(F.ws + WS_BM); const bf16_t* bmt = (const bf16_t*)(F.ws + WS_BMT); const bf16_t* xst = (const bf16_t*)(F.ws + WS_XST);
    const float* dtb = (const float*)(F.ws + WS_DT);
#define SCAN_DMA(dstbase, srcptr_row0, pitch_elems) do { _Pragma("unroll") for (int q_ = 0; q_ < 4; ++q_) { const int idx_ = tid + 512 * q_, row_ = idx_ >> 4, c16_ = (idx_ & 15) ^ (row_ & 15); \
        __builtin_amdgcn_global_load_lds((const unsigned*)((srcptr_row0) + (size_t)row_ * (pitch_elems) + c16_ * 8), (LAS unsigned*)((dstbase) + (w * 64 + 512 * q_) * 16), 16, 0, 0); } } while (0)
    for (int item = blockIdx.x; item < 256; item += F.G) {
        const int ph = item & 1, dir = (item >> 1) & 1, g = (item >> 2) & 7, b = item >> 5, h = g * 8 + w;
        const float a_h = -expf(F.in[I_ALOG][(j * 2 + dir) * NH + h]) * LOG2E;
        const float dtbias = F.in[I_DTB][(j * 2 + dir) * NH + h];
        const float dsk = dir == 0 ? F.in[I_DSK][(j * 2 + 0) * NH + h] + F.in[I_DSK][(j * 2 + 1) * NH + h] : 0.f;
        bf16_t* yout = dir == 0 ? (bf16_t*)(F.ws + WS_XBCP) : (bf16_t*)(F.ws + WS_YB);
        f32x4 hT[8][2];
#pragma unroll
        for (int nt = 0; nt < 8; ++nt) { hT[nt][0] = (f32x4){0.f, 0.f, 0.f, 0.f}; hT[nt][1] = (f32x4){0.f, 0.f, 0.f, 0.f}; }
        for (int k = 0; k < 18; ++k) {
            const bool isctx = k < 2; const int cc = isctx ? (dir == 0 ? k : 1 - k) : (dir == 0 ? k - 2 : 17 - k);
            const int row0 = isctx ? MLAT + b * LCTX + cc * 128 : b * LSEQ + cc * 128, T = isctx ? LCTX : LSEQ;
            const bf16_t* xp = isctx ? xst + (size_t)NB * DI * LSEQ + ((size_t)(b * DI + h * 64 + ph * 32)) * LCTX + cc * 128 : xst + ((size_t)(b * DI + h * 64 + ph * 32)) * LSEQ + cc * 128;
            const bf16_t* btp = isctx ? bmt + (size_t)NB * GNW * LSEQ + ((size_t)(b * GNW + g * 128)) * LCTX + cc * 128 : bmt + ((size_t)(b * GNW + g * 128)) * LSEQ + cc * 128;
            const bool need_y = ctx_out || !isctx;
            __builtin_amdgcn_sched_barrier(0);
            const int lane = fresh_lane(), fr = lane & 15, fq = lane >> 4, tid = w * 64 + lane;
            const bf16_t* xl = xp + (size_t)fr * T + 8 * fq;
            bf16x8 xf[2][4];
#pragma unroll
            for (int pt = 0; pt < 2; ++pt)
#pragma unroll
                for (int ks = 0; ks < 4; ++ks) xf[pt][ks] = *(const bf16x8*)(xl + (size_t)(16 * pt) * T + 32 * ks);
            const float dtr0 = dtb[(size_t)(row0 + lane) * 128 + dir * 64 + h], dtr1 = dtb[(size_t)(row0 + 64 + lane) * 128 + dir * 64 + h];
            __syncthreads();
            if (need_y && !(MODE & 8)) { SCAN_DMA(CS, cm + (size_t)row0 * GNW + g * 128, GNW); SCAN_DMA(BS, bm + (size_t)row0 * GNW + g * 128, GNW); }
            float tot = -1.f;
            if (!(MODE & 16)) {
                const float dt0 = softplus_f(dtr0 + dtbias), dt1 = softplus_f(dtr1 + dtbias);
                const float dA0 = dt0 * a_h, dA1 = dt1 * a_h;
                const float p0 = incl_scan64(dA0, lane), tot0 = __builtin_bit_cast(float, __builtin_amdgcn_readlane(__builtin_bit_cast(int, p0), 63)), p1 = incl_scan64(dA1, lane) + tot0; tot = __builtin_bit_cast(float, __builtin_amdgcn_readlane(__builtin_bit_cast(int, p1), 63));
                const float c0 = dir == 0 ? p0 : tot - p0 + dA0, c1 = dir == 0 ? p1 : tot - p1 + dA1;
                tab[lane] = c0; tab[64 + lane] = c1; tab[128 + lane] = dt0; tab[192 + lane] = dt1;
                tab[256 + lane] = dt0 * exp2f(tot - c0); tab[320 + lane] = dt1 * exp2f(tot - c1);
                asm volatile("" ::: "memory");
                const int r0 = dir == 0 ? (lane | 31) : (lane & ~31);
                tab[384 + lane] = dt0 * __builtin_amdgcn_exp2f(tab[r0] - c0); tab[448 + lane] = dt1 * __builtin_amdgcn_exp2f(tab[64 + r0] - c1);
            }
            VM_WAIT(); __syncthreads();
            bf16x8 xs2[2][4];
#pragma unroll
            for (int ks = 0; ks < 4; ++ks) { const f32x4 fa = *(const LAS f32x4*)(tab + 384 + 32 * ks + 8 * fq), fb = *(const LAS f32x4*)(tab + 384 + 32 * ks + 8 * fq + 4);
#pragma unroll
                for (int pt = 0; pt < 2; ++pt) { float xv[8]; unpack8(__builtin_bit_cast(u32x4, xf[pt][ks]), xv);
                    xv[0] *= fa.x; xv[1] *= fa.y; xv[2] *= fa.z; xv[3] *= fa.w; xv[4] *= fb.x; xv[5] *= fb.y; xv[6] *= fb.z; xv[7] *= fb.w;
                    xs2[pt][ks] = __builtin_bit_cast(bf16x8, pack8(xv)); } }
            if (need_y && !(MODE & 2)) {
                bf16x8 cf[4];
#pragma unroll
                for (int ks = 0; ks < 4; ++ks) cf[ks] = *(const LAS bf16x8*)(CS + (16 * w + fr) * 256 + (((4 * ks + fq) ^ fr) << 4));
#pragma unroll 2
                for (int st = 0; st < 8; ++st) { f32x4 acc = (f32x4){0.f, 0.f, 0.f, 0.f};
#pragma unroll
                    for (int ks = 0; ks < 4; ++ks) { const bf16x8 bfr = *(const LAS bf16x8*)(BS + (16 * st + fr) * 256 + (((4 * ks + fq) ^ fr) << 4)); acc = __builtin_amdgcn_mfma_f32_16x16x32_bf16(bfr, cf[ks], acc, 0, 0, 0); }
                    u32x2 o; o.x = cvt_pk_bf16(acc[0], acc[1]); o.y = cvt_pk_bf16(acc[2], acc[3]);
                    *(LAS u32x2*)(GS + (16 * w + fr) * 256 + (((2 * st + (fq >> 1)) ^ fr) << 4) + (fq & 1) * 8) = o; }
            }
            __syncthreads();
            if (!(MODE & 8)) SCAN_DMA(BS, btp, T);
            if (need_y && !(MODE & 1)) {
                bf16x8 hf[2][4];
#pragma unroll
                for (int pt = 0; pt < 2; ++pt)
#pragma unroll
                    for (int q = 0; q < 4; ++q) { const f32x4 lo4 = hT[2 * q][pt], hi4 = hT[2 * q + 1][pt]; u32x4 o; o.x = cvt_pk_bf16(lo4[0], lo4[1]); o.y = cvt_pk_bf16(lo4[2], lo4[3]); o.z = cvt_pk_bf16(hi4[0], hi4[1]); o.w = cvt_pk_bf16(hi4[2], hi4[3]);
                        hf[pt][q] = __builtin_bit_cast(bf16x8, o); }
#pragma unroll 1
                for (int lt = 0; lt < 8; ++lt) {
                    const int l = 16 * lt + fr; const float cl = tab[l];
                    f32x4 accd[2], acco[2];
                    accd[0] = accd[1] = acco[0] = acco[1] = (f32x4){0.f, 0.f, 0.f, 0.f};
                    const int kd = lt >> 1;
                    const bf16x8 xa = *(const bf16x8*)(xl + 32 * kd), xb = *(const bf16x8*)(xl + (size_t)16 * T + 32 * kd);
#pragma unroll
                    for (int ks = 0; ks < 4; ++ks) {
                        const bool full = dir == 0 ? (ks < kd) : (ks > kd);
                        if (full) {
                            const bf16x8 gf = *(const LAS bf16x8*)(GS + l * 256 + (((4 * ks + fq) ^ fr) << 4));
                            const float f1 = __builtin_amdgcn_exp2f(cl - tab[dir == 0 ? 32 * ks + 31 : 32 * ks]);
                            const f32x4 z4 = (f32x4){0.f, 0.f, 0.f, 0.f};
                            const f32x4 t0 = __builtin_amdgcn_mfma_f32_16x16x32_bf16(xs2[0][ks], gf, z4, 0, 0, 0), t1 = __builtin_amdgcn_mfma_f32_16x16x32_bf16(xs2[1][ks], gf, z4, 0, 0, 0);
                            accd[0] += t0 * f1; accd[1] += t1 * f1;
                        }
                    }
#pragma unroll
                    for (int q = 0; q < 4; ++q) {
                        const u32x2 lo = *(const LAS u32x2*)(CS + l * 256 + (((4 * q + (fq >> 1)) ^ fr) << 4) + (fq & 1) * 8), hi = *(const LAS u32x2*)(CS + l * 256 + (((4 * q + 2 + (fq >> 1)) ^ fr) << 4) + (fq & 1) * 8);
                        u32x4 c4; c4.x = lo.x; c4.y = lo.y; c4.z = hi.x; c4.w = hi.y; const bf16x8 cfr = __builtin_bit_cast(bf16x8, c4);
                        acco[0] = __builtin_amdgcn_mfma_f32_16x16x32_bf16(hf[0][q], cfr, acco[0], 0, 0, 0);
                        acco[1] = __builtin_amdgcn_mfma_f32_16x16x32_bf16(hf[1][q], cfr, acco[1], 0, 0, 0);
                    }
                    {
                        float gg[8]; unpack8(*(const LAS u32x4*)(GS + l * 256 + (((4 * kd + fq) ^ fr) << 4)), gg);
                        const f32x4 ca = *(const LAS f32x4*)(tab + 32 * kd + 8 * fq), cb = *(const LAS f32x4*)(tab + 32 * kd + 8 * fq + 4);
                        const f32x4 da = *(const LAS f32x4*)(tab + 128 + 32 * kd + 8 * fq), db = *(const LAS f32x4*)(tab + 128 + 32 * kd + 8 * fq + 4);
                        const float cs[8] = {ca.x, ca.y, ca.z, ca.w, cb.x, cb.y, cb.z, cb.w}, ds[8] = {da.x, da.y, da.z, da.w, db.x, db.y, db.z, db.w};
                        float m[8];
#pragma unroll
                        for (int jj = 0; jj < 8; ++jj) { const int s = 32 * kd + 8 * fq + jj; const bool valid = dir == 0 ? (s <= l) : (s >= l);
                            const float e = valid ? __builtin_amdgcn_exp2f(cl - cs[jj]) : 0.f; m[jj] = gg[jj] * e * ds[jj]; if (dir == 0 && s == l) m[jj] += dsk; }
                        const bf16x8 mf = __builtin_bit_cast(bf16x8, pack8(m));
                        accd[0] = __builtin_amdgcn_mfma_f32_16x16x32_bf16(xa, mf, accd[0], 0, 0, 0);
                        accd[1] = __builtin_amdgcn_mfma_f32_16x16x32_bf16(xb, mf, accd[1], 0, 0, 0);
                    }
                    const float el = __builtin_amdgcn_exp2f(cl);
#pragma unroll
                    for (int pt = 0; pt < 2; ++pt) { const f32x4 y = accd[pt] + acco[pt] * el; u32x2 o; o.x = cvt_pk_bf16(y[0], y[1]); o.y = cvt_pk_bf16(y[2], y[3]);
                        *(u32x2*)(yout + (size_t)(row0 + l) * DI + h * 64 + ph * 32 + 16 * pt + 4 * fq) = o; }
                }
            }
            VM_WAIT(); __syncthreads();
            if (!(MODE & 4)) {
                const float dec = exp2f(tot);
#pragma unroll
                for (int nt = 0; nt < 8; ++nt) { hT[nt][0] *= dec; hT[nt][1] *= dec; }
                bf16x8 xw[2][4];
#pragma unroll
                for (int ks = 0; ks < 4; ++ks) { const float sck = __builtin_amdgcn_exp2f(tot - tab[dir == 0 ? 32 * ks + 31 : 32 * ks]);
#pragma unroll
                    for (int pt = 0; pt < 2; ++pt) { float xv[8]; unpack8(__builtin_bit_cast(u32x4, xs2[pt][ks]), xv);
#pragma unroll
                        for (int e = 0; e < 8; ++e) xv[e] *= sck;
                        xw[pt][ks] = __builtin_bit_cast(bf16x8, pack8(xv)); } }
#pragma unroll
                for (int nt = 0; nt < 8; ++nt) {
#pragma unroll
                    for (int ks = 0; ks < 4; ++ks) { const bf16x8 bfr = *(const LAS bf16x8*)(BS + (16 * nt + fr) * 256 + (((4 * ks + fq) ^ fr) << 4));
                        hT[nt][0] = __builtin_amdgcn_mfma_f32_16x16x32_bf16(bfr, xw[0][ks], hT[nt][0], 0, 0, 0);
                        hT[nt][1] = __builtin_amdgcn_mfma_f32_16x16x32_bf16(bfr, xw[1][ks], hT[nt][1], 0, 0, 0); }
                    if (nt & 1) __builtin_amdgcn_sched_barrier(0);
                }
            }
        }
        __syncthreads();
    }
#undef SCAN_DMA
}

constexpr int N_PHASES = 43;
__host__ __device__ constexpr bool phase_exists(int p) {
    if (p < 2 || p == 42) return true;
    const int L = (p - 2) / 10, s = (p - 2) % 10;
    if (L & 1) return true;
    return s != 5;
}
__global__ void __launch_bounds__(NWAVES * 64, 2) trunk_fwd(Args args) {
    extern __shared__ __attribute__((aligned(16))) unsigned char lds_raw[];
    Frame F;
    F.lds = (LAS unsigned char*)lds_raw;
    F.tid = threadIdx.x; F.lane = F.tid & 63; F.wave = __builtin_amdgcn_readfirstlane(F.tid >> 6); F.G = gridDim.x;
    F.in = args.in; F.out = args.out; F.ws = args.ws;
    volatile LAS unsigned* MISC = (volatile LAS unsigned*)(F.lds + MISC_OFF);
    for (int u = F.tid; u < (LDS_BYTES - LDSCTL_OFF) / 4; u += NWAVES * 64) ((LAS unsigned*)(F.lds + LDSCTL_OFF))[u] = 0u;
    __syncthreads();
    const int lo = args.ph_lo, hi = args.ph_hi;
    XcdBarrier bar; bar.bar = (unsigned*)(F.ws + WS_CTL) + CW_BAR; bar.x = 0; bar.st = nullptr;
    if (hi - lo > 1) bar = xcd_barrier_post((unsigned*)(F.ws + WS_CTL) + CW_BAR, MISC + 8);
#ifndef ONLY_PHASE
#define ONLY_PHASE -1
#endif
#ifndef SKIP_PHASE
#define SKIP_PHASE -2
#endif
#ifndef REP_PHASE
#define REP_PHASE -3
#endif
#define PHON(id) ((id) != SKIP_PHASE && (ONLY_PHASE < 0 || ONLY_PHASE == (id)))
#define IN(k) (lo <= (k) && (k) < hi)
#define SEAM(k) do { if ((k) + 1 < hi) xcd_barrier(bar, F.wave == 0 && fresh_lane() == 0); } while (0)
    LAS unsigned char* ring = F.lds;

#define REPS(id) ((REP_PHASE == (id)) ? 2 : 1)
#define PHASE(id, k, ...) do { if (PHON(id) && IN(k)) { for (int rep_ = 0; rep_ < REPS(id); ++rep_) { __VA_ARGS__; if (rep_ + 1 < REPS(id)) xcd_barrier(bar, F.wave == 0 && fresh_lane() == 0); } SEAM(k); } } while (0)
    PHASE(0, 0, p0_prologue(F));
    PHASE(1, 1, p0b_modreduce(F));

    for (int L = 0; L < DEPTH; ++L) {
        const int pb = 2 + 10 * L; const bool ssd = (L & 1) != 0, last = (L == DEPTH - 1); const int j = L >> 1;
        if (hi <= pb || lo >= pb + 10) continue;
        const int nrows_ffn = last ? MLAT : MALL;
        PHASE(2, pb + 0, norm_mod_phase(F, L, F.in[I_NMIX] + (size_t)L * D, 0, MALL, L > 0 ? (const float*)(F.ws + WS_MOD) + (size_t)(L - 1) * 9 * MODW + 5 * D : nullptr, L == 0 ? F.in[I_X] : F.out, L == 0 ? F.in[I_CTX] : (const float*)(F.ws + WS_XC)));
        if (!ssd) {
            PHASE(3, pb + 1, { fresh_ids(F); SchedF1 S{F.ws}; pg8::EpiTile E; pg8::gemm_phase<pg8::EpiTile, SchedF1, true>(ring, F.wave, 256, D, 256, S, E); });
            PHASE(15, pb + 2, fft8_phase(F));
            PHASE(4, pb + 3, { fresh_ids(F); SchedF2 S{F.ws}; pg8::EpiTile E; pg8::gemm_phase<pg8::EpiTile, SchedF2, true>(ring, F.wave, 512, 512, 512, S, E); });
            PHASE(5, pb + 4, { fresh_ids(F); SchedAB<D> S{F.ws, WS_F, WS_WFOUR + (size_t)j * D * D * 2, 1};
                               pg8::EpiTile E; pg8::gemm_phase<pg8::EpiTile, SchedAB<D>, true>(ring, F.wave, D, D, D, S, E); });
        } else {
            PHASE(6, pb + 1, { fresh_ids(F); SchedIn S{F.ws, WS_WIN + (size_t)j * INP * D * 2, last ? 1 : 0}; pg8::EpiTile E; pg8::gemm_phase<pg8::EpiTile, SchedIn, true>(ring, F.wave, D, D, D, S, E); });
            PHASE(7, pb + 2, ssd_conv_phase(F, j, last));
#ifndef SCAN_PROBE
#define SCAN_PROBE 0
#endif
            PHASE(8, pb + 3, { if (REPS(8) == 2 && rep_ == 0) ssd_scan_phase<SCAN_PROBE>(F, j, !last); else ssd_scan_phase<0>(F, j, !last); });
            PHASE(9, pb + 4, ssd_gate_norm_phase(F, j, last ? MLAT : MALL));
            PHASE(10, pb + 5, { fresh_ids(F); SchedAB<DI> S{F.ws, WS_XBCP, WS_WOUT + (size_t)j * D * DI * 2, last ? 0 : 1};
                                pg8::EpiTile E; pg8::gemm_phase<pg8::EpiTile, SchedAB<DI>, true>(ring, F.wave, DI, DI, DI, S, E); });
        }
        PHASE(2, pb + 6, norm_mod_phase(F, L, F.in[I_NFFN] + (size_t)L * D, 3, nrows_ffn, (const float*)(F.ws + WS_MOD) + (size_t)L * 9 * MODW + 2 * D, L == 0 ? F.in[I_X] : F.out, L == 0 ? F.in[I_CTX] : (const float*)(F.ws + WS_XC)));
        PHASE(11, pb + 7, { fresh_ids(F); SchedUp S{F.ws, WS_WUP + (size_t)L * 2 * DFF * D * 2, nrows_ffn / 256}; pg8::EpiTile E; pg8::gemm_phase<pg8::EpiTile, SchedUp, true>(ring, F.wave, D, D, D, S, E); });
        PHASE(12, pb + 8, ffn_conv_phase(F, L, nrows_ffn, REPS(12) == 2 && rep_ == 0));
        PHASE(13, pb + 9, { fresh_ids(F); SchedAB<DFF> S{F.ws, WS_VAL, WS_WDN + (size_t)L * D * DFF * 2, last ? 0 : 1};
                            pg8::EpiTile E; pg8::gemm_phase<pg8::EpiTile, SchedAB<DFF>, true>(ring, F.wave, DFF, DFF, DFF, S, E); });
    }
    PHASE(14, 42, final_norm_phase(F));
#undef PHASE
#undef REPS
#undef IN
#undef PHON
#undef SEAM
}

extern "C" void kernel_launch(void* const* d_in, const int* in_sizes, int n_in, void* d_out, int out_size, void* d_ws, size_t ws_size, hipStream_t stream) {
    static int grid = 0;
    if (grid == 0) {
        if (n_in != 22 || out_size != MLAT * D || ws_size < WS_END) { fprintf(stderr, "kernel_launch: unexpected problem (n_in %d, out %d, ws %zu < %zu)\n", n_in, out_size, ws_size, (size_t)WS_END); grid = -1; return; }
        int dev = 0, cus = 0, per_cu = 0;
        if (hipGetDevice(&dev) != hipSuccess || hipDeviceGetAttribute(&cus, hipDeviceAttributeMultiprocessorCount, dev) != hipSuccess) { grid = -1; return; }
        if (hipFuncSetAttribute((const void*)trunk_fwd, hipFuncAttributeMaxDynamicSharedMemorySize, LDS_BYTES) != hipSuccess) { fprintf(stderr, "kernel_launch: hipFuncSetAttribute failed\n"); grid = -1; return; }
        if (hipOccupancyMaxActiveBlocksPerMultiprocessor(&per_cu, (const void*)trunk_fwd, NWAVES * 64, LDS_BYTES) != hipSuccess || per_cu < 1) fprintf(stderr, "kernel_launch: occupancy query says %d\n", per_cu);
        (void)hipGetLastError();
        grid = cus;
    }
    if (grid < 0) return;
    (void)hipMemsetAsync((char*)d_ws + WS_CTL, 0, CTL_ZERO_BYTES, stream);
    Args a{};
    for (int i = 0; i < 22; ++i) a.in[i] = (const float*)d_in[i];
    a.out = (float*)d_out; a.ws = (unsigned char*)d_ws;
#if MK_N_LAUNCHES == 1
    a.ph_lo = 0; a.ph_hi = N_PHASES;
    hipLaunchKernelGGL(trunk_fwd, dim3(grid), dim3(NWAVES * 64), LDS_BYTES, stream, a);
#else
    for (int p = 0; p < N_PHASES; ++p) { if (!phase_exists(p)) continue; a.ph_lo = p; a.ph_hi = p + 1;
        hipLaunchKernelGGL(trunk_fwd, dim3(grid), dim3(NWAVES * 64), LDS_BYTES, stream, a); }
#endif
}
```

```cpp
#include <hip/hip_runtime.h>
#include <cstdio>
#include <cstdint>

#define LAS __attribute__((address_space(3)))
#define GAS __attribute__((address_space(1)))
typedef unsigned short bf16_t;
typedef short bf16x8 __attribute__((ext_vector_type(8)));
typedef float f32x4 __attribute__((ext_vector_type(4)));
typedef float f32x2 __attribute__((ext_vector_type(2)));
typedef unsigned u32x4 __attribute__((ext_vector_type(4)));
typedef unsigned u32x2 __attribute__((ext_vector_type(2)));

#ifndef MK_N_LAUNCHES
#define MK_N_LAUNCHES 1
#endif

constexpr int D = 2048, NB = 8, LSEQ = 2048, LCTX = 256, DEPTH = 4;
constexpr int MLAT = NB * LSEQ, MCTX = NB * LCTX, MALL = MLAT + MCTX;
constexpr int DFF = 5632, DI = 4096, GNW = 1024, NH = 64, NS = 128;
constexpr int XBC = DI + 2 * GNW;
constexpr int INW = 10368, INP = 10496;
constexpr int MODW = 6 * D;
constexpr float EPS = 1e-6f;
constexpr float LOG2E = 1.4426950408889634f;

constexpr size_t MiB = 1u << 20;
constexpr size_t WS_CTL = 0, CTL_ZERO_BYTES = 1 * MiB;
constexpr size_t WS_MOD = 1 * MiB;
constexpr size_t WS_W1 = 3 * MiB;
constexpr size_t WS_W2C = 3 * MiB + 512 * 1024;
constexpr size_t WS_W2 = 4 * MiB;
constexpr size_t WS_WFOUR = 20 * MiB;
constexpr size_t WS_WIN = 36 * MiB;
constexpr size_t WS_WOUT = 118 * MiB;
constexpr size_t WS_WUP = 150 * MiB;
constexpr size_t WS_WDN = 326 * MiB;
constexpr size_t WS_XC = 414 * MiB;
constexpr size_t WS_A = 430 * MiB;
constexpr size_t WS_R = 502 * MiB;
constexpr size_t WS_MODP = WS_R;
constexpr size_t WS_GATE = WS_R, WS_VAL = WS_R + 198 * MiB;
constexpr size_t WS_PQT = WS_R, WS_PQTC = WS_R + 128 * MiB, WS_F = WS_R + 144 * MiB;
constexpr size_t WS_VT = WS_R + 216 * MiB;
constexpr size_t WS_XBCP = WS_R;
constexpr size_t WS_Z = WS_R + 216 * MiB;
constexpr size_t WS_DT = WS_R + 360 * MiB;
constexpr size_t WS_XST = WS_R + 369 * MiB;
constexpr size_t WS_BM = WS_R + 513 * MiB;
constexpr size_t WS_BMT = WS_R + 549 * MiB;
constexpr size_t WS_CM = WS_R + 585 * MiB;
constexpr size_t WS_YB = WS_R + 621 * MiB;
constexpr size_t WS_Y = WS_R + 621 * MiB;
constexpr size_t WS_PART = WS_R + 700 * MiB;
constexpr size_t WS_END = WS_R + 765 * MiB;
constexpr int CW_BAR = 4096;

constexpr int RING_BYTES = 131072;
constexpr int LDSCTL_OFF = RING_BYTES, MISC_OFF = LDSCTL_OFF + 320;
constexpr int LDS_BYTES = 147456;
constexpr int NWAVES = 8;

typedef __bf16 bf16x2_t __attribute__((ext_vector_type(2)));
__device__ __forceinline__ unsigned cvt_pk_bf16(float lo, float hi) { const f32x2 v = {lo, hi}; return __builtin_bit_cast(unsigned, __builtin_convertvector(v, bf16x2_t)); }
__device__ __forceinline__ float bf_lo(unsigned u) { return __uint_as_float(u << 16); }
__device__ __forceinline__ float bf_hi(unsigned u) { return __uint_as_float(u & 0xffff0000u); }
__device__ __forceinline__ float silu_f(float v) { return v / (1.0f + __expf(-v)); }
__device__ __forceinline__ float wave_sum(float v, int lane) {
#pragma unroll
    for (int o = 1; o < 64; o <<= 1) v += __builtin_bit_cast(float, __builtin_amdgcn_ds_bpermute((lane ^ o) << 2, __builtin_bit_cast(int, v)));
    return v;
}
__device__ __forceinline__ int fresh_lane() { int l; asm volatile("v_mbcnt_lo_u32_b32 %0, -1, 0\n\tv_mbcnt_hi_u32_b32 %0, -1, %0" : "=v"(l)); return l; }
#define LDS_WAIT() asm volatile("s_waitcnt lgkmcnt(0)" ::: "memory")
#define VM_WAIT() asm volatile("s_waitcnt vmcnt(0)" ::: "memory")

namespace pg8 {
constexpr int BM = 256, BK = 64, HALF = 128, HTB = HALF * BK * 2, STAGE_BYTES = 8 * HTB, NXCD = 8, WGM = 4;
__host__ __device__ __forceinline__ int lds_byte(int r, int c) { const int st = (r >> 4) * 2 + (c >> 5), rr = r & 15, cc = c & 31, ob = rr * 64 + cc * 2; return st * 1024 + (ob ^ (((ob >> 9) & 1) << 5)); }
__host__ __device__ __forceinline__ void stage_rc(int b, int& R, int& C) { const int st = b / 1024, sb = b % 1024, swz = sb ^ (((sb >> 9) & 1) << 5); R = (st >> 1) * 16 + swz / 64; C = (st & 1) * 32 + (swz % 64) / 2; }
__host__ __device__ __forceinline__ int perm32(int rho) { const int n = rho >> 4, i = rho & 15; return 8 * (i >> 2) + 4 * n + (i & 3); }

struct Unit { int pm, pn, kq; };

template <int NN> __device__ __forceinline__ void tile_of_id(int wgid, int nM, int& pm, int& pn) {
    const int nwg = nM * NN;
    { const int q = nwg / NXCD, r = nwg % NXCD, xcd = wgid % NXCD, off = wgid / NXCD; wgid = (xcd < r ? xcd * (q + 1) : r * (q + 1) + (xcd - r) * q) + off; }
    const int nig = WGM * NN, gid = wgid / nig, fm = gid * WGM, gsz = (nM - fm) < WGM ? (nM - fm) : WGM;
    pm = fm + ((wgid % nig) % gsz); pn = (wgid % nig) / gsz;
}
template <int NN> __device__ __forceinline__ bool tile2d(int i, int nM, Unit& u) {
    const long L = (long)i * (int)gridDim.x + (int)blockIdx.x; if (L >= nM * NN) return false;
    tile_of_id<NN>((int)L, nM, u.pm, u.pn); u.kq = -1; return true;
}

struct EpiTile {
    static constexpr bool PERM = true;
    template <class Sched> __device__ __forceinline__ void operator()(const f32x4 (&acc)[2][2][4][2], const Unit& u, const Sched& S, int wr, int wc, int fr, int fq) const {
        const int rl0 = wr * 64 + fr, cl0 = wc * 32 + 8 * fq;
        char* uo; int ldo, kind; S.out(u, uo, ldo, kind);
        asm volatile("" : "+s"(ldo));
        if (kind == 0) {
            bf16_t* base = (bf16_t*)uo;
#pragma unroll
            for (int ai = 0; ai < 2; ++ai)
#pragma unroll
                for (int m = 0; m < 4; ++m) { bf16_t* rowp = base + (size_t)(rl0 + ai * HALF + m * 16) * ldo + cl0;
#pragma unroll
                    for (int bj = 0; bj < 2; ++bj) { const f32x4 v0 = acc[ai][bj][m][0], v1 = acc[ai][bj][m][1];
                        u32x4 w; w.x = cvt_pk_bf16(v0[0], v0[1]); w.y = cvt_pk_bf16(v0[2], v0[3]); w.z = cvt_pk_bf16(v1[0], v1[1]); w.w = cvt_pk_bf16(v1[2], v1[3]);
                        *(u32x4*)(rowp + bj * HALF) = w; } }
        } else {
            float* base = (float*)uo;
#pragma unroll
            for (int ai = 0; ai < 2; ++ai)
#pragma unroll
                for (int m = 0; m < 4; ++m) { float* rowp = base + (size_t)(rl0 + ai * HALF + m * 16) * ldo + cl0;
                    *(f32x4*)(rowp) = acc[ai][0][m][0]; *(f32x4*)(rowp + 4) = acc[ai][0][m][1];
                    if (kind == 2) { *(f32x4*)(rowp + HALF) = acc[ai][1][m][0]; *(f32x4*)(rowp + HALF + 4) = acc[ai][1][m][1]; } }
        }
    }
};
template <class Epi, class Sched, bool ALIGN_EPI>
__device__ __forceinline__ void gemm_phase(LAS unsigned char* lds, const int wid, const int lda_, const int ldb_, const int K_, const Sched& S, const Epi& E) {
    int lda = lda_, ldb = ldb_; (void)K_; asm volatile("" : "+s"(lda), "+s"(ldb));
    const int lane = fresh_lane(), tid = wid * 64 + lane;
    const int wr = wid >> 2, wc = wid & 3, fr = lane & 15, fq = lane >> 4;
    unsigned voffA[2], voffB[2];
#pragma unroll
    for (int i = 0; i < 2; ++i) { int R, C; stage_rc(tid * 16 + i * 8192, R, C); const int Rb = Epi::PERM ? ((R & ~31) + perm32(R & 31)) : R;
        voffA[i] = (unsigned)(R * lda + C) * 2u; voffB[i] = (unsigned)(Rb * ldb + C) * 2u; }
    const size_t kstep = (size_t)(BK * 2);
    const size_t hstepA = (size_t)HALF * lda * 2, hstepB = (size_t)HALF * ldb * 2;
    const unsigned ldsw = (unsigned)wid * 1024u;
    const int aoff = lds_byte(wr * 64 + fr, fq * 8), boff = lds_byte(wc * 32 + fr, fq * 8);
#define PG8_SA(b, h) (((b) * 2 + (h)) * HTB)
#define PG8_SB(b, h) ((4 + (b) * 2 + (h)) * HTB)
#define PG8_STAGE(bufoff, gbase, voff) do { _Pragma("unroll") for (int _i = 0; _i < 2; ++_i) \
        __builtin_amdgcn_global_load_lds((const unsigned*)((const char*)(gbase) + (voff)[_i]), (LAS unsigned*)(lds + (bufoff) + ldsw + _i * 8192), 16, 0, 0); } while (0)
#define PG8_LDA(dst, b, h) do { _Pragma("unroll") for (int m = 0; m < 4; ++m) _Pragma("unroll") for (int k = 0; k < 2; ++k) dst[m][k] = *(const LAS bf16x8*)(lds + PG8_SA(b, h) + aoff + m * 2048 + k * 1024); } while (0)
#define PG8_LDB(dst, b, h) do { _Pragma("unroll") for (int n = 0; n < 2; ++n) _Pragma("unroll") for (int k = 0; k < 2; ++k) dst[n][k] = *(const LAS bf16x8*)(lds + PG8_SB(b, h) + boff + n * 2048 + k * 1024); } while (0)
#define PG8_MMA(ai, bj, At, Bt) do { __builtin_amdgcn_s_setprio(1); _Pragma("unroll") for (int m = 0; m < 4; ++m) _Pragma("unroll") for (int n = 0; n < 2; ++n) _Pragma("unroll") for (int k = 0; k < 2; ++k) \
        acc[ai][bj][m][n] = __builtin_amdgcn_mfma_f32_16x16x32_bf16(Bt[n][k], At[m][k], acc[ai][bj][m][n], 0, 0, 0); __builtin_amdgcn_s_setprio(0); } while (0)
#define PG8_WAIT_V(n) asm volatile("s_waitcnt vmcnt(" #n ")" ::: "memory")
#define PG8_WAIT_L(n) asm volatile("s_waitcnt lgkmcnt(" #n ")" ::: "memory")
#define PG8_BAR __builtin_amdgcn_s_barrier()
#define PG8_SCHED __builtin_amdgcn_sched_barrier(0)
    Unit cur, nxt; int ui = 0;
    if (!S.next(0, cur)) return;
    f32x4 acc[2][2][4][2];
#pragma unroll
    for (int a = 0; a < 2; ++a)
#pragma unroll
        for (int b = 0; b < 2; ++b)
#pragma unroll
            for (int m = 0; m < 4; ++m)
#pragma unroll
                for (int n = 0; n < 2; ++n) acc[a][b][m][n] = (f32x4){0.f, 0.f, 0.f, 0.f};
    bf16x8 At[4][2], B0[2][2], B1[2][2];
    const char* cA = S.a(cur); const char* cB = S.b(cur);
    PG8_STAGE(PG8_SB(0, 0), cB, voffB); PG8_STAGE(PG8_SB(0, 1), cB + hstepB, voffB); PG8_STAGE(PG8_SA(0, 0), cA, voffA); PG8_STAGE(PG8_SA(0, 1), cA + hstepA, voffA);
    if (wr == 1) PG8_BAR;
    PG8_WAIT_V(2); PG8_BAR;
    PG8_STAGE(PG8_SB(1, 0), cB + kstep, voffB); PG8_STAGE(PG8_SA(1, 0), cA + kstep, voffA); PG8_STAGE(PG8_SB(1, 1), cB + hstepB + kstep, voffB);
    PG8_WAIT_V(6); PG8_BAR;
    for (;;) {
        const bool has_next = S.next(ui + 1, nxt);
        const int nt = S.nt(cur);
        const char* nA = has_next ? S.a(nxt) : cA; const char* nB = has_next ? S.b(nxt) : cB;
#pragma unroll 1
        for (int t = 0; t < nt; t += 2) {
            const bool last = (t == nt - 2);
            const char* a1 = cA + (size_t)(t + 1) * kstep;
            const char* a2 = last ? nA : cA + (size_t)(t + 2) * kstep; const char* b2 = last ? nB : cB + (size_t)(t + 2) * kstep;
            const char* a3 = a2 + kstep; const char* b3 = b2 + kstep;
            PG8_LDB(B0, 0, 0); PG8_LDB(B1, 0, 1); PG8_SCHED; PG8_LDA(At, 0, 0); PG8_STAGE(PG8_SA(1, 1), a1 + hstepA, voffA);
            PG8_WAIT_V(8); PG8_WAIT_L(0); PG8_BAR; PG8_MMA(0, 0, At, B0); PG8_MMA(0, 1, At, B1); PG8_BAR; PG8_SCHED;
            PG8_LDA(At, 0, 1); PG8_STAGE(PG8_SB(0, 0), b2, voffB); PG8_STAGE(PG8_SB(0, 1), b2 + hstepB, voffB); PG8_STAGE(PG8_SA(0, 0), a2, voffA);
            PG8_WAIT_V(8); PG8_WAIT_L(0); PG8_BAR; PG8_MMA(1, 0, At, B0); PG8_MMA(1, 1, At, B1); PG8_BAR; PG8_SCHED;
            PG8_LDB(B0, 1, 0); PG8_LDB(B1, 1, 1); PG8_SCHED; PG8_LDA(At, 1, 0); PG8_STAGE(PG8_SA(0, 1), a2 + hstepA, voffA);
            PG8_WAIT_V(8); PG8_WAIT_L(0); PG8_BAR; PG8_MMA(0, 0, At, B0); PG8_MMA(0, 1, At, B1); PG8_BAR; PG8_SCHED;
            PG8_LDA(At, 1, 1); PG8_STAGE(PG8_SB(1, 0), b3, voffB); PG8_STAGE(PG8_SB(1, 1), b3 + hstepB, voffB); PG8_STAGE(PG8_SA(1, 0), a3, voffA);
            PG8_WAIT_V(8); PG8_WAIT_L(0); PG8_BAR; PG8_MMA(1, 0, At, B0); PG8_MMA(1, 1, At, B1); PG8_BAR; PG8_SCHED;
        }
        if constexpr (ALIGN_EPI) { if (wr == 0) PG8_BAR; }
        E(acc, cur, S, wr, wc, fr, fq);
        if (!has_next) break;
#pragma unroll
        for (int a = 0; a < 2; ++a)
#pragma unroll
            for (int b = 0; b < 2; ++b)
#pragma unroll
                for (int m = 0; m < 4; ++m)
#pragma unroll
                    for (int n = 0; n < 2; ++n) acc[a][b][m][n] = (f32x4){0.f, 0.f, 0.f, 0.f};
        cur = nxt; cA = nA; cB = nB; ++ui;
        if constexpr (ALIGN_EPI) { if (wr == 1) PG8_BAR; }
    }
    PG8_WAIT_V(0);
    if constexpr (!ALIGN_EPI) { if (wr == 0) PG8_BAR; }
    PG8_BAR;
#undef PG8_SA
#undef PG8_SB
#undef PG8_STAGE
#undef PG8_LDA
#undef PG8_LDB
#undef PG8_MMA
#undef PG8_WAIT_V
#undef PG8_WAIT_L
#undef PG8_BAR
#undef PG8_SCHED
}
}

#define XB_TMO      128
#define XB_XCNT(j)  (256  + 64 * (j))
#define XB_XSUB(j)  (1280 + 64 * (j))
#define XB_XGEN(j)  (2304 + 64 * (j))
#define XB_TOP      3328
#define XB_TOPGEN   3392
#define XCD_BAR_WORDS 3456
#define XB_SPIN_CAP (1u << 18)
__device__ __forceinline__ unsigned xb_ld(unsigned* p)              { return __hip_atomic_load(p, __ATOMIC_RELAXED, __HIP_MEMORY_SCOPE_AGENT); }
__device__ __forceinline__ unsigned xb_add(unsigned* p, unsigned v) { return __hip_atomic_fetch_add(p, v, __ATOMIC_RELAXED, __HIP_MEMORY_SCOPE_AGENT); }
__device__ __forceinline__ unsigned xb_xcc_id() { return (unsigned)__builtin_amdgcn_s_getreg((3 << 11) | 20) & 0xFu; }
#define XB_SPIN(cond, bar) do { unsigned _sp = 0; while (cond) { __builtin_amdgcn_s_sleep(1); \
    if ((++_sp & 255u) == 0u) { if (xb_ld(&(bar)[XB_TMO])) break; if (_sp > XB_SPIN_CAP) { atomicAdd(&(bar)[XB_TMO], 1u); break; } } } } while (0)
struct XcdBarrier { unsigned* bar; unsigned x; volatile LAS unsigned* st; };
__device__ __forceinline__ XcdBarrier xcd_barrier_post(unsigned* bar, volatile LAS unsigned* st) {
    XcdBarrier b; b.bar = bar; b.x = xb_xcc_id(); b.st = st;
    if (threadIdx.x == 0) (void)xb_add(&bar[XB_XCNT(b.x)], 1u);
    return b;
}
__device__ __forceinline__ void xcd_barrier_complete(unsigned* bar, unsigned x, unsigned& nloc, unsigned& nx) {
    const unsigned G = gridDim.x * gridDim.y * gridDim.z;
    unsigned sum, cnt, mine, sp = 0u;
    for (;;) {
        sum = 0u; cnt = 0u; mine = 0u;
#pragma unroll
        for (unsigned j = 0; j < 16; ++j) { const unsigned c = xb_ld(&bar[XB_XCNT(j)]); sum += c; cnt += (c > 0u) ? 1u : 0u; mine = (j == x) ? c : mine; }
        if (sum == G) break;
        __builtin_amdgcn_s_sleep(1);
        if ((++sp & 255u) == 0u) { if (xb_ld(&bar[XB_TMO])) break; if (sp > XB_SPIN_CAP) { atomicAdd(&bar[XB_TMO], 1u); break; } }
    }
    nloc = mine > 0u ? mine : 1u; nx = cnt > 0u ? cnt : 1u;
}
__device__ __forceinline__ void xcd_barrier(const XcdBarrier& b, const bool leader  ) {
    asm volatile("s_waitcnt vmcnt(0)" ::: "memory");
    __syncthreads();
    if (leader) {
        unsigned* bar = b.bar;
        __builtin_amdgcn_s_waitcnt(0);
        unsigned nloc = b.st[0], nx = b.st[1];
        if (nloc == 0u) { xcd_barrier_complete(bar, b.x, nloc, nx); b.st[0] = nloc; b.st[1] = nx; }
        const unsigned old = xb_add(&bar[XB_XSUB(b.x)], 1u);
        const unsigned gen = old / nloc;
        if (old + 1u == (gen + 1u) * nloc) {
            __builtin_amdgcn_fence(__ATOMIC_RELEASE, "agent");
            asm volatile("s_waitcnt vmcnt(0)" ::: "memory");
            const unsigned og = xb_add(&bar[XB_TOP], 1u);
            const unsigned tg = og / nx;
            if (og + 1u == (tg + 1u) * nx) xb_add(&bar[XB_TOPGEN], 1u);
            else XB_SPIN(xb_ld(&bar[XB_TOPGEN]) == tg, bar);
            __builtin_amdgcn_fence(__ATOMIC_ACQUIRE, "agent");
            xb_add(&bar[XB_XGEN(b.x)], 1u);
            asm volatile("s_waitcnt vmcnt(0)" ::: "memory");
        } else {
            XB_SPIN(xb_ld(&bar[XB_XGEN(b.x)]) == gen, bar);
            __builtin_amdgcn_fence(__ATOMIC_ACQUIRE, "agent");
            asm volatile("s_waitcnt vmcnt(0)" ::: "memory");
        }
    }
    __syncthreads();
}

struct Args { const float* in[22]; float* out; unsigned char* ws; int ph_lo, ph_hi; };
struct Frame {
    LAS unsigned char* lds;
    int tid, lane, wave, G;
    const float* const* in;
    float* out; unsigned char* ws;
};
enum { I_X = 0, I_C, I_CTX, I_CCTX, I_WMOD, I_BMOD, I_NMIX, I_NFFN, I_FOURW, I_WIN, I_CONVW, I_CONVB, I_DTB, I_ALOG, I_DSK, I_SNG, I_WOUT, I_WUP, I_FCW, I_FCB, I_WDN, I_FING };

__device__ __forceinline__ void fresh_ids(Frame& F) { F.lane = fresh_lane(); F.tid = F.wave * 64 + F.lane; }

template <int K_> struct SchedAB {
    unsigned char* ws; size_t aoff, boff; int has_ctx;
    static constexpr int KT = K_ / 64;
    __device__ __forceinline__ bool next(int i, pg8::Unit& u) const {
        const int L = i * (int)gridDim.x + (int)blockIdx.x;
        if (L < 512) { pg8::tile_of_id<8>(L, 64, u.pm, u.pn); u.kq = -1; return true; }
        if (!has_ctx || L >= 768) return false;
        const int c2 = L - 512, ct = c2 >> 2; u.kq = c2 & 3; u.pm = 64 + (ct >> 3); u.pn = ct & 7; return true; }
    __device__ __forceinline__ int nt(const pg8::Unit& u) const { return u.kq < 0 ? KT : KT / 4; }
    __device__ __forceinline__ void out(const pg8::Unit& u, char*& o, int& ldo, int& kind) const { ldo = D;
        if (u.kq < 0) { o = (char*)ws + WS_Y + ((size_t)u.pm * 256 * D + (size_t)u.pn * 256) * 2; kind = 0; }
        else { o = (char*)ws + WS_PART + (((size_t)u.kq * MCTX + (size_t)(u.pm - 64) * 256) * D + (size_t)u.pn * 256) * 4; kind = 2; } }
    __device__ __forceinline__ const char* a(const pg8::Unit& u) const { return (const char*)ws + aoff + (size_t)u.pm * 256 * K_ * 2 + (u.kq < 0 ? 0 : u.kq * (K_ / 4) * 2); }
    __device__ __forceinline__ const char* b(const pg8::Unit& u) const { return (const char*)ws + boff + (size_t)u.pn * 256 * K_ * 2 + (u.kq < 0 ? 0 : u.kq * (K_ / 4) * 2); }
};
struct SchedUp {
    unsigned char* ws; size_t boff; int nM;
    __device__ __forceinline__ int nt(const pg8::Unit&) const { return D / 64; }
    __device__ __forceinline__ bool next(int i, pg8::Unit& u) const { return pg8::tile2d<44>(i, nM, u); }
    __device__ __forceinline__ const char* a(const pg8::Unit& u) const { return (const char*)ws + WS_A + (size_t)u.pm * 256 * D * 2; }
    __device__ __forceinline__ const char* b(const pg8::Unit& u) const { return (const char*)ws + boff + (size_t)u.pn * 256 * D * 2; }
    __device__ __forceinline__ void out(const pg8::Unit& u, char*& o, int& ldo, int& kind) const {
        o = (char*)ws + (u.pn < 22 ? WS_GATE + (size_t)u.pn * 512 : WS_VAL + (size_t)(u.pn - 22) * 512) + (size_t)u.pm * 256 * DFF * 2; ldo = DFF; kind = 0; }
};
struct SchedIn {
    unsigned char* ws; size_t boff; int last;
    __device__ __forceinline__ int nt(const pg8::Unit&) const { return D / 64; }
    __device__ __forceinline__ bool next(int i, pg8::Unit& u) const {
        const int L = i * (int)gridDim.x + (int)blockIdx.x; u.kq = -1;
        if (L < 64 * 41) { pg8::tile_of_id<41>(L, 64, u.pm, u.pn); return true; }
        const int c2 = L - 64 * 41, nct = last ? 21 : 41; if (c2 >= 8 * nct) return false;
        u.pm = 64 + (c2 & 7); const int t = c2 >> 3; u.pn = (last && t >= 20) ? 40 : t; return true; }
    __device__ __forceinline__ const char* a(const pg8::Unit& u) const { return (const char*)ws + WS_A + (size_t)u.pm * 256 * D * 2; }
    __device__ __forceinline__ const char* b(const pg8::Unit& u) const { return (const char*)ws + boff + (size_t)u.pn * 256 * D * 2; }
    __device__ __forceinline__ void out(const pg8::Unit& u, char*& o, int& ldo, int& kind) const {
        if (u.pn < 24) { o = (char*)ws + WS_XBCP + ((size_t)u.pm * 256 * XBC + (size_t)u.pn * 256) * 2; ldo = XBC; kind = 0; }
        else if (u.pn < 40) { o = (char*)ws + WS_Z + ((size_t)u.pm * 256 * DI + (size_t)(u.pn - 24) * 256) * 2; ldo = DI; kind = 0; }
        else { o = (char*)ws + WS_DT + (size_t)u.pm * 256 * 128 * 4; ldo = 128; kind = 1; } }
};
struct SchedF1 {
    unsigned char* ws;
    __device__ __forceinline__ int nt(const pg8::Unit&) const { return 4; }
    __device__ __forceinline__ bool next(int i, pg8::Unit& u) const { return pg8::tile2d<72>(i, 16, u); }
    __device__ __forceinline__ const char* a(const pg8::Unit& u) const { return (const char*)ws + WS_W1 + (size_t)(u.pm & 1) * 256 * 256 * 2; }
    __device__ __forceinline__ const char* b(const pg8::Unit& u) const { return (const char*)ws + WS_A + ((size_t)u.pn * 256 * D + (size_t)(u.pm >> 1) * 256) * 2; }
    __device__ __forceinline__ void out(const pg8::Unit& u, char*& o, int& ldo, int& kind) const { const int g = u.pm >> 1, cs = u.pm & 1;
        if (u.pn < 64) { const int b = u.pn >> 3, p0 = (u.pn & 7) * 256; o = (char*)ws + WS_PQT + (((size_t)(b * 2048 + g * 256)) * 4096 + (size_t)cs * 2048 + p0) * 2; ldo = 4096; }
        else { const int b = u.pn - 64; o = (char*)ws + WS_PQTC + (((size_t)(b * 2048 + g * 256)) * 512 + (size_t)cs * 256) * 2; ldo = 512; }
        kind = 0; }
};
struct SchedF2 {
    unsigned char* ws;
    __device__ __forceinline__ int total() const { return 576; }
    __device__ __forceinline__ int nt(const pg8::Unit&) const { return 8; }
    __device__ __forceinline__ bool next(int i, pg8::Unit& u) const {
        const int L = i * (int)gridDim.x + (int)blockIdx.x; u.kq = -1;
        if (L < 512) { pg8::tile_of_id<8>(L, 64, u.pm, u.pn); return true; }
        if (L >= 576) return false;
        u.pm = 64 + ((L - 512) & 7); u.pn = (L - 512) >> 3; return true; }
    __device__ __forceinline__ const char* a(const pg8::Unit& u) const { return (const char*)ws + (u.pm < 64 ? WS_W2 : WS_W2C); }
    __device__ __forceinline__ const char* b(const pg8::Unit& u) const { return u.pm < 64 ? (const char*)ws + WS_VT + ((size_t)u.pm * 2048 + (size_t)u.pn * 256) * 512 * 2
                                                                                           : (const char*)ws + WS_PQTC + ((size_t)((u.pm - 64) * 2048 + u.pn * 256)) * 512 * 2; }
    __device__ __forceinline__ void out(const pg8::Unit& u, char*& o, int& ldo, int& kind) const { kind = 0;
        if (u.pm < 64) { o = (char*)ws + WS_F + (((size_t)((u.pm >> 3) * 2048 + (u.pm & 7))) * D + (size_t)u.pn * 256) * 2; ldo = 8 * D; }
        else { o = (char*)ws + WS_F + (((size_t)(MLAT + (u.pm - 64) * 256)) * D + (size_t)u.pn * 256) * 2; ldo = D; } }
};

__device__ __forceinline__ void p0_transpose_item(const float* W, int K, int N, bf16_t* WT, int k0, int n0, int drow0, LAS float* scr, int lane) {
    const int kk = lane >> 3, nq = (lane & 7) * 4;
    f32x4 v[8];
#pragma unroll
    for (int i = 0; i < 8; ++i) v[i] = *(const f32x4*)(W + (size_t)(k0 + 8 * i + kk) * N + n0 + nq);
#pragma unroll
    for (int i = 0; i < 8; ++i) { LAS float* d = scr + (8 * i + kk) * 33 + nq; d[0] = v[i].x; d[1] = v[i].y; d[2] = v[i].z; d[3] = v[i].w; }
    LDS_WAIT(); asm volatile("" ::: "memory");
    const int c = lane & 7;
#pragma unroll
    for (int j = 0; j < 4; ++j) { const int n = (lane >> 3) + 8 * j; const LAS float* s = scr + (8 * c) * 33 + n;
        u32x4 o; o.x = cvt_pk_bf16(s[0 * 33], s[1 * 33]); o.y = cvt_pk_bf16(s[2 * 33], s[3 * 33]); o.z = cvt_pk_bf16(s[4 * 33], s[5 * 33]); o.w = cvt_pk_bf16(s[6 * 33], s[7 * 33]);
        *(u32x4*)(WT + (size_t)(drow0 + n) * K + k0 + 8 * c) = o; }
    LDS_WAIT(); asm volatile("" ::: "memory");
}
__device__ __forceinline__ int win_dst_row(int n0) { return n0 < 5120 ? n0 : (n0 < 5248 ? 10240 + (n0 - 5120) : n0 - 128); }

__device__ __forceinline__ void p0_prologue(Frame& F) {
    fresh_ids(F);
    LAS float* scr = (LAS float*)(F.lds + F.wave * 16384);
    const int gw = blockIdx.x * NWAVES + F.wave, NGW = F.G * NWAVES, lane = F.lane;
    unsigned char* ws = F.ws;
    {
        constexpr int NCG = MODW / 256, NKS = 8, NIT = DEPTH * NCG * NKS;
        const float* c = F.in[I_C]; const float* cc = F.in[I_CCTX]; const float* wm = F.in[I_WMOD];
        float* modp = (float*)(ws + WS_MODP);
        for (int it = gw; it < NIT; it += NGW) {
            const int ks = it % NKS, cg = (it / NKS) % NCG, L = it / (NKS * NCG), k0 = ks * 256;
            for (int e = lane; e < 9 * 256; e += 64) { const int k = e & 255, b = e >> 8; const float v = (b < 8) ? c[b * D + k0 + k] : cc[k0 + k]; scr[k * 12 + b] = silu_f(v); }
            LDS_WAIT(); asm volatile("" ::: "memory");
            f32x4 acc[9];
#pragma unroll
            for (int b = 0; b < 9; ++b) acc[b] = (f32x4){0.f, 0.f, 0.f, 0.f};
            const float* wp = wm + ((size_t)L * D + k0) * MODW + cg * 256 + lane * 4;
#pragma unroll 8
            for (int k = 0; k < 256; ++k) {
                const f32x4 wv = *(const f32x4*)(wp + (size_t)k * MODW);
                const f32x4 s0 = *(const LAS f32x4*)(scr + k * 12), s1 = *(const LAS f32x4*)(scr + k * 12 + 4); const float s2 = scr[k * 12 + 8];
                acc[0] += wv * s0[0]; acc[1] += wv * s0[1]; acc[2] += wv * s0[2]; acc[3] += wv * s0[3];
                acc[4] += wv * s1[0]; acc[5] += wv * s1[1]; acc[6] += wv * s1[2]; acc[7] += wv * s1[3]; acc[8] += wv * s2;
            }
#pragma unroll
            for (int b = 0; b < 9; ++b) *(f32x4*)(modp + (((size_t)ks * DEPTH + L) * 9 + b) * MODW + cg * 256 + lane * 4) = acc[b];
            LDS_WAIT(); asm volatile("" ::: "memory");
        }
    }
    {
        constexpr int I_F = (D / 64) * (D / 32);
        constexpr int I_I = (D / 64) * (INW / 32);
        constexpr int I_O = (DI / 64) * (D / 32);
        constexpr int I_U = (D / 64) * (2 * DFF / 32);
        constexpr int I_D = (DFF / 64) * (D / 32);
        constexpr int NIT = 2 * I_F + 2 * I_I + 2 * I_O + 4 * I_U + 4 * I_D;
        for (int it = gw; it < NIT; it += NGW) {
            int r = it;
            if (r < 2 * I_F) { const int j = r / I_F; r -= j * I_F; const int nblk = D / 32, kb = r / nblk, nb = r % nblk;
                p0_transpose_item(F.in[I_FOURW] + (size_t)j * D * D, D, D, (bf16_t*)(ws + WS_WFOUR) + (size_t)j * D * D, 64 * kb, 32 * nb, 32 * nb, scr, lane); continue; } r -= 2 * I_F;
            if (r < 2 * I_I) { const int j = r / I_I; r -= j * I_I; const int nblk = INW / 32, kb = r / nblk, nb = r % nblk;
                p0_transpose_item(F.in[I_WIN] + (size_t)j * D * INW, D, INW, (bf16_t*)(ws + WS_WIN) + (size_t)j * INP * D, 64 * kb, 32 * nb, win_dst_row(32 * nb), scr, lane); continue; } r -= 2 * I_I;
            if (r < 2 * I_O) { const int j = r / I_O; r -= j * I_O; const int nblk = D / 32, kb = r / nblk, nb = r % nblk;
                p0_transpose_item(F.in[I_WOUT] + (size_t)j * DI * D, DI, D, (bf16_t*)(ws + WS_WOUT) + (size_t)j * D * DI, 64 * kb, 32 * nb, 32 * nb, scr, lane); continue; } r -= 2 * I_O;
            if (r < 4 * I_U) { const int j = r / I_U; r -= j * I_U; const int nblk = 2 * DFF / 32, kb = r / nblk, nb = r % nblk;
                p0_transpose_item(F.in[I_WUP] + (size_t)j * D * 2 * DFF, D, 2 * DFF, (bf16_t*)(ws + WS_WUP) + (size_t)j * 2 * DFF * D, 64 * kb, 32 * nb, 32 * nb, scr, lane); continue; } r -= 4 * I_U;
            { const int j = r / I_D; r -= j * I_D; const int nblk = D / 32, kb = r / nblk, nb = r % nblk;
                p0_transpose_item(F.in[I_WDN] + (size_t)j * DFF * D, DFF, D, (bf16_t*)(ws + WS_WDN) + (size_t)j * D * DFF, 64 * kb, 32 * nb, 32 * nb, scr, lane); }
        }
    }
    const size_t gt = (size_t)blockIdx.x * 512 + F.tid, NT = (size_t)F.G * 512;
    for (size_t i = gt; i < (size_t)2 * 128 * D / 8; i += NT) { const size_t j = i / (128 * D / 8), e = i % (128 * D / 8);
        *(u32x4*)((bf16_t*)(ws + WS_WIN) + ((size_t)j * INP + INW) * D + e * 8) = (u32x4){0u, 0u, 0u, 0u}; }
    {
        bf16_t* W1 = (bf16_t*)(ws + WS_W1);
        for (size_t i = gt; i < (size_t)512 * 256 / 2; i += NT) { const int m = (int)(i / 128), c0 = (int)(i % 128) * 2; float v[2];
#pragma unroll
            for (int e = 0; e < 2; ++e) { const int idx = ((m & 255) * (c0 + e)) & 255; const float a = (float)idx * (1.0f / 128.0f); v[e] = (m < 256) ? cospif(a) : sinpif(a); }
            *(unsigned*)(W1 + (size_t)m * 256 + c0) = cvt_pk_bf16(v[0], v[1]); }
        bf16_t* W2c = (bf16_t*)(ws + WS_W2C);
        for (size_t i = gt; i < (size_t)256 * 512 / 2; i += NT) { const int k1 = (int)(i / 256), c0 = (int)(i % 256) * 2; float v[2];
#pragma unroll
            for (int e = 0; e < 2; ++e) { const int cc = c0 + e, l = cc & 255; const int idx = (k1 * l) & 255; const float a = (float)idx * (1.0f / 128.0f); v[e] = ((cc < 256) ? cospif(a) : -sinpif(a)) * (1.0f / 256.0f); }
            *(unsigned*)(W2c + (size_t)k1 * 512 + c0) = cvt_pk_bf16(v[0], v[1]); }
        bf16_t* W2 = (bf16_t*)(ws + WS_W2); const float sc = 0.0013810679320049757f;
        for (size_t i = gt; i < (size_t)256 * 512 / 2; i += NT) { const int k2 = (int)(i / 256), c0 = (int)(i % 256) * 2; float v[2];
#pragma unroll
            for (int e = 0; e < 2; ++e) { const int cc = c0 + e, l = cc & 255; const int idx = (k2 * l) & 255; const float a = (float)idx * (1.0f / 128.0f); v[e] = ((cc < 256) ? cospif(a) : sinpif(a)) * sc; }
            *(unsigned*)(W2 + (size_t)k2 * 512 + c0) = cvt_pk_bf16(v[0], v[1]); }
    }
}
__device__ __forceinline__ void p0b_modreduce(Frame& F) {
    fresh_ids(F);
    const size_t gt = (size_t)blockIdx.x * 512 + F.tid, NT = (size_t)F.G * 512;
    const float* modp = (const float*)(F.ws + WS_MODP); float* mod = (float*)(F.ws + WS_MOD); const float* bm = F.in[I_BMOD];
    constexpr size_t PER = (size_t)DEPTH * 9 * MODW;
    for (size_t i = gt; i < PER / 4; i += NT) { const size_t e = i * 4; const int n = (int)(e % MODW), L = (int)(e / ((size_t)9 * MODW));
        f32x4 s = *(const f32x4*)(bm + (size_t)L * MODW + n);
#pragma unroll
        for (int ks = 0; ks < 8; ++ks) s += *(const f32x4*)(modp + (size_t)ks * PER + e);
        *(f32x4*)(mod + e) = s; }
}

__device__ __forceinline__ void norm_mod_phase(Frame& F, int L, const float* gvec, int sh_chunk, int nrows, const float* pg, const float* xlat, const float* xctx) {
    fresh_ids(F);
    const int gw = blockIdx.x * NWAVES + F.wave, NGW = F.G * NWAVES, lane = F.lane;
    const float* mod = (const float*)(F.ws + WS_MOD) + (size_t)L * 9 * MODW; bf16_t* A = (bf16_t*)(F.ws + WS_A);
    for (int r = gw; r < nrows; r += NGW) {
        const int bidx = r < MLAT ? (r >> 11) : 8;
        const f32x4* xr = (const f32x4*)(r < MLAT ? xlat + (size_t)r * D : xctx + (size_t)(r - MLAT) * D) + lane;
        f32x4 v[8]; float ss = 0.f;
#pragma unroll
        for (int j = 0; j < 8; ++j) v[j] = xr[64 * j];
        if (pg != nullptr && r < MLAT) {
            const u32x2* yp = (const u32x2*)((const bf16_t*)(F.ws + WS_Y) + (size_t)r * D) + lane; const f32x4* gq = (const f32x4*)(pg + (size_t)bidx * MODW) + lane; f32x4* xw_ = (f32x4*)(F.out + (size_t)r * D) + lane;
#pragma unroll
            for (int j = 0; j < 8; ++j) { const u32x2 yy = yp[64 * j]; const f32x4 y4 = {bf_lo(yy.x), bf_hi(yy.x), bf_lo(yy.y), bf_hi(yy.y)}; v[j] += gq[64 * j] * y4; xw_[64 * j] = v[j]; }
        }
        if (pg != nullptr && r >= MLAT) {
            const f32x4* pp = (const f32x4*)((const float*)(F.ws + WS_PART) + (size_t)(r - MLAT) * D) + lane; const f32x4* gq = (const f32x4*)(pg + (size_t)8 * MODW) + lane; f32x4* xw_ = (f32x4*)((float*)(F.ws + WS_XC) + (size_t)(r - MLAT) * D) + lane;
#pragma unroll
            for (int j = 0; j < 8; ++j) { const f32x4 p = (pp[64 * j] + pp[64 * j + (size_t)MCTX * D / 4]) + (pp[64 * j + (size_t)2 * MCTX * D / 4] + pp[64 * j + (size_t)3 * MCTX * D / 4]); v[j] += gq[64 * j] * p; xw_[64 * j] = v[j]; }
        }
#pragma unroll
        for (int j = 0; j < 8; ++j) ss += (v[j].x * v[j].x + v[j].y * v[j].y) + (v[j].z * v[j].z + v[j].w * v[j].w);
        const float rstd = rsqrtf(wave_sum(ss, lane) * (1.0f / D) + EPS);
        const f32x4* gp = (const f32x4*)gvec + lane; const f32x4* shp = (const f32x4*)(mod + (size_t)bidx * MODW + sh_chunk * D) + lane; const f32x4* scp = shp + D / 4;
        u32x2* o = (u32x2*)(A + (size_t)r * D) + lane;
#pragma unroll
        for (int j = 0; j < 8; ++j) { const f32x4 g = gp[64 * j], sh = shp[64 * j], sc = scp[64 * j]; const f32x4 y = v[j] * rstd * g * (sc + 1.0f) + sh;
            u32x2 w; w.x = cvt_pk_bf16(y.x, y.y); w.y = cvt_pk_bf16(y.z, y.w); o[64 * j] = w; }
    }
}
__device__ __forceinline__ void final_norm_phase(Frame& F) {
    fresh_ids(F);
    const int gw = blockIdx.x * NWAVES + F.wave, NGW = F.G * NWAVES, lane = F.lane;
    const f32x4* gp = (const f32x4*)F.in[I_FING] + lane;
    for (int r = gw; r < MLAT; r += NGW) {
        f32x4* xr = (f32x4*)(F.out + (size_t)r * D) + lane;
        const u32x2* yp = (const u32x2*)((const bf16_t*)(F.ws + WS_Y) + (size_t)r * D) + lane; const f32x4* gq = (const f32x4*)((const float*)(F.ws + WS_MOD) + ((size_t)(DEPTH - 1) * 9 + (r >> 11)) * MODW + 5 * D) + lane;
        f32x4 v[8]; float ss = 0.f;
#pragma unroll
        for (int j = 0; j < 8; ++j) { const u32x2 yy = yp[64 * j]; const f32x4 y4 = {bf_lo(yy.x), bf_hi(yy.x), bf_lo(yy.y), bf_hi(yy.y)}; v[j] = xr[64 * j] + gq[64 * j] * y4;
            ss += (v[j].x * v[j].x + v[j].y * v[j].y) + (v[j].z * v[j].z + v[j].w * v[j].w); }
        const float rstd = rsqrtf(wave_sum(ss, lane) * (1.0f / D) + EPS);
#pragma unroll
        for (int j = 0; j < 8; ++j) xr[64 * j] = v[j] * rstd * gp[64 * j];
    }
}

__device__ __forceinline__ void unpack8(const u32x4 w, float (&f)[8]) {
    f[0] = bf_lo(w.x); f[1] = bf_hi(w.x); f[2] = bf_lo(w.y); f[3] = bf_hi(w.y); f[4] = bf_lo(w.z); f[5] = bf_hi(w.z); f[6] = bf_lo(w.w); f[7] = bf_hi(w.w);
}
__device__ __forceinline__ u32x4 pack8(const float (&f)[8]) { u32x4 w; w.x = cvt_pk_bf16(f[0], f[1]); w.y = cvt_pk_bf16(f[2], f[3]); w.z = cvt_pk_bf16(f[4], f[5]); w.w = cvt_pk_bf16(f[6], f[7]); return w; }

__device__ __forceinline__ void fft8_phase(Frame& F) {
    fresh_ids(F);
    const int gw = blockIdx.x * NWAVES + F.wave, NGW = F.G * NWAVES, lane = F.lane;
    const bf16_t* pqt = (const bf16_t*)(F.ws + WS_PQT); bf16_t* vt = (bf16_t*)(F.ws + WS_VT);
    float twc[8][4], tws[8][4];
#pragma unroll
    for (int k1 = 0; k1 < 8; ++k1)
#pragma unroll
        for (int e = 0; e < 4; ++e) { const int idx = (4 * lane + e) * k1; const float a = (float)idx * (1.0f / 1024.0f); twc[k1][e] = cospif(a); tws[k1][e] = sinpif(a); }
    constexpr float R2 = 0.70710678118654752f;
    for (int row = gw; row < NB * D; row += NGW) {
        const bf16_t* src = pqt + (size_t)row * 4096 + 4 * lane;
        u32x2 rp[8], rq[8];
#pragma unroll
        for (int l1 = 0; l1 < 8; ++l1) { rp[l1] = *(const u32x2*)(src + 256 * l1); rq[l1] = *(const u32x2*)(src + 2048 + 256 * l1); }
        const int b = row >> 11, n = row & 2047;
        bf16_t* dst = vt + (((size_t)b * 8) * 2048 + n) * 512 + 4 * lane;
        float vr[8][4], vi[8][4];
#pragma unroll
        for (int e = 0; e < 4; ++e) {
            float xr[8], xi[8];
#pragma unroll
            for (int l1 = 0; l1 < 8; ++l1) { const unsigned wp = (e < 2) ? rp[l1].x : rp[l1].y, wq = (e < 2) ? rq[l1].x : rq[l1].y; xr[l1] = (e & 1) ? bf_hi(wp) : bf_lo(wp); xi[l1] = -((e & 1) ? bf_hi(wq) : bf_lo(wq)); }
            const float a0r = xr[0] + xr[4], a0i = xi[0] + xi[4], a1r = xr[0] - xr[4], a1i = xi[0] - xi[4], a2r = xr[2] + xr[6], a2i = xi[2] + xi[6], a3r = xr[2] - xr[6], a3i = xi[2] - xi[6];
            const float a4r = xr[1] + xr[5], a4i = xi[1] + xi[5], a5r = xr[1] - xr[5], a5i = xi[1] - xi[5], a6r = xr[3] + xr[7], a6i = xi[3] + xi[7], a7r = xr[3] - xr[7], a7i = xi[3] - xi[7];
            const float b0r = a0r + a2r, b0i = a0i + a2i, b2r = a0r - a2r, b2i = a0i - a2i, b1r = a1r + a3i, b1i = a1i - a3r, b3r = a1r - a3i, b3i = a1i + a3r;
            const float c0r = a4r + a6r, c0i = a4i + a6i, c2r = a4r - a6r, c2i = a4i - a6i, c1r = a5r + a7i, c1i = a5i - a7r, c3r = a5r - a7i, c3i = a5i + a7r;
            const float d1r = (c1r + c1i) * R2, d1i = (c1i - c1r) * R2, d2r = c2i, d2i = -c2r, d3r = (c3i - c3r) * R2, d3i = -(c3r + c3i) * R2;
            float yr[8], yi[8];
            yr[0] = b0r + c0r; yi[0] = b0i + c0i; yr[4] = b0r - c0r; yi[4] = b0i - c0i;
            yr[1] = b1r + d1r; yi[1] = b1i + d1i; yr[5] = b1r - d1r; yi[5] = b1i - d1i;
            yr[2] = b2r + d2r; yi[2] = b2i + d2i; yr[6] = b2r - d2r; yi[6] = b2i - d2i;
            yr[3] = b3r + d3r; yi[3] = b3i + d3i; yr[7] = b3r - d3r; yi[7] = b3i - d3i;
#pragma unroll
            for (int k1 = 0; k1 < 8; ++k1) { const float c = twc[k1][e], sn = tws[k1][e]; vr[k1][e] = yr[k1] * c + yi[k1] * sn; vi[k1][e] = yi[k1] * c - yr[k1] * sn; }
        }
#pragma unroll
        for (int k1 = 0; k1 < 8; ++k1) { u32x2 o; o.x = cvt_pk_bf16(vr[k1][0], vr[k1][1]); o.y = cvt_pk_bf16(vr[k1][2], vr[k1][3]); *(u32x2*)(dst + (size_t)k1 * 2048 * 512) = o;
            u32x2 p; p.x = cvt_pk_bf16(vi[k1][0], vi[k1][1]); p.y = cvt_pk_bf16(vi[k1][2], vi[k1][3]); *(u32x2*)(dst + (size_t)k1 * 2048 * 512 + 256) = p; }
    }
}

__device__ __forceinline__ void ssd_conv_phase(Frame& F, int j, bool skip_ctx_c) {
    fresh_ids(F);
    const int gw = blockIdx.x * NWAVES + F.wave, NGW = F.G * NWAVES, lane = F.lane, cq = lane & 7, tq = lane >> 3;
    const bf16_t* pre = (const bf16_t*)(F.ws + WS_XBCP);
    const float* cw = F.in[I_CONVW] + (size_t)j * 3 * XBC; const float* cb_ = F.in[I_CONVB] + (size_t)j * XBC;
    bf16_t* xst = (bf16_t*)(F.ws + WS_XST); bf16_t* bm = (bf16_t*)(F.ws + WS_BM); bf16_t* bmt = (bf16_t*)(F.ws + WS_BMT); bf16_t* cm = (bf16_t*)(F.ws + WS_CM);
    constexpr int NTB = MALL / 64, NCB = XBC / 64;
    for (int job = gw; job < NTB * NCB; job += NGW) {
        const int cb = job % NCB, tb = job / NCB;
        const int rb = tb * 64;
        if (skip_ctx_c && rb >= MLAT && cb >= 80) continue;
        int seq0, T, sb;
        if (rb < MLAT) { sb = rb >> 11; seq0 = sb << 11; T = LSEQ; } else { sb = (rb - MLAT) >> 8; seq0 = MLAT + (sb << 8); T = LCTX; }
        const int tl = rb - seq0 + tq * 8;
        const int c0 = cb * 64 + cq * 8;
        float w0[8], w1[8], w2[8], bi[8];
        { const f32x4* p = (const f32x4*)(cw + c0); const f32x4 a = p[0], b = p[1]; w0[0] = a.x; w0[1] = a.y; w0[2] = a.z; w0[3] = a.w; w0[4] = b.x; w0[5] = b.y; w0[6] = b.z; w0[7] = b.w; }
        { const f32x4* p = (const f32x4*)(cw + XBC + c0); const f32x4 a = p[0], b = p[1]; w1[0] = a.x; w1[1] = a.y; w1[2] = a.z; w1[3] = a.w; w1[4] = b.x; w1[5] = b.y; w1[6] = b.z; w1[7] = b.w; }
        { const f32x4* p = (const f32x4*)(cw + 2 * XBC + c0); const f32x4 a = p[0], b = p[1]; w2[0] = a.x; w2[1] = a.y; w2[2] = a.z; w2[3] = a.w; w2[4] = b.x; w2[5] = b.y; w2[6] = b.z; w2[7] = b.w; }
        { const f32x4* p = (const f32x4*)(cb_ + c0); const f32x4 a = p[0], b = p[1]; bi[0] = a.x; bi[1] = a.y; bi[2] = a.z; bi[3] = a.w; bi[4] = b.x; bi[5] = b.y; bi[6] = b.z; bi[7] = b.w; }
        u32x4 raw[10];
#pragma unroll
        for (int i = 0; i < 10; ++i) { const int tt = tl - 1 + i; raw[i] = (tt >= 0 && tt < T) ? *(const u32x4*)(pre + (size_t)(seq0 + tt) * XBC + c0) : (u32x4){0u, 0u, 0u, 0u}; }
        float o[8][8];
        { float pa[8], pb[8], pc[8]; unpack8(raw[0], pa); unpack8(raw[1], pb);
#pragma unroll
          for (int i = 0; i < 8; ++i) { unpack8(raw[i + 2], pc);
#pragma unroll
              for (int c = 0; c < 8; ++c) o[i][c] = silu_f(bi[c] + w0[c] * pa[c] + w1[c] * pb[c] + w2[c] * pc[c]);
#pragma unroll
              for (int c = 0; c < 8; ++c) { pa[c] = pb[c]; pb[c] = pc[c]; } } }
        if (cb < 64) {
            bf16_t* dst = (rb < MLAT) ? xst + ((size_t)sb * DI + c0) * LSEQ + tl : xst + (size_t)NB * DI * LSEQ + ((size_t)sb * DI + c0) * LCTX + tl;
#pragma unroll
            for (int c = 0; c < 8; ++c) { float t8[8];
#pragma unroll
                for (int i = 0; i < 8; ++i) t8[i] = o[i][c];
                *(u32x4*)(dst + (size_t)c * T) = pack8(t8); }
        } else if (cb < 80) {
            const int cc = c0 - DI;
#pragma unroll
            for (int i = 0; i < 8; ++i) *(u32x4*)(bm + (size_t)(seq0 + tl + i) * GNW + cc) = pack8(o[i]);
            bf16_t* dst = (rb < MLAT) ? bmt + ((size_t)sb * GNW + cc) * LSEQ + tl : bmt + (size_t)NB * GNW * LSEQ + ((size_t)sb * GNW + cc) * LCTX + tl;
#pragma unroll
            for (int c = 0; c < 8; ++c) { float t8[8];
#pragma unroll
                for (int i = 0; i < 8; ++i) t8[i] = o[i][c];
                *(u32x4*)(dst + (size_t)c * T) = pack8(t8); }
        } else {
            const int cc = c0 - DI - GNW;
#pragma unroll
            for (int i = 0; i < 8; ++i) *(u32x4*)(cm + (size_t)(seq0 + tl + i) * GNW + cc) = pack8(o[i]);
        }
    }
}

__device__ __forceinline__ void ffn_conv_phase(Frame& F, int L, int nrows, bool probe_alt = false) {
    fresh_ids(F);
    const int gw = blockIdx.x * NWAVES + F.wave, NGW = F.G * NWAVES;
    const bf16_t* gate = (const bf16_t*)(F.ws + WS_GATE); bf16_t* val = (bf16_t*)(F.ws + WS_VAL);
    const float* cw = F.in[I_FCW] + (size_t)L * 9 * DFF; const float* cb_ = F.in[I_FCB] + (size_t)L * DFF;
    const int NTB = nrows / 64; constexpr int NCB = DFF / 64;
    for (int job = gw; job < NTB * NCB; job += NGW) {
        const int lane = fresh_lane(), cq = lane & 7, tq = lane >> 3;
        const int cb = job / NTB, tb = job % NTB;
        const int rb = tb * 64, c0 = cb * 64 + cq * 8;
        const bool lat = rb < MLAT;
        const int gr = lat ? (tb & 31) : 0, base = lat ? (rb - gr * 64) : (MLAT + (((rb - MLAT) >> 8) << 8)), q = lat ? 0 : (((rb - MLAT) >> 6) & 3);
        u32x4 raw[3][10], rv[8];
#define FFN_LOAD_ROW(dr) do { const bool rowok_ = lat ? (gr + (dr) - 1 >= 0 && gr + (dr) - 1 < 32) : ((dr) == 1); const int rbase_ = lat ? base + (gr + (dr) - 1) * 64 : base + q * 64; \
            _Pragma("unroll") for (int i_ = 0; i_ < 10; ++i_) { const int col_ = tq * 8 - 1 + i_; const bool ok_ = rowok_ && (lat ? (col_ >= 0 && col_ < 64) : (q * 64 + col_ >= 0 && q * 64 + col_ < LCTX)); \
                raw[dr][i_] = ok_ ? *(const u32x4*)(gate + (size_t)(rbase_ + col_) * DFF + c0) : (u32x4){0u, 0u, 0u, 0u}; } } while (0)
#define FFN_ACC_ROW(dr) do { float w_[3][8]; \
            _Pragma("unroll") for (int dc_ = 0; dc_ < 3; ++dc_) { const f32x4* p_ = (const f32x4*)(cw + (size_t)((dr) * 3 + dc_) * DFF + c0); const f32x4 a_ = p_[0], b_ = p_[1]; \
                w_[dc_][0] = a_.x; w_[dc_][1] = a_.y; w_[dc_][2] = a_.z; w_[dc_][3] = a_.w; w_[dc_][4] = b_.x; w_[dc_][5] = b_.y; w_[dc_][6] = b_.z; w_[dc_][7] = b_.w; } \
            float pa_[8], pb_[8], pc_[8]; unpack8(raw[dr][0], pa_); unpack8(raw[dr][1], pb_); \
            _Pragma("unroll") for (int i_ = 0; i_ < 8; ++i_) { unpack8(raw[dr][i_ + 2], pc_); \
                _Pragma("unroll") for (int c_ = 0; c_ < 8; ++c_) acc[i_][c_] += w_[0][c_] * pa_[c_] + w_[1][c_] * pb_[c_] + w_[2][c_] * pc_[c_]; \
                _Pragma("unroll") for (int c_ = 0; c_ < 8; ++c_) { pa_[c_] = pb_[c_]; pb_[c_] = pc_[c_]; } } } while (0)
        FFN_LOAD_ROW(0); FFN_LOAD_ROW(1);
        float acc[8][8];
        { const f32x4* p = (const f32x4*)(cb_ + c0); const f32x4 a = p[0], b = p[1];
#pragma unroll
          for (int i = 0; i < 8; ++i) { acc[i][0] = a.x; acc[i][1] = a.y; acc[i][2] = a.z; acc[i][3] = a.w; acc[i][4] = b.x; acc[i][5] = b.y; acc[i][6] = b.z; acc[i][7] = b.w; } }
        FFN_ACC_ROW(0);
        asm volatile("" ::: "memory");
        FFN_LOAD_ROW(2);
#pragma unroll
        for (int i = 0; i < 8; ++i) rv[i] = *(const u32x4*)(val + (size_t)(rb + tq * 8 + i) * DFF + c0);
        FFN_ACC_ROW(1);
        FFN_ACC_ROW(2);
#undef FFN_LOAD_ROW
#undef FFN_ACC_ROW
#pragma unroll
        for (int i = 0; i < 8; ++i) { bf16_t* vp = val + (size_t)(rb + tq * 8 + i) * DFF + c0; float v[8]; unpack8(rv[i], v);
#pragma unroll
            for (int c = 0; c < 8; ++c) v[c] *= silu_f(acc[i][c]);
            *(u32x4*)(probe_alt ? vp + (size_t)202 * MiB / 2 : vp) = pack8(v); }
    }
}

__device__ __forceinline__ void ssd_gate_norm_phase(Frame& F, int j, int nrows) {
    fresh_ids(F);
    const int gw = blockIdx.x * NWAVES + F.wave, NGW = F.G * NWAVES, lane = F.lane;
    bf16_t* yf = (bf16_t*)(F.ws + WS_XBCP); const bf16_t* yb = (const bf16_t*)(F.ws + WS_YB); const bf16_t* z = (const bf16_t*)(F.ws + WS_Z);
    const float* ng = F.in[I_SNG] + (size_t)j * DI;
    for (int r = gw; r < nrows; r += NGW) {
#pragma unroll 4
        for (int g = 0; g < 8; ++g) { const size_t off = (size_t)r * DI + g * 512 + lane * 8;
            float a[8], b[8], zz[8]; unpack8(*(const u32x4*)(yf + off), a); unpack8(*(const u32x4*)(yb + off), b); unpack8(*(const u32x4*)(z + off), zz);
            float ss = 0.f;
#pragma unroll
            for (int c = 0; c < 8; ++c) { a[c] = (a[c] + b[c]) * silu_f(zz[c]); ss += a[c] * a[c]; }
            const float rs = rsqrtf(wave_sum(ss, lane) * (1.0f / 512.0f) + EPS);
            const f32x4* gp = (const f32x4*)(ng + g * 512 + lane * 8); const f32x4 g0 = gp[0], g1 = gp[1];
            a[0] *= rs * g0.x; a[1] *= rs * g0.y; a[2] *= rs * g0.z; a[3] *= rs * g0.w; a[4] *= rs * g1.x; a[5] *= rs * g1.y; a[6] *= rs * g1.z; a[7] *= rs * g1.w;
            *(u32x4*)(yf + off) = pack8(a); }
    }
}

__device__ __forceinline__ float softplus_f(float x) { return x > 20.f ? x : log1pf(expf(x)); }
__device__ __forceinline__ float incl_scan64(float v, int lane) {
#pragma unroll
    for (int o = 1; o < 64; o <<= 1) { const float t = __builtin_bit_cast(float, __builtin_amdgcn_ds_bpermute(((lane - o) & 63) << 2, __builtin_bit_cast(int, v))); if (lane >= o) v += t; }
    return v;
}
template <int MODE> __device__ __forceinline__ void ssd_scan_phase(Frame& F, int j, bool ctx_out) {
    fresh_ids(F);
    const int w = F.wave;
    LAS unsigned char* CS = F.lds; LAS unsigned char* BS = F.lds + 32768; LAS unsigned char* GS = F.lds + 65536;
    LAS float* tab = (LAS float*)(F.lds + 98304 + w * 2048);
    const bf16_t* cm = (const bf16_t*)(F.ws + WS_CM); const bf16_t* bm = (const bf16_t*)(F.ws + WS_BM); const bf16_t* bmt = (const bf16_t*)(F.ws + WS_BMT); const bf16_t* xst = (const bf16_t*)(F.ws + WS_XST);
    const float* dtb = (const float*)(F.ws + WS_DT);
#define SCAN_DMA(dstbase, srcptr_row0, pitch_elems) do { _Pragma("unroll") for (int q_ = 0; q_ < 4; ++q_) { const int idx_ = tid + 512 * q_, row_ = idx_ >> 4, c16_ = (idx_ & 15) ^ (row_ & 15); \
        __builtin_amdgcn_global_load_lds((const unsigned*)((srcptr_row0) + (size_t)row_ * (pitch_elems) + c16_ * 8), (LAS unsigned*)((dstbase) + (w * 64 + 512 * q_) * 16), 16, 0, 0); } } while (0)
    for (int item = blockIdx.x; item < 256; item += F.G) {
        const int ph = item & 1, dir = (item >> 1) & 1, g = (item >> 2) & 7, b = item >> 5, h = g * 8 + w;
        const float a_h = -expf(F.in[I_ALOG][(j * 2 + dir) * NH + h]) * LOG2E;
        const float dtbias = F.in[I_DTB][(j * 2 + dir) * NH + h];
        const float dsk = dir == 0 ? F.in[I_DSK][(j * 2 + 0) * NH + h] + F.in[I_DSK][(j * 2 + 1) * NH + h] : 0.f;
        bf16_t* yout = dir == 0 ? (bf16_t*)(F.ws + WS_XBCP) : (bf16_t*)(F.ws + WS_YB);
        f32x4 hT[8][2];
#pragma unroll
        for (int nt = 0; nt < 8; ++nt) { hT[nt][0] = (f32x4){0.f, 0.f, 0.f, 0.f}; hT[nt][1] = (f32x4){0.f, 0.f, 0.f, 0.f}; }
        for (int k = 0; k < 18; ++k) {
            const bool isctx = k < 2; const int cc = isctx ? (dir == 0 ? k : 1 - k) : (dir == 0 ? k - 2 : 17 - k);
            const int row0 = isctx ? MLAT + b * LCTX + cc * 128 : b * LSEQ + cc * 128, T = isctx ? LCTX : LSEQ;
            const bf16_t* xp = isctx ? xst + (size_t)NB * DI * LSEQ + ((size_t)(b * DI + h * 64 + ph * 32)) * LCTX + cc * 128 : xst + ((size_t)(b * DI + h * 64 + ph * 32)) * LSEQ + cc * 128;
            const bf16_t* btp = isctx ? bmt + (size_t)NB * GNW * LSEQ + ((size_t)(b * GNW + g * 128)) * LCTX + cc * 128 : bmt + ((size_t)(b * GNW + g * 128)) * LSEQ + cc * 128;
            const bool need_y = ctx_out || !isctx;
            __builtin_amdgcn_sched_barrier(0);
            const int lane = fresh_lane(), fr = lane & 15, fq = lane >> 4, tid = w * 64 + lane;
            const bf16_t* xl = xp + (size_t)fr * T + 8 * fq;
            bf16x8 xf[2][4];
#pragma unroll
            for (int pt = 0; pt < 2; ++pt)
#pragma unroll
                for (int ks = 0; ks < 4; ++ks) xf[pt][ks] = *(const bf16x8*)(xl + (size_t)(16 * pt) * T + 32 * ks);
            const float dtr0 = dtb[(size_t)(row0 + lane) * 128 + dir * 64 + h], dtr1 = dtb[(size_t)(row0 + 64 + lane) * 128 + dir * 64 + h];
            __syncthreads();
            if (need_y && !(MODE & 8)) { SCAN_DMA(CS, cm + (size_t)row0 * GNW + g * 128, GNW); SCAN_DMA(BS, bm + (size_t)row0 * GNW + g * 128, GNW); }
            float tot = -1.f;
            if (!(MODE & 16)) {
                const float dt0 = softplus_f(dtr0 + dtbias), dt1 = softplus_f(dtr1 + dtbias);
                const float dA0 = dt0 * a_h, dA1 = dt1 * a_h;
                const float p0 = incl_scan64(dA0, lane), tot0 = __builtin_bit_cast(float, __builtin_amdgcn_readlane(__builtin_bit_cast(int, p0), 63)), p1 = incl_scan64(dA1, lane) + tot0; tot = __builtin_bit_cast(float, __builtin_amdgcn_readlane(__builtin_bit_cast(int, p1), 63));
                const float c0 = dir == 0 ? p0 : tot - p0 + dA0, c1 = dir == 0 ? p1 : tot - p1 + dA1;
                tab[lane] = c0; tab[64 + lane] = c1; tab[128 + lane] = dt0; tab[192 + lane] = dt1;
                tab[256 + lane] = dt0 * exp2f(tot - c0); tab[320 + lane] = dt1 * exp2f(tot - c1);
                asm volatile("" ::: "memory");
                const int r0 = dir == 0 ? (lane | 31) : (lane & ~31);
                tab[384 + lane] = dt0 * __builtin_amdgcn_exp2f(tab[r0] - c0); tab[448 + lane] = dt1 * __builtin_amdgcn_exp2f(tab[64 + r0] - c1);
            }
            VM_WAIT(); __syncthreads();
            bf16x8 xs2[2][4];
#pragma unroll
            for (int ks = 0; ks < 4; ++ks) { const f32x4 fa = *(const LAS f32x4*)(tab + 384 + 32 * ks + 8 * fq), fb = *(const LAS f32x4*)(tab + 384 + 32 * ks + 8 * fq + 4);
#pragma unroll
                for (int pt = 0; pt < 2; ++pt) { float xv[8]; unpack8(__builtin_bit_cast(u32x4, xf[pt][ks]), xv);
                    xv[0] *= fa.x; xv[1] *= fa.y; xv[2] *= fa.z; xv[3] *= fa.w; xv[4] *= fb.x; xv[5] *= fb.y; xv[6] *= fb.z; xv[7] *= fb.w;
                    xs2[pt][ks] = __builtin_bit_cast(bf16x8, pack8(xv)); } }
            if (need_y && !(MODE & 2)) {
                bf16x8 cf[4];
#pragma unroll
                for (int ks = 0; ks < 4; ++ks) cf[ks] = *(const LAS bf16x8*)(CS + (16 * w + fr) * 256 + (((4 * ks + fq) ^ fr) << 4));
#pragma unroll 2
                for (int st = 0; st < 8; ++st) { f32x4 acc = (f32x4){0.f, 0.f, 0.f, 0.f};
#pragma unroll
                    for (int ks = 0; ks < 4; ++ks) { const bf16x8 bfr = *(const LAS bf16x8*)(BS + (16 * st + fr) * 256 + (((4 * ks + fq) ^ fr) << 4)); acc = __builtin_amdgcn_mfma_f32_16x16x32_bf16(bfr, cf[ks], acc, 0, 0, 0); }
                    u32x2 o; o.x = cvt_pk_bf16(acc[0], acc[1]); o.y = cvt_pk_bf16(acc[2], acc[3]);
                    *(LAS u32x2*)(GS + (16 * w + fr) * 256 + (((2 * st + (fq >> 1)) ^ fr) << 4) + (fq & 1) * 8) = o; }
            }
            __syncthreads();
            if (!(MODE & 8)) SCAN_DMA(BS, btp, T);
            if (need_y && !(MODE & 1)) {
                bf16x8 hf[2][4];
#pragma unroll
                for (int pt = 0; pt < 2; ++pt)
#pragma unroll
                    for (int q = 0; q < 4; ++q) { const f32x4 lo4 = hT[2 * q][pt], hi4 = hT[2 * q + 1][pt]; u32x4 o; o.x = cvt_pk_bf16(lo4[0], lo4[1]); o.y = cvt_pk_bf16(lo4[2], lo4[3]); o.z = cvt_pk_bf16(hi4[0], hi4[1]); o.w = cvt_pk_bf16(hi4[2], hi4[3]);
                        hf[pt][q] = __builtin_bit_cast(bf16x8, o); }
#pragma unroll 1
                for (int lt = 0; lt < 8; ++lt) {
                    const int l = 16 * lt + fr; const float cl = tab[l];
                    f32x4 accd[2], acco[2];
                    accd[0] = accd[1] = acco[0] = acco[1] = (f32x4){0.f, 0.f, 0.f, 0.f};
                    const int kd = lt >> 1;
                    const bf16x8 xa = *(const bf16x8*)(xl + 32 * kd), xb = *(const bf16x8*)(xl + (size_t)16 * T + 32 * kd);
#pragma unroll
                    for (int ks = 0; ks < 4; ++ks) {
                        const bool full = dir == 0 ? (ks < kd) : (ks > kd);
                        if (full) {
                            const bf16x8 gf = *(const LAS bf16x8*)(GS + l * 256 + (((4 * ks + fq) ^ fr) << 4));
                            const float f1 = __builtin_amdgcn_exp2f(cl - tab[dir == 0 ? 32 * ks + 31 : 32 * ks]);
                            const f32x4 z4 = (f32x4){0.f, 0.f, 0.f, 0.f};
                            const f32x4 t0 = __builtin_amdgcn_mfma_f32_16x16x32_bf16(xs2[0][ks], gf, z4, 0, 0, 0), t1 = __builtin_amdgcn_mfma_f32_16x16x32_bf16(xs2[1][ks], gf, z4, 0, 0, 0);
                            accd[0] += t0 * f1; accd[1] += t1 * f1;
                        }
                    }
#pragma unroll
                    for (int q = 0; q < 4; ++q) {
                        const u32x2 lo = *(const LAS u32x2*)(CS + l * 256 + (((4 * q + (fq >> 1)) ^ fr) << 4) + (fq & 1) * 8), hi = *(const LAS u32x2*)(CS + l * 256 + (((4 * q + 2 + (fq >> 1)) ^ fr) << 4) + (fq & 1) * 8);
                        u32x4 c4; c4.x = lo.x; c4.y = lo.y; c4.z = hi.x; c4.w = hi.y; const bf16x8 cfr = __builtin_bit_cast(bf16x8, c4);
                        acco[0] = __builtin_amdgcn_mfma_f32_16x16x32_bf16(hf[0][q], cfr, acco[0], 0, 0, 0);
                        acco[1] = __builtin_amdgcn_mfma_f32_16x16x32_bf16(hf[1][q], cfr, acco[1], 0, 0, 0);
                    }
                    {
                        float gg[8]; unpack8(*(const LAS u32x4*)(GS + l * 256 + (((4 * kd + fq) ^ fr) << 4)), gg);
                        const f32x4 ca = *(const LAS f32x4*)(tab + 32 * kd + 8 * fq), cb = *(const LAS f32x4*)(tab + 32 * kd + 8 * fq + 4);
                        const f32x4 da = *(const LAS f32x4*)(tab + 128 + 32 * kd + 8 * fq), db = *(const LAS f32x4*)(tab + 128 + 32 * kd + 8 * fq + 4);
                        const float cs[8] = {ca.x, ca.y, ca.z, ca.w, cb.x, cb.y, cb.z, cb.w}, ds[8] = {da.x, da.y, da.z, da.w, db.x, db.y, db.z, db.w};
                        float m[8];
#pragma unroll
                        for (int jj = 0; jj < 8; ++jj) { const int s = 32 * kd + 8 * fq + jj; const bool valid = dir == 0 ? (s <= l) : (s >= l);
                            const float e = valid ? __builtin_amdgcn_exp2f(cl - cs[jj]) : 0.f; m[jj] = gg[jj] * e * ds[jj]; if (dir == 0 && s == l) m[jj] += dsk; }
                        const bf16x8 mf = __builtin_bit_cast(bf16x8, pack8(m));
                        accd[0] = __builtin_amdgcn_mfma_f32_16x16x32_bf16(xa, mf, accd[0], 0, 0, 0);
                        accd[1] = __builtin_amdgcn_mfma_f32_16x16x32_bf16(xb, mf, accd[1], 0, 0, 0);
                    }
                    const float el = __builtin_amdgcn_exp2f(cl);
#pragma unroll
                    for (int pt = 0; pt < 2; ++pt) { const f32x4 y = accd[pt] + acco[pt] * el; u32x2 o; o.x = cvt_pk_bf16(y[0], y[1]); o.y = cvt_pk_bf16(y[2], y[3]);
                        *(u32x2*)(yout + (size_t)(row0 + l) * DI + h * 64 + ph * 32 + 16 * pt + 4 * fq) = o; }
                }
            }
            VM_WAIT(); __syncthreads();
            if (!(MODE & 4)) {
                const float dec = exp2f(tot);
#pragma unroll
                for (int nt = 0; nt < 8; ++nt) { hT[nt][0] *= dec; hT[nt][1] *= dec; }
                bf16x8 xw[2][4];
#pragma unroll
                for (int ks = 0; ks < 4; ++ks) { const float sck = __builtin_amdgcn_exp2f(tot - tab[dir == 0 ? 32 * ks + 31 : 32 * ks]);
#pragma unroll
                    for (int pt = 0; pt < 2; ++pt) { float xv[8]; unpack8(__builtin_bit_cast(u32x4, xs2[pt][ks]), xv);
#pragma unroll
                        for (int e = 0; e < 8; ++e) xv[e] *= sck;
                        xw[pt][ks] = __builtin_bit_cast(bf16x8, pack8(xv)); } }
#pragma unroll
                for (int nt = 0; nt < 8; ++nt) {
#pragma unroll
                    for (int ks = 0; ks < 4; ++ks) { const bf16x8 bfr = *(const LAS bf16x8*)(BS + (16 * nt + fr) * 256 + (((4 * ks + fq) ^ fr) << 4));
                        hT[nt][0] = __builtin_amdgcn_mfma_f32_16x16x32_bf16(bfr, xw[0][ks], hT[nt][0], 0, 0, 0);
                        hT[nt][1] = __builtin_amdgcn_mfma_f32_16x16x32_bf16(bfr, xw[1][ks], hT[nt][1], 0, 0, 0); }
                    if (nt & 1) __builtin_amdgcn_sched_barrier(0);
                }
            }
        }
        __syncthreads();
    }
#undef SCAN_DMA
}

constexpr int N_PHASES = 43;
__host__ __device__ constexpr bool phase_exists(int p) {
    if (p < 2 || p == 42) return true;
    const int L = (p - 2) / 10, s = (p - 2) % 10;
    if (L & 1) return true;
    return s != 5;
}
__global__ void __launch_bounds__(NWAVES * 64, 2) trunk_fwd(Args args) {
    extern __shared__ __attribute__((aligned(16))) unsigned char lds_raw[];
    Frame F;
    F.lds = (LAS unsigned char*)lds_raw;
    F.tid = threadIdx.x; F.lane = F.tid & 63; F.wave = __builtin_amdgcn_readfirstlane(F.tid >> 6); F.G = gridDim.x;
    F.in = args.in; F.out = args.out; F.ws = args.ws;
    volatile LAS unsigned* MISC = (volatile LAS unsigned*)(F.lds + MISC_OFF);
    for (int u = F.tid; u < (LDS_BYTES - LDSCTL_OFF) / 4; u += NWAVES * 64) ((LAS unsigned*)(F.lds + LDSCTL_OFF))[u] = 0u;
    __syncthreads();
    const int lo = args.ph_lo, hi = args.ph_hi;
    XcdBarrier bar; bar.bar = (unsigned*)(F.ws + WS_CTL) + CW_BAR; bar.x = 0; bar.st = nullptr;
    if (hi - lo > 1) bar = xcd_barrier_post((unsigned*)(F.ws + WS_CTL) + CW_BAR, MISC + 8);
#ifndef ONLY_PHASE
#define ONLY_PHASE -1
#endif
#ifndef SKIP_PHASE
#define SKIP_PHASE -2
#endif
#ifndef REP_PHASE
#define REP_PHASE -3
#endif
#define PHON(id) ((id) != SKIP_PHASE && (ONLY_PHASE < 0 || ONLY_PHASE == (id)))
#define IN(k) (lo <= (k) && (k) < hi)
#define SEAM(k) do { if ((k) + 1 < hi) xcd_barrier(bar, F.wave == 0 && fresh_lane() == 0); } while (0)
    LAS unsigned char* ring = F.lds;

#define REPS(id) ((REP_PHASE == (id)) ? 2 : 1)
#define PHASE(id, k, ...) do { if (PHON(id) && IN(k)) { for (int rep_ = 0; rep_ < REPS(id); ++rep_) { __VA_ARGS__; if (rep_ + 1 < REPS(id)) xcd_barrier(bar, F.wave == 0 && fresh_lane() == 0); } SEAM(k); } } while (0)
    PHASE(0, 0, p0_prologue(F));
    PHASE(1, 1, p0b_modreduce(F));

    for (int L = 0; L < DEPTH; ++L) {
        const int pb = 2 + 10 * L; const bool ssd = (L & 1) != 0, last = (L == DEPTH - 1); const int j = L >> 1;
        if (hi <= pb || lo >= pb + 10) continue;
        const int nrows_ffn = last ? MLAT : MALL;
        PHASE(2, pb + 0, norm_mod_phase(F, L, F.in[I_NMIX] + (size_t)L * D, 0, MALL, L > 0 ? (const float*)(F.ws + WS_MOD) + (size_t)(L - 1) * 9 * MODW + 5 * D : nullptr, L == 0 ? F.in[I_X] : F.out, L == 0 ? F.in[I_CTX] : (const float*)(F.ws + WS_XC)));
        if (!ssd) {
            PHASE(3, pb + 1, { fresh_ids(F); SchedF1 S{F.ws}; pg8::EpiTile E; pg8::gemm_phase<pg8::EpiTile, SchedF1, true>(ring, F.wave, 256, D, 256, S, E); });
            PHASE(15, pb + 2, fft8_phase(F));
            PHASE(4, pb + 3, { fresh_ids(F); SchedF2 S{F.ws}; pg8::EpiTile E; pg8::gemm_phase<pg8::EpiTile, SchedF2, true>(ring, F.wave, 512, 512, 512, S, E); });
            PHASE(5, pb + 4, { fresh_ids(F); SchedAB<D> S{F.ws, WS_F, WS_WFOUR + (size_t)j * D * D * 2, 1};
                               pg8::EpiTile E; pg8::gemm_phase<pg8::EpiTile, SchedAB<D>, true>(ring, F.wave, D, D, D, S, E); });
        } else {
            PHASE(6, pb + 1, { fresh_ids(F); SchedIn S{F.ws, WS_WIN + (size_t)j * INP * D * 2, last ? 1 : 0}; pg8::EpiTile E; pg8::gemm_phase<pg8::EpiTile, SchedIn, true>(ring, F.wave, D, D, D, S, E); });
            PHASE(7, pb + 2, ssd_conv_phase(F, j, last));
#ifndef SCAN_PROBE
#define SCAN_PROBE 0
#endif
            PHASE(8, pb + 3, { if (REPS(8) == 2 && rep_ == 0) ssd_scan_phase<SCAN_PROBE>(F, j, !last); else ssd_scan_phase<0>(F, j, !last); });
            PHASE(9, pb + 4, ssd_gate_norm_phase(F, j, last ? MLAT : MALL));
            PHASE(10, pb + 5, { fresh_ids(F); SchedAB<DI> S{F.ws, WS_XBCP, WS_WOUT + (size_t)j * D * DI * 2, last ? 0 : 1};
                                pg8::EpiTile E; pg8::gemm_phase<pg8::EpiTile, SchedAB<DI>, true>(ring, F.wave, DI, DI, DI, S, E); });
        }
        PHASE(2, pb + 6, norm_mod_phase(F, L, F.in[I_NFFN] + (size_t)L * D, 3, nrows_ffn, (const float*)(F.ws + WS_MOD) + (size_t)L * 9 * MODW + 2 * D, L == 0 ? F.in[I_X] : F.out, L == 0 ? F.in[I_CTX] : (const float*)(F.ws + WS_XC)));
        PHASE(11, pb + 7, { fresh_ids(F); SchedUp S{F.ws, WS_WUP + (size_t)L * 2 * DFF * D * 2, nrows_ffn / 256}; pg8::EpiTile E; pg8::gemm_phase<pg8::EpiTile, SchedUp, true>(ring, F.wave, D, D, D, S, E); });
        PHASE(12, pb + 8, ffn_conv_phase(F, L, nrows_ffn, REPS(12) == 2 && rep_ == 0));
        PHASE(13, pb + 9, { fresh_ids(F); SchedAB<DFF> S{F.ws, WS_VAL, WS_WDN + (size_t)L * D * DFF * 2, last ? 0 : 1};
                            pg8::EpiTile E; pg8::gemm_phase<pg8::EpiTile, SchedAB<DFF>, true>(ring, F.wave, DFF, DFF, DFF, S, E); });
    }
    PHASE(14, 42, final_norm_phase(F));
#undef PHASE
#undef REPS
#undef IN
#undef PHON
#undef SEAM
}

extern "C" void kernel_launch(void* const* d_in, const int* in_sizes, int n_in, void* d_out, int out_size, void* d_ws, size_t ws_size, hipStream_t stream) {
    static int grid = 0;
    if (grid == 0) {
        if (n_in != 22 || out_size != MLAT * D || ws_size < WS_END) { fprintf(stderr, "kernel_launch: unexpected problem (n_in %d, out %d, ws %zu < %zu)\n", n_in, out_size, ws_size, (size_t)WS_END); grid = -1; return; }
        int dev = 0, cus = 0, per_cu = 0;
        if (hipGetDevice(&dev) != hipSuccess || hipDeviceGetAttribute(&cus, hipDeviceAttributeMultiprocessorCount, dev) != hipSuccess) { grid = -1; return; }
        if (hipFuncSetAttribute((const void*)trunk_fwd, hipFuncAttributeMaxDynamicSharedMemorySize, LDS_BYTES) != hipSuccess) { fprintf(stderr, "kernel_launch: hipFuncSetAttribute failed\n"); grid = -1; return; }
        if (hipOccupancyMaxActiveBlocksPerMultiprocessor(&per_cu, (const void*)trunk_fwd, NWAVES * 64, LDS_BYTES) != hipSuccess || per_cu < 1) fprintf(stderr, "kernel_launch: occupancy query says %d\n", per_cu);
        (void)hipGetLastError();
        grid = cus;
    }
    if (grid < 0) return;
    (void)hipMemsetAsync((char*)d_ws + WS_CTL, 0, CTL_ZERO_BYTES, stream);
    Args a{};
    for (int i = 0; i < 22; ++i) a.in[i] = (const float*)d_in[i];
    a.out = (float*)d_out; a.ws = (unsigned char*)d_ws;
#if MK_N_LAUNCHES == 1
    a.ph_lo = 0; a.ph_hi = N_PHASES;
    hipLaunchKernelGGL(trunk_fwd, dim3(grid), dim3(NWAVES * 64), LDS_BYTES, stream, a);
#else
    for (int p = 0; p < N_PHASES; ++p) { if (!phase_exists(p)) continue; a.ph_lo = p; a.ph_hi = p + 1;
        hipLaunchKernelGGL(trunk_fwd, dim3(grid), dim3(NWAVES * 64), LDS_BYTES, stream, a); }
#endif
}
```

```cpp
#include <hip/hip_runtime.h>
#include <cstdio>
#include <cstdint>

#define LAS __attribute__((address_space(3)))
#define GAS __attribute__((address_space(1)))
typedef unsigned short bf16_t;
typedef short bf16x8 __attribute__((ext_vector_type(8)));
typedef float f32x4 __attribute__((ext_vector_type(4)));
typedef float f32x2 __attribute__((ext_vector_type(2)));
typedef unsigned u32x4 __attribute__((ext_vector_type(4)));
typedef unsigned u32x2 __attribute__((ext_vector_type(2)));

#ifndef MK_N_LAUNCHES
#define MK_N_LAUNCHES 1
#endif

constexpr int D = 2048, NB = 8, LSEQ = 2048, LCTX = 256, DEPTH = 4;
constexpr int MLAT = NB * LSEQ, MCTX = NB * LCTX, MALL = MLAT + MCTX;
constexpr int DFF = 5632, DI = 4096, GNW = 1024, NH = 64, NS = 128;
constexpr int XBC = DI + 2 * GNW;
constexpr int INW = 10368, INP = 10496;
constexpr int MODW = 6 * D;
constexpr float EPS = 1e-6f;
constexpr float LOG2E = 1.4426950408889634f;

constexpr size_t MiB = 1u << 20;
constexpr size_t WS_CTL = 0, CTL_ZERO_BYTES = 1 * MiB;
constexpr size_t WS_MOD = 1 * MiB;
constexpr size_t WS_W1 = 3 * MiB;
constexpr size_t WS_W2C = 3 * MiB + 512 * 1024;
constexpr size_t WS_W2 = 4 * MiB;
constexpr size_t WS_WFOUR = 20 * MiB;
constexpr size_t WS_WIN = 36 * MiB;
constexpr size_t WS_WOUT = 118 * MiB;
constexpr size_t WS_WUP = 150 * MiB;
constexpr size_t WS_WDN = 326 * MiB;
constexpr size_t WS_XC = 414 * MiB;
constexpr size_t WS_A = 430 * MiB;
constexpr size_t WS_R = 502 * MiB;
constexpr size_t WS_MODP = WS_R;
constexpr size_t WS_GATE = WS_R, WS_VAL = WS_R + 198 * MiB;
constexpr size_t WS_PQT = WS_R, WS_PQTC = WS_R + 128 * MiB, WS_F = WS_R + 144 * MiB;
constexpr size_t WS_VT = WS_R + 216 * MiB;
constexpr size_t WS_XBCP = WS_R;
constexpr size_t WS_Z = WS_R + 216 * MiB;
constexpr size_t WS_DT = WS_R + 360 * MiB;
constexpr size_t WS_XST = WS_R + 369 * MiB;
constexpr size_t WS_BM = WS_R + 513 * MiB;
constexpr size_t WS_BMT = WS_R + 549 * MiB;
constexpr size_t WS_CM = WS_R + 585 * MiB;
constexpr size_t WS_YB = WS_R + 621 * MiB;
constexpr size_t WS_Y = WS_R + 621 * MiB;
constexpr size_t WS_Y2 = WS_R + 400 * MiB;
constexpr size_t WS_PART = WS_R + 700 * MiB;
constexpr size_t WS_XB = WS_R + 765 * MiB;
constexpr size_t WS_END = WS_R + 829 * MiB;
constexpr int CW_BAR = 4096;

constexpr int RING_BYTES = 131072;
constexpr int LDSCTL_OFF = RING_BYTES, MISC_OFF = LDSCTL_OFF + 320;
constexpr int LDS_BYTES = 147456;
constexpr int NWAVES = 8;

typedef __bf16 bf16x2_t __attribute__((ext_vector_type(2)));
__device__ __forceinline__ unsigned cvt_pk_bf16(float lo, float hi) { const f32x2 v = {lo, hi}; return __builtin_bit_cast(unsigned, __builtin_convertvector(v, bf16x2_t)); }
__device__ __forceinline__ float bf_lo(unsigned u) { return __uint_as_float(u << 16); }
__device__ __forceinline__ float bf_hi(unsigned u) { return __uint_as_float(u & 0xffff0000u); }
__device__ __forceinline__ float silu_f(float v) { return v * __builtin_amdgcn_rcpf(1.0f + __expf(-v)); }
typedef float f32x2 __attribute__((ext_vector_type(2)));
__device__ __forceinline__ float wave_sum(float v, int lane) {
#pragma unroll
    for (int o = 1; o < 64; o <<= 1) v += __builtin_bit_cast(float, __builtin_amdgcn_ds_bpermute((lane ^ o) << 2, __builtin_bit_cast(int, v)));
    return v;
}
__device__ __forceinline__ int fresh_lane() { int l; asm volatile("v_mbcnt_lo_u32_b32 %0, -1, 0\n\tv_mbcnt_hi_u32_b32 %0, -1, %0" : "=v"(l)); return l; }
#define LDS_WAIT() asm volatile("s_waitcnt lgkmcnt(0)" ::: "memory")
#define VM_WAIT() asm volatile("s_waitcnt vmcnt(0)" ::: "memory")

namespace pg8 {
constexpr int BM = 256, BK = 64, HALF = 128, HTB = HALF * BK * 2, STAGE_BYTES = 8 * HTB, NXCD = 8, WGM = 8;
__host__ __device__ __forceinline__ int lds_byte(int r, int c) { const int st = (r >> 4) * 2 + (c >> 5), rr = r & 15, cc = c & 31, ob = rr * 64 + cc * 2; return st * 1024 + (ob ^ (((ob >> 9) & 1) << 5)); }
__host__ __device__ __forceinline__ void stage_rc(int b, int& R, int& C) { const int st = b / 1024, sb = b % 1024, swz = sb ^ (((sb >> 9) & 1) << 5); R = (st >> 1) * 16 + swz / 64; C = (st & 1) * 32 + (swz % 64) / 2; }
__host__ __device__ __forceinline__ int perm32(int rho) { const int n = rho >> 4, i = rho & 15; return 8 * (i >> 2) + 4 * n + (i & 3); }

struct Unit { int pm, pn, kq; };

template <int NN> __device__ __forceinline__ void tile_of_id(int wgid, int nM, int& pm, int& pn) {
    const int nwg = nM * NN;
    { const int q = nwg / NXCD, r = nwg % NXCD, xcd = wgid % NXCD, off = wgid / NXCD; wgid = (xcd < r ? xcd * (q + 1) : r * (q + 1) + (xcd - r) * q) + off; }
    const int nig = WGM * NN, gid = wgid / nig, fm = gid * WGM, gsz = (nM - fm) < WGM ? (nM - fm) : WGM;
    pm = fm + ((wgid % nig) % gsz); pn = (wgid % nig) / gsz;
}
template <int NN> __device__ __forceinline__ bool tile2d(int i, int nM, Unit& u) {
    const long L = (long)i * (int)gridDim.x + (int)blockIdx.x; if (L >= nM * NN) return false;
    tile_of_id<NN>((int)L, nM, u.pm, u.pn); u.kq = -1; return true;
}

struct EpiTile {
    static constexpr bool PERM = true;
    template <class Sched> __device__ __forceinline__ void operator()(const f32x4 (&acc)[2][2][4][2], const Unit& u, const Sched& S, int wr, int wc, int fr, int fq) const {
        const int rl0 = wr * 64 + fr, cl0 = wc * 32 + 8 * fq;
        char* uo; int ldo, kind; S.out(u, uo, ldo, kind);
        asm volatile("" : "+s"(ldo));
        if (kind == 0) {
            bf16_t* base = (bf16_t*)uo;
#pragma unroll
            for (int ai = 0; ai < 2; ++ai)
#pragma unroll
                for (int m = 0; m < 4; ++m) { bf16_t* rowp = base + (size_t)(rl0 + ai * HALF + m * 16) * ldo + cl0;
#pragma unroll
                    for (int bj = 0; bj < 2; ++bj) { const f32x4 v0 = acc[ai][bj][m][0], v1 = acc[ai][bj][m][1];
                        u32x4 w; w.x = cvt_pk_bf16(v0[0], v0[1]); w.y = cvt_pk_bf16(v0[2], v0[3]); w.z = cvt_pk_bf16(v1[0], v1[1]); w.w = cvt_pk_bf16(v1[2], v1[3]);
                        *(u32x4*)(rowp + bj * HALF) = w; } }
        } else {
            float* base = (float*)uo;
#pragma unroll
            for (int ai = 0; ai < 2; ++ai)
#pragma unroll
                for (int m = 0; m < 4; ++m) { float* rowp = base + (size_t)(rl0 + ai * HALF + m * 16) * ldo + cl0;
                    *(f32x4*)(rowp) = acc[ai][0][m][0]; *(f32x4*)(rowp + 4) = acc[ai][0][m][1];
                    if (kind == 2) { *(f32x4*)(rowp + HALF) = acc[ai][1][m][0]; *(f32x4*)(rowp + HALF + 4) = acc[ai][1][m][1]; } }
        }
    }
};
template <class Epi, class Sched, bool ALIGN_EPI>
__device__ __forceinline__ void gemm_phase(LAS unsigned char* lds, const int wid, const int lda_, const int ldb_, const int K_, const Sched& S, const Epi& E) {
    int lda = lda_, ldb = ldb_; (void)K_; asm volatile("" : "+s"(lda), "+s"(ldb));
    const int lane = fresh_lane(), tid = wid * 64 + lane;
    const int wr = wid >> 2, wc = wid & 3, fr = lane & 15, fq = lane >> 4;
    unsigned voffA[2], voffB[2];
#pragma unroll
    for (int i = 0; i < 2; ++i) { int R, C; stage_rc(tid * 16 + i * 8192, R, C); const int Rb = Epi::PERM ? ((R & ~31) + perm32(R & 31)) : R;
        voffA[i] = (unsigned)(R * lda + C) * 2u; voffB[i] = (unsigned)(Rb * ldb + C) * 2u; }
    const size_t kstep = (size_t)(BK * 2);
    const size_t hstepA = (size_t)HALF * lda * 2, hstepB = (size_t)HALF * ldb * 2;
    const unsigned ldsw = (unsigned)wid * 1024u;
    const int aoff = lds_byte(wr * 64 + fr, fq * 8), boff = lds_byte(wc * 32 + fr, fq * 8);
#define PG8_SA(b, h) (((b) * 2 + (h)) * HTB)
#define PG8_SB(b, h) ((4 + (b) * 2 + (h)) * HTB)
#define PG8_STAGE(bufoff, gbase, voff) do { _Pragma("unroll") for (int _i = 0; _i < 2; ++_i) \
        __builtin_amdgcn_global_load_lds((const unsigned*)((const char*)(gbase) + (voff)[_i]), (LAS unsigned*)(lds + (bufoff) + ldsw + _i * 8192), 16, 0, 0); } while (0)
#define PG8_LDA(dst, b, h) do { _Pragma("unroll") for (int m = 0; m < 4; ++m) _Pragma("unroll") for (int k = 0; k < 2; ++k) dst[m][k] = *(const LAS bf16x8*)(lds + PG8_SA(b, h) + aoff + m * 2048 + k * 1024); } while (0)
#define PG8_LDB(dst, b, h) do { _Pragma("unroll") for (int n = 0; n < 2; ++n) _Pragma("unroll") for (int k = 0; k < 2; ++k) dst[n][k] = *(const LAS bf16x8*)(lds + PG8_SB(b, h) + boff + n * 2048 + k * 1024); } while (0)
#define PG8_MMA(ai, bj, At, Bt) do { __builtin_amdgcn_s_setprio(1); _Pragma("unroll") for (int m = 0; m < 4; ++m) _Pragma("unroll") for (int n = 0; n < 2; ++n) _Pragma("unroll") for (int k = 0; k < 2; ++k) \
        acc[ai][bj][m][n] = __builtin_amdgcn_mfma_f32_16x16x32_bf16(Bt[n][k], At[m][k], acc[ai][bj][m][n], 0, 0, 0); __builtin_amdgcn_s_setprio(0); } while (0)
#define PG8_WAIT_V(n) asm volatile("s_waitcnt vmcnt(" #n ")" ::: "memory")
#define PG8_WAIT_L(n) asm volatile("s_waitcnt lgkmcnt(" #n ")" ::: "memory")
#define PG8_BAR __builtin_amdgcn_s_barrier()
#define PG8_SCHED __builtin_amdgcn_sched_barrier(0)
    Unit cur, nxt; int ui = 0;
    if (!S.next(0, cur)) return;
    f32x4 acc[2][2][4][2];
#pragma unroll
    for (int a = 0; a < 2; ++a)
#pragma unroll
        for (int b = 0; b < 2; ++b)
#pragma unroll
            for (int m = 0; m < 4; ++m)
#pragma unroll
                for (int n = 0; n < 2; ++n) acc[a][b][m][n] = (f32x4){0.f, 0.f, 0.f, 0.f};
    bf16x8 At[4][2], B0[2][2], B1[2][2];
    const char* cA = S.a(cur); const char* cB = S.b(cur);
    PG8_STAGE(PG8_SB(0, 0), cB, voffB); PG8_STAGE(PG8_SB(0, 1), cB + hstepB, voffB); PG8_STAGE(PG8_SA(0, 0), cA, voffA); PG8_STAGE(PG8_SA(0, 1), cA + hstepA, voffA);
    if (wr == 1) PG8_BAR;
    PG8_WAIT_V(2); PG8_BAR;
    PG8_STAGE(PG8_SB(1, 0), cB + kstep, voffB); PG8_STAGE(PG8_SA(1, 0), cA + kstep, voffA); PG8_STAGE(PG8_SB(1, 1), cB + hstepB + kstep, voffB);
    PG8_WAIT_V(6); PG8_BAR;
    for (;;) {
        const bool has_next = S.next(ui + 1, nxt);
        const int nt = S.nt(cur);
        const char* nA = has_next ? S.a(nxt) : cA; const char* nB = has_next ? S.b(nxt) : cB;
#pragma unroll 1
        for (int t = 0; t < nt; t += 2) {
            const bool last = (t == nt - 2);
            const char* a1 = cA + (size_t)(t + 1) * kstep;
            const char* a2 = last ? nA : cA + (size_t)(t + 2) * kstep; const char* b2 = last ? nB : cB + (size_t)(t + 2) * kstep;
            const char* a3 = a2 + kstep; const char* b3 = b2 + kstep;
            PG8_LDB(B0, 0, 0); PG8_LDB(B1, 0, 1); PG8_SCHED; PG8_LDA(At, 0, 0); PG8_STAGE(PG8_SA(1, 1), a1 + hstepA, voffA);
            PG8_WAIT_V(8); PG8_WAIT_L(0); PG8_BAR; PG8_MMA(0, 0, At, B0); PG8_MMA(0, 1, At, B1); PG8_BAR; PG8_SCHED;
            PG8_LDA(At, 0, 1); PG8_STAGE(PG8_SB(0, 0), b2, voffB); PG8_STAGE(PG8_SB(0, 1), b2 + hstepB, voffB); PG8_STAGE(PG8_SA(0, 0), a2, voffA);
            PG8_WAIT_V(8); PG8_WAIT_L(0); PG8_BAR; PG8_MMA(1, 0, At, B0); PG8_MMA(1, 1, At, B1); PG8_BAR; PG8_SCHED;
            PG8_LDB(B0, 1, 0); PG8_LDB(B1, 1, 1); PG8_SCHED; PG8_LDA(At, 1, 0); PG8_STAGE(PG8_SA(0, 1), a2 + hstepA, voffA);
            PG8_WAIT_V(8); PG8_WAIT_L(0); PG8_BAR; PG8_MMA(0, 0, At, B0); PG8_MMA(0, 1, At, B1); PG8_BAR; PG8_SCHED;
            PG8_LDA(At, 1, 1); PG8_STAGE(PG8_SB(1, 0), b3, voffB); PG8_STAGE(PG8_SB(1, 1), b3 + hstepB, voffB); PG8_STAGE(PG8_SA(1, 0), a3, voffA);
            PG8_WAIT_V(8); PG8_WAIT_L(0); PG8_BAR; PG8_MMA(1, 0, At, B0); PG8_MMA(1, 1, At, B1); PG8_BAR; PG8_SCHED;
        }
        if constexpr (ALIGN_EPI) { if (wr == 0) PG8_BAR; }
        E(acc, cur, S, wr, wc, fr, fq);
        if (!has_next) break;
#pragma unroll
        for (int a = 0; a < 2; ++a)
#pragma unroll
            for (int b = 0; b < 2; ++b)
#pragma unroll
                for (int m = 0; m < 4; ++m)
#pragma unroll
                    for (int n = 0; n < 2; ++n) acc[a][b][m][n] = (f32x4){0.f, 0.f, 0.f, 0.f};
        cur = nxt; cA = nA; cB = nB; ++ui;
        if constexpr (ALIGN_EPI) { if (wr == 1) PG8_BAR; }
    }
    PG8_WAIT_V(0);
    if constexpr (!ALIGN_EPI) { if (wr == 0) PG8_BAR; }
    PG8_BAR;
#undef PG8_SA
#undef PG8_SB
#undef PG8_STAGE
#undef PG8_LDA
#undef PG8_LDB
#undef PG8_MMA
#undef PG8_WAIT_V
#undef PG8_WAIT_L
#undef PG8_BAR
#undef PG8_SCHED
}
}

#define XB_TMO      128
#define XB_XCNT(j)  (256  + 64 * (j))
#define XB_XSUB(j)  (1280 + 64 * (j))
#define XB_XGEN(j)  (2304 + 64 * (j))
#define XB_TOP      3328
#define XB_TOPGEN   3392
#define XCD_BAR_WORDS 3456
#define XB_SPIN_CAP (1u << 18)
__device__ __forceinline__ unsigned xb_ld(unsigned* p)              { return __hip_atomic_load(p, __ATOMIC_RELAXED, __HIP_MEMORY_SCOPE_AGENT); }
__device__ __forceinline__ unsigned xb_add(unsigned* p, unsigned v) { return __hip_atomic_fetch_add(p, v, __ATOMIC_RELAXED, __HIP_MEMORY_SCOPE_AGENT); }
__device__ __forceinline__ unsigned xb_xcc_id() { return (unsigned)__builtin_amdgcn_s_getreg((3 << 11) | 20) & 0xFu; }
#define XB_SPIN(cond, bar) do { unsigned _sp = 0; while (cond) { __builtin_amdgcn_s_sleep(1); \
    if ((++_sp & 255u) == 0u) { if (xb_ld(&(bar)[XB_TMO])) break; if (_sp > XB_SPIN_CAP) { atomicAdd(&(bar)[XB_TMO], 1u); break; } } } } while (0)
struct XcdBarrier { unsigned* bar; unsigned x; volatile LAS unsigned* st; };
__device__ __forceinline__ XcdBarrier xcd_barrier_post(unsigned* bar, volatile LAS unsigned* st) {
    XcdBarrier b; b.bar = bar; b.x = xb_xcc_id(); b.st = st;
    if (threadIdx.x == 0) (void)xb_add(&bar[XB_XCNT(b.x)], 1u);
    return b;
}
__device__ __forceinline__ void xcd_barrier_complete(unsigned* bar, unsigned x, unsigned& nloc, unsigned& nx) {
    const unsigned G = gridDim.x * gridDim.y * gridDim.z;
    unsigned sum, cnt, mine, sp = 0u;
    for (;;) {
        sum = 0u; cnt = 0u; mine = 0u;
#pragma unroll
        for (unsigned j = 0; j < 16; ++j) { const unsigned c = xb_ld(&bar[XB_XCNT(j)]); sum += c; cnt += (c > 0u) ? 1u : 0u; mine = (j == x) ? c : mine; }
        if (sum == G) break;
        __builtin_amdgcn_s_sleep(1);
        if ((++sp & 255u) == 0u) { if (xb_ld(&bar[XB_TMO])) break; if (sp > XB_SPIN_CAP) { atomicAdd(&bar[XB_TMO], 1u); break; } }
    }
    nloc = mine > 0u ? mine : 1u; nx = cnt > 0u ? cnt : 1u;
}
__device__ __forceinline__ void xcd_barrier(const XcdBarrier& b, const bool leader  ) {
    asm volatile("s_waitcnt vmcnt(0)" ::: "memory");
    __syncthreads();
    if (leader) {
        unsigned* bar = b.bar;
        __builtin_amdgcn_s_waitcnt(0);
        unsigned nloc = b.st[0], nx = b.st[1];
        if (nloc == 0u) { xcd_barrier_complete(bar, b.x, nloc, nx); b.st[0] = nloc; b.st[1] = nx; }
        const unsigned old = xb_add(&bar[XB_XSUB(b.x)], 1u);
        const unsigned gen = old / nloc;
        if (old + 1u == (gen + 1u) * nloc) {
            __builtin_amdgcn_fence(__ATOMIC_RELEASE, "agent");
            asm volatile("s_waitcnt vmcnt(0)" ::: "memory");
            const unsigned og = xb_add(&bar[XB_TOP], 1u);
            const unsigned tg = og / nx;
            if (og + 1u == (tg + 1u) * nx) xb_add(&bar[XB_TOPGEN], 1u);
            else XB_SPIN(xb_ld(&bar[XB_TOPGEN]) == tg, bar);
            __builtin_amdgcn_fence(__ATOMIC_ACQUIRE, "agent");
            xb_add(&bar[XB_XGEN(b.x)], 1u);
            asm volatile("s_waitcnt vmcnt(0)" ::: "memory");
        } else {
            XB_SPIN(xb_ld(&bar[XB_XGEN(b.x)]) == gen, bar);
            __builtin_amdgcn_fence(__ATOMIC_ACQUIRE, "agent");
            asm volatile("s_waitcnt vmcnt(0)" ::: "memory");
        }
    }
    __syncthreads();
}

struct Args { const float* in[22]; float* out; unsigned char* ws; int ph_lo, ph_hi; };
struct Frame {
    LAS unsigned char* lds;
    int tid, lane, wave, G;
    const float* const* in;
    float* out; unsigned char* ws;
};
enum { I_X = 0, I_C, I_CTX, I_CCTX, I_WMOD, I_BMOD, I_NMIX, I_NFFN, I_FOURW, I_WIN, I_CONVW, I_CONVB, I_DTB, I_ALOG, I_DSK, I_SNG, I_WOUT, I_WUP, I_FCW, I_FCB, I_WDN, I_FING };

__device__ __forceinline__ void fresh_ids(Frame& F) { F.lane = fresh_lane(); F.tid = F.wave * 64 + F.lane; }

template <int K_, size_t YOFF> struct SchedAB {
    unsigned char* ws; size_t aoff, boff; int has_ctx;
    static constexpr int KT = K_ / 64;
    __device__ __forceinline__ bool next(int i, pg8::Unit& u) const {
        const int L = i * (int)gridDim.x + (int)blockIdx.x;
        if (L < 512) { pg8::tile_of_id<8>(L, 64, u.pm, u.pn); u.kq = -1; return true; }
        if (!has_ctx || L >= 768) return false;
        const int c2 = L - 512, ct = c2 >> 2; u.kq = c2 & 3; u.pm = 64 + (ct >> 3); u.pn = ct & 7; return true; }
    __device__ __forceinline__ int nt(const pg8::Unit& u) const { return u.kq < 0 ? KT : KT / 4; }
    __device__ __forceinline__ void out(const pg8::Unit& u, char*& o, int& ldo, int& kind) const { ldo = D;
        if (u.kq < 0) { o = (char*)ws + YOFF + ((size_t)u.pm * 256 * D + (size_t)u.pn * 256) * 2; kind = 0; }
        else { o = (char*)ws + WS_PART + (((size_t)u.kq * MCTX + (size_t)(u.pm - 64) * 256) * D + (size_t)u.pn * 256) * 2; kind = 0; } }
    __device__ __forceinline__ const char* a(const pg8::Unit& u) const { return (const char*)ws + aoff + (size_t)u.pm * 256 * K_ * 2 + (u.kq < 0 ? 0 : u.kq * (K_ / 4) * 2); }
    __device__ __forceinline__ const char* b(const pg8::Unit& u) const { return (const char*)ws + boff + (size_t)u.pn * 256 * K_ * 2 + (u.kq < 0 ? 0 : u.kq * (K_ / 4) * 2); }
};
struct SchedUp {
    unsigned char* ws; size_t boff; int nM;
    __device__ __forceinline__ int nt(const pg8::Unit&) const { return D / 64; }
    __device__ __forceinline__ bool next(int i, pg8::Unit& u) const { return pg8::tile2d<44>(i, nM, u); }
    __device__ __forceinline__ const char* a(const pg8::Unit& u) const { return (const char*)ws + WS_A + (size_t)u.pm * 256 * D * 2; }
    __device__ __forceinline__ const char* b(const pg8::Unit& u) const { return (const char*)ws + boff + (size_t)u.pn * 256 * D * 2; }
    __device__ __forceinline__ void out(const pg8::Unit& u, char*& o, int& ldo, int& kind) const {
        o = (char*)ws + (u.pn < 22 ? WS_GATE + (size_t)u.pn * 512 : WS_VAL + (size_t)(u.pn - 22) * 512) + (size_t)u.pm * 256 * DFF * 2; ldo = DFF; kind = 0; }
};
struct SchedIn {
    unsigned char* ws; size_t boff; int last;
    __device__ __forceinline__ int nt(const pg8::Unit&) const { return D / 64; }
    __device__ __forceinline__ bool next(int i, pg8::Unit& u) const {
        const int L = i * (int)gridDim.x + (int)blockIdx.x; u.kq = -1;
        if (L < 64 * 41) { pg8::tile_of_id<41>(L, 64, u.pm, u.pn); return true; }
        const int c2 = L - 64 * 41, nct = last ? 21 : 41; if (c2 >= 8 * nct) return false;
        u.pm = 64 + (c2 & 7); const int t = c2 >> 3; u.pn = (last && t >= 20) ? 40 : t; return true; }
    __device__ __forceinline__ const char* a(const pg8::Unit& u) const { return (const char*)ws + WS_A + (size_t)u.pm * 256 * D * 2; }
    __device__ __forceinline__ const char* b(const pg8::Unit& u) const { return (const char*)ws + boff + (size_t)u.pn * 256 * D * 2; }
    __device__ __forceinline__ void out(const pg8::Unit& u, char*& o, int& ldo, int& kind) const {
        if (u.pn < 24) { o = (char*)ws + WS_XBCP + ((size_t)u.pm * 256 * XBC + (size_t)u.pn * 256) * 2; ldo = XBC; kind = 0; }
        else if (u.pn < 40) { o = (char*)ws + WS_Z + ((size_t)u.pm * 256 * DI + (size_t)(u.pn - 24) * 256) * 2; ldo = DI; kind = 0; }
        else { o = (char*)ws + WS_DT + (size_t)u.pm * 256 * 128 * 4; ldo = 128; kind = 1; } }
};
struct SchedF1 {
    unsigned char* ws;
    __device__ __forceinline__ int nt(const pg8::Unit&) const { return 4; }
    __device__ __forceinline__ bool next(int i, pg8::Unit& u) const { return pg8::tile2d<72>(i, 16, u); }
    __device__ __forceinline__ const char* a(const pg8::Unit& u) const { return (const char*)ws + WS_W1 + (size_t)(u.pm & 1) * 256 * 256 * 2; }
    __device__ __forceinline__ const char* b(const pg8::Unit& u) const { return (const char*)ws + WS_A + ((size_t)u.pn * 256 * D + (size_t)(u.pm >> 1) * 256) * 2; }
    __device__ __forceinline__ void out(const pg8::Unit& u, char*& o, int& ldo, int& kind) const { const int g = u.pm >> 1, cs = u.pm & 1;
        if (u.pn < 64) { const int b = u.pn >> 3, p0 = (u.pn & 7) * 256; o = (char*)ws + WS_PQT + (((size_t)(b * 2048 + g * 256)) * 4096 + (size_t)cs * 2048 + p0) * 2; ldo = 4096; }
        else { const int b = u.pn - 64; o = (char*)ws + WS_PQTC + (((size_t)(b * 2048 + g * 256)) * 512 + (size_t)cs * 256) * 2; ldo = 512; }
        kind = 0; }
};
struct SchedF2 {
    unsigned char* ws;
    __device__ __forceinline__ int total() const { return 576; }
    __device__ __forceinline__ int nt(const pg8::Unit&) const { return 8; }
    __device__ __forceinline__ bool next(int i, pg8::Unit& u) const {
        const int L = i * (int)gridDim.x + (int)blockIdx.x; u.kq = -1;
        if (L < 512) { pg8::tile_of_id<8>(L, 64, u.pm, u.pn); return true; }
        if (L >= 576) return false;
        u.pm = 64 + ((L - 512) & 7); u.pn = (L - 512) >> 3; return true; }
    __device__ __forceinline__ const char* a(const pg8::Unit& u) const { return (const char*)ws + (u.pm < 64 ? WS_W2 : WS_W2C); }
    __device__ __forceinline__ const char* b(const pg8::Unit& u) const { return u.pm < 64 ? (const char*)ws + WS_VT + ((size_t)u.pm * 2048 + (size_t)u.pn * 256) * 512 * 2
                                                                                           : (const char*)ws + WS_PQTC + ((size_t)((u.pm - 64) * 2048 + u.pn * 256)) * 512 * 2; }
    __device__ __forceinline__ void out(const pg8::Unit& u, char*& o, int& ldo, int& kind) const { kind = 0;
        if (u.pm < 64) { o = (char*)ws + WS_F + (((size_t)((u.pm >> 3) * 2048 + (u.pm & 7))) * D + (size_t)u.pn * 256) * 2; ldo = 8 * D; }
        else { o = (char*)ws + WS_F + (((size_t)(MLAT + (u.pm - 64) * 256)) * D + (size_t)u.pn * 256) * 2; ldo = D; } }
};

__device__ __forceinline__ void p0_transpose_item(const float* W, int K, int N, bf16_t* WT, int k0, int n0, int drow0, LAS float* scr, int lane) {
    const int kk = lane >> 3, nq = (lane & 7) * 4;
    f32x4 v[8];
#pragma unroll
    for (int i = 0; i < 8; ++i) v[i] = __builtin_nontemporal_load((const f32x4*)(W + (size_t)(k0 + 8 * i + kk) * N + n0 + nq));
#pragma unroll
    for (int i = 0; i < 8; ++i) { LAS float* d = scr + (8 * i + kk) * 33 + nq; d[0] = v[i].x; d[1] = v[i].y; d[2] = v[i].z; d[3] = v[i].w; }
    LDS_WAIT(); asm volatile("" ::: "memory");
    const int c = lane & 7;
#pragma unroll
    for (int j = 0; j < 4; ++j) { const int n = (lane >> 3) + 8 * j; const LAS float* s = scr + (8 * c) * 33 + n;
        u32x4 o; o.x = cvt_pk_bf16(s[0 * 33], s[1 * 33]); o.y = cvt_pk_bf16(s[2 * 33], s[3 * 33]); o.z = cvt_pk_bf16(s[4 * 33], s[5 * 33]); o.w = cvt_pk_bf16(s[6 * 33], s[7 * 33]);
        *(u32x4*)(WT + (size_t)(drow0 + n) * K + k0 + 8 * c) = o; }
    LDS_WAIT(); asm volatile("" ::: "memory");
}
__device__ __forceinline__ int win_dst_row(int n0) { return n0 < 5120 ? n0 : (n0 < 5248 ? 10240 + (n0 - 5120) : n0 - 128); }

__device__ __forceinline__ void p0_prologue(Frame& F) {
    fresh_ids(F);
    LAS float* scr = (LAS float*)(F.lds + F.wave * 16384);
    const int gw = blockIdx.x * NWAVES + F.wave, NGW = F.G * NWAVES, lane = F.lane;
    unsigned char* ws = F.ws;
    {
        constexpr int NCG = MODW / 256, NKS = 8, NIT = DEPTH * NCG * NKS;
        const float* c = F.in[I_C]; const float* cc = F.in[I_CCTX]; const float* wm = F.in[I_WMOD];
        float* modp = (float*)(ws + WS_MODP);
        for (int it = gw; it < NIT; it += NGW) {
            const int ks = it % NKS, cg = (it / NKS) % NCG, L = it / (NKS * NCG), k0 = ks * 256;
            for (int e = lane; e < 9 * 256; e += 64) { const int k = e & 255, b = e >> 8; const float v = (b < 8) ? c[b * D + k0 + k] : cc[k0 + k]; scr[k * 12 + b] = silu_f(v); }
            LDS_WAIT(); asm volatile("" ::: "memory");
            f32x4 acc[9];
#pragma unroll
            for (int b = 0; b < 9; ++b) acc[b] = (f32x4){0.f, 0.f, 0.f, 0.f};
            const float* wp = wm + ((size_t)L * D + k0) * MODW + cg * 256 + lane * 4;
#pragma unroll 8
            for (int k = 0; k < 256; ++k) {
                const f32x4 wv = __builtin_nontemporal_load((const f32x4*)(wp + (size_t)k * MODW));
                const f32x4 s0 = *(const LAS f32x4*)(scr + k * 12), s1 = *(const LAS f32x4*)(scr + k * 12 + 4); const float s2 = scr[k * 12 + 8];
                acc[0] += wv * s0[0]; acc[1] += wv * s0[1]; acc[2] += wv * s0[2]; acc[3] += wv * s0[3];
                acc[4] += wv * s1[0]; acc[5] += wv * s1[1]; acc[6] += wv * s1[2]; acc[7] += wv * s1[3]; acc[8] += wv * s2;
            }
#pragma unroll
            for (int b = 0; b < 9; ++b) *(f32x4*)(modp + (((size_t)ks * DEPTH + L) * 9 + b) * MODW + cg * 256 + lane * 4) = acc[b];
            LDS_WAIT(); asm volatile("" ::: "memory");
        }
    }
    {
        constexpr int I_F = (D / 64) * (D / 32);
        constexpr int I_I = (D / 64) * (INW / 32);
        constexpr int I_O = (DI / 64) * (D / 32);
        constexpr int I_U = (D / 64) * (2 * DFF / 32);
        constexpr int I_D = (DFF / 64) * (D / 32);
        constexpr int NIT = I_F + 2 * I_U + 2 * I_D; (void)I_I; (void)I_O;
        for (int it = gw; it < NIT; it += NGW) {
            int r = it;
            if (r < I_F) { const int nblk = D / 32, kb = r / nblk, nb = r % nblk;
                p0_transpose_item(F.in[I_FOURW], D, D, (bf16_t*)(ws + WS_WFOUR), 64 * kb, 32 * nb, 32 * nb, scr, lane); continue; } r -= I_F;
            if (r < 2 * I_U) { const int jj = r / I_U; r -= jj * I_U; const int j = jj * (DEPTH - 1); const int nblk = 2 * DFF / 32, kb = r / nblk, nb = r % nblk;
                p0_transpose_item(F.in[I_WUP] + (size_t)j * D * 2 * DFF, D, 2 * DFF, (bf16_t*)(ws + WS_WUP) + (size_t)j * 2 * DFF * D, 64 * kb, 32 * nb, 32 * nb, scr, lane); continue; } r -= 2 * I_U;
            { const int jj = r / I_D; r -= jj * I_D; const int j = 2 * jj; const int nblk = D / 32, kb = r / nblk, nb = r % nblk;
                p0_transpose_item(F.in[I_WDN] + (size_t)j * DFF * D, DFF, D, (bf16_t*)(ws + WS_WDN) + (size_t)j * D * DFF, 64 * kb, 32 * nb, 32 * nb, scr, lane); }
        }
    }
    const size_t gt = (size_t)blockIdx.x * 512 + F.tid, NT = (size_t)F.G * 512;
    for (size_t i = gt; i < (size_t)2 * 128 * D / 8; i += NT) { const size_t j = i / (128 * D / 8), e = i % (128 * D / 8);
        *(u32x4*)((bf16_t*)(ws + WS_WIN) + ((size_t)j * INP + INW) * D + e * 8) = (u32x4){0u, 0u, 0u, 0u}; }
    {
        bf16_t* W1 = (bf16_t*)(ws + WS_W1);
        for (size_t i = gt; i < (size_t)512 * 256 / 2; i += NT) { const int m = (int)(i / 128), c0 = (int)(i % 128) * 2; float v[2];
#pragma unroll
            for (int e = 0; e < 2; ++e) { const int idx = ((m & 255) * (c0 + e)) & 255; const float a = (float)idx * (1.0f / 128.0f); v[e] = (m < 256) ? cospif(a) : sinpif(a); }
            *(unsigned*)(W1 + (size_t)m * 256 + c0) = cvt_pk_bf16(v[0], v[1]); }
        bf16_t* W2c = (bf16_t*)(ws + WS_W2C);
        for (size_t i = gt; i < (size_t)256 * 512 / 2; i += NT) { const int k1 = (int)(i / 256), c0 = (int)(i % 256) * 2; float v[2];
#pragma unroll
            for (int e = 0; e < 2; ++e) { const int cc = c0 + e, l = cc & 255; const int idx = (k1 * l) & 255; const float a = (float)idx * (1.0f / 128.0f); v[e] = ((cc < 256) ? cospif(a) : -sinpif(a)) * (1.0f / 256.0f); }
            *(unsigned*)(W2c + (size_t)k1 * 512 + c0) = cvt_pk_bf16(v[0], v[1]); }
        bf16_t* W2 = (bf16_t*)(ws + WS_W2); const float sc = 0.0013810679320049757f;
        for (size_t i = gt; i < (size_t)256 * 512 / 2; i += NT) { const int k2 = (int)(i / 256), c0 = (int)(i % 256) * 2; float v[2];
#pragma unroll
            for (int e = 0; e < 2; ++e) { const int cc = c0 + e, l = cc & 255; const int idx = (k2 * l) & 255; const float a = (float)idx * (1.0f / 128.0f); v[e] = ((cc < 256) ? cospif(a) : sinpif(a)) * sc; }
            *(unsigned*)(W2 + (size_t)k2 * 512 + c0) = cvt_pk_bf16(v[0], v[1]); }
    }
}
__device__ __forceinline__ void tail_convert(Frame& F, int total_units, const float* W0, bf16_t* WT0, int K0, int N0, int perm0, const float* W1, bf16_t* WT1, int K1, int N1) {
    const int rem = total_units % F.G;
    if ((int)blockIdx.x < rem) return;
    const int lane = fresh_lane();
    LAS float* scr = (LAS float*)(F.lds + F.wave * 16384);
    const int slot = ((int)blockIdx.x - rem) * NWAVES + F.wave, nslots = (F.G - rem) * NWAVES;
    const int n0 = (K0 / 64) * (N0 / 32), n1 = (K1 / 64) * (N1 / 32);
    const int kk = lane >> 3, nq = (lane & 7) * 4, c = lane & 7;
#define TC_ITEM(it_, W_, WT_, K_, N_, k0_, n0_, dr_) do { const bool first_ = (it_) < n0; const int r_ = first_ ? (it_) : (it_) - n0; \
        W_ = first_ ? W0 : W1; WT_ = first_ ? WT0 : WT1; K_ = first_ ? K0 : K1; N_ = first_ ? N0 : N1; \
        const int nblk_ = N_ / 32, kb_ = r_ / nblk_, nb_ = r_ - kb_ * nblk_; k0_ = 64 * kb_; n0_ = 32 * nb_; dr_ = (first_ && perm0) ? win_dst_row(32 * nb_) : 32 * nb_; } while (0)
    f32x4 v[8];
    int it = slot;
    if (it < n0 + n1) { const float* W; bf16_t* WT; int K, N, k0, nn0, dr; TC_ITEM(it, W, WT, K, N, k0, nn0, dr); (void)WT; (void)K; (void)dr;
#pragma unroll
        for (int i = 0; i < 8; ++i) v[i] = __builtin_nontemporal_load((const f32x4*)(W + (size_t)(k0 + 8 * i + kk) * N + nn0 + nq)); }
    for (; it < n0 + n1; it += nslots) {
        const float* W; bf16_t* WT; int K, N, k0, nn0, dr; TC_ITEM(it, W, WT, K, N, k0, nn0, dr); (void)W;
#pragma unroll
        for (int i = 0; i < 8; ++i) { LAS float* d = scr + (8 * i + kk) * 33 + nq; d[0] = v[i].x; d[1] = v[i].y; d[2] = v[i].z; d[3] = v[i].w; }
        const int itn = it + nslots;
        if (itn < n0 + n1) { const float* Wn; bf16_t* WTn; int Kn, Nn, k0n, n0n, drn; TC_ITEM(itn, Wn, WTn, Kn, Nn, k0n, n0n, drn); (void)WTn; (void)Kn; (void)drn;
#pragma unroll
            for (int i = 0; i < 8; ++i) v[i] = __builtin_nontemporal_load((const f32x4*)(Wn + (size_t)(k0n + 8 * i + kk) * Nn + n0n + nq)); }
        LDS_WAIT(); asm volatile("" ::: "memory");
#pragma unroll
        for (int j = 0; j < 4; ++j) { const int n = (lane >> 3) + 8 * j; const LAS float* sp = scr + (8 * c) * 33 + n;
            u32x4 o; o.x = cvt_pk_bf16(sp[0 * 33], sp[1 * 33]); o.y = cvt_pk_bf16(sp[2 * 33], sp[3 * 33]); o.z = cvt_pk_bf16(sp[4 * 33], sp[5 * 33]); o.w = cvt_pk_bf16(sp[6 * 33], sp[7 * 33]);
            *(u32x4*)(WT + (size_t)(dr + n) * K + k0 + 8 * c) = o; }
        LDS_WAIT(); asm volatile("" ::: "memory");
    }
#undef TC_ITEM
}
__device__ __forceinline__ void p0b_modreduce(Frame& F) {
    fresh_ids(F);
    const size_t gt = (size_t)blockIdx.x * 512 + F.tid, NT = (size_t)F.G * 512;
    const float* modp = (const float*)(F.ws + WS_MODP); float* mod = (float*)(F.ws + WS_MOD); const float* bm = F.in[I_BMOD];
    constexpr size_t PER = (size_t)DEPTH * 9 * MODW;
    for (size_t i = gt; i < PER / 4; i += NT) { const size_t e = i * 4; const int n = (int)(e % MODW), L = (int)(e / ((size_t)9 * MODW));
        f32x4 s = *(const f32x4*)(bm + (size_t)L * MODW + n);
#pragma unroll
        for (int ks = 0; ks < 8; ++ks) s += *(const f32x4*)(modp + (size_t)ks * PER + e);
        *(f32x4*)(mod + e) = s; }
}

__device__ __forceinline__ void norm_mod_phase(Frame& F, int L, const float* gvec, int sh_chunk, int nrows, const float* pg, const float* pg2, const float* xlat, const float* xctx) {
    fresh_ids(F);
    const int G_ = F.G, wg = (int)blockIdx.x, latper = (MLAT + G_ - 1) / G_, nctx = nrows - MLAT, ctxper = (nctx + G_ - 1) / G_;
    const int l0 = wg * latper < MLAT ? wg * latper : MLAT, l1 = l0 + latper < MLAT ? l0 + latper : MLAT;
    const int c0 = MLAT + (wg * ctxper < nctx ? wg * ctxper : nctx), c1 = MLAT + ((wg + 1) * ctxper < nctx ? (wg + 1) * ctxper : nctx);
    const int b0 = l0 >> 11, nbl = l1 > l0 ? ((l1 - 1) >> 11) - b0 + 1 : 0;
    const float* mod = (const float*)(F.ws + WS_MOD) + (size_t)L * 9 * MODW; bf16_t* A = (bf16_t*)(F.ws + WS_A);
    LAS float* V = (LAS float*)F.lds;
    for (int i = F.tid; i < 3 * 512; i += NWAVES * 64) { const int bs = i >> 9, c4 = i & 511, b = bs < 2 ? b0 + bs : 8;
        if (bs < 2 ? (bs < nbl) : (c1 > c0)) {
            const f32x4 g = ((const f32x4*)gvec)[c4], sh = ((const f32x4*)(mod + (size_t)b * MODW + sh_chunk * D))[c4], sc = ((const f32x4*)(mod + (size_t)b * MODW + sh_chunk * D + D))[c4];
            LAS f32x4* d = (LAS f32x4*)(V + (size_t)bs * 4 * D) + c4;
            d[0] = g * (sc + 1.0f); d[D / 4] = sh;
            if (pg != nullptr) d[2 * (D / 4)] = ((const f32x4*)(((b == 8 && pg2 != nullptr) ? pg2 : pg) + (size_t)b * MODW))[c4];
            if (pg2 != nullptr) d[3 * (D / 4)] = ((const f32x4*)(pg2 + (size_t)b * MODW))[c4]; } }
    __syncthreads();
    const int lane = F.lane, nl = l1 - l0, ntot = nl + (c1 - c0);
    for (int i = F.wave; i < ntot; i += NWAVES) {
        const int r = i < nl ? l0 + i : c0 + (i - nl);
        const LAS f32x4* vq = (const LAS f32x4*)(V + (size_t)(r < MLAT ? (r >> 11) - b0 : 2) * 4 * D) + lane;
        f32x4 v[8]; float ss = 0.f;
        if (r < MLAT && xlat == nullptr) {
            const u32x2* xb = (const u32x2*)((const bf16_t*)(F.ws + WS_XB) + (size_t)r * D) + lane;
#pragma unroll
            for (int j = 0; j < 8; ++j) { const u32x2 w = __builtin_nontemporal_load(xb + 64 * j); v[j] = (f32x4){bf_lo(w.x), bf_hi(w.x), bf_lo(w.y), bf_hi(w.y)}; }
        } else if (r >= MLAT && xctx == nullptr) {
            const u32x2* xb = (const u32x2*)((const bf16_t*)(F.ws + WS_XC) + (size_t)(r - MLAT) * D) + lane;
#pragma unroll
            for (int j = 0; j < 8; ++j) { const u32x2 w = __builtin_nontemporal_load(xb + 64 * j); v[j] = (f32x4){bf_lo(w.x), bf_hi(w.x), bf_lo(w.y), bf_hi(w.y)}; }
        } else {
            const f32x4* xr = (const f32x4*)(r < MLAT ? xlat + (size_t)r * D : xctx + (size_t)(r - MLAT) * D) + lane;
#pragma unroll
            for (int j = 0; j < 8; ++j) v[j] = __builtin_nontemporal_load(xr + 64 * j);
        }
        if (pg != nullptr && r < MLAT) {
            const u32x2* yp = (const u32x2*)((const bf16_t*)(F.ws + WS_Y) + (size_t)r * D) + lane; const LAS f32x4* gq = vq + 2 * (D / 4);
#pragma unroll
            for (int j = 0; j < 8; ++j) { const u32x2 yy = __builtin_nontemporal_load(yp + 64 * j); const f32x4 y4 = {bf_lo(yy.x), bf_hi(yy.x), bf_lo(yy.y), bf_hi(yy.y)}; v[j] += gq[64 * j] * y4; }
        }
        if (pg2 != nullptr && r < MLAT) {
            const u32x2* yp = (const u32x2*)((const bf16_t*)(F.ws + WS_Y2) + (size_t)r * D) + lane; const LAS f32x4* gq = vq + 3 * (D / 4); u32x2* xw_ = (u32x2*)((bf16_t*)(F.ws + WS_XB) + (size_t)r * D) + lane;
#pragma unroll
            for (int j = 0; j < 8; ++j) { const u32x2 yy = __builtin_nontemporal_load(yp + 64 * j); const f32x4 y4 = {bf_lo(yy.x), bf_hi(yy.x), bf_lo(yy.y), bf_hi(yy.y)}; v[j] += gq[64 * j] * y4; u32x2 w; w.x = cvt_pk_bf16(v[j].x, v[j].y); w.y = cvt_pk_bf16(v[j].z, v[j].w); xw_[64 * j] = w; }
        }
        if (pg != nullptr && r >= MLAT) {
            const u32x2* pp = (const u32x2*)((const bf16_t*)(F.ws + WS_PART) + (size_t)(r - MLAT) * D) + lane; const LAS f32x4* gq = vq + 2 * (D / 4); u32x2* xw_ = (u32x2*)((bf16_t*)(F.ws + WS_XC) + (size_t)(r - MLAT) * D) + lane;
#pragma unroll
            for (int j = 0; j < 8; ++j) { f32x4 p = {0.f, 0.f, 0.f, 0.f};
#pragma unroll
                for (int q = 0; q < 4; ++q) { const u32x2 w = pp[64 * j + (size_t)q * MCTX * D / 4]; p += (f32x4){bf_lo(w.x), bf_hi(w.x), bf_lo(w.y), bf_hi(w.y)}; }
                v[j] += gq[64 * j] * p; u32x2 w; w.x = cvt_pk_bf16(v[j].x, v[j].y); w.y = cvt_pk_bf16(v[j].z, v[j].w); xw_[64 * j] = w; }
        }
#pragma unroll
        for (int j = 0; j < 8; ++j) ss += (v[j].x * v[j].x + v[j].y * v[j].y) + (v[j].z * v[j].z + v[j].w * v[j].w);
        const float rstd = rsqrtf(wave_sum(ss, lane) * (1.0f / D) + EPS);
        u32x2* o = (u32x2*)(A + (size_t)r * D) + lane;
#pragma unroll
        for (int j = 0; j < 8; ++j) { const f32x4 y = v[j] * rstd * vq[64 * j] + vq[64 * j + D / 4];
            u32x2 w; w.x = cvt_pk_bf16(y.x, y.y); w.y = cvt_pk_bf16(y.z, y.w); o[64 * j] = w; }
    }
}
__device__ __forceinline__ void final_norm_phase(Frame& F) {
    fresh_ids(F);
    const int gw = blockIdx.x * NWAVES + F.wave, NGW = F.G * NWAVES, lane = F.lane;
    const f32x4* gp = (const f32x4*)F.in[I_FING] + lane;
    for (int r = gw; r < MLAT; r += NGW) {
        f32x4* xr = (f32x4*)(F.out + (size_t)r * D) + lane; const u32x2* xb = (const u32x2*)((const bf16_t*)(F.ws + WS_XB) + (size_t)r * D) + lane;
        const u32x2* yp = (const u32x2*)((const bf16_t*)(F.ws + WS_Y) + (size_t)r * D) + lane; const u32x2* yp2 = (const u32x2*)((const bf16_t*)(F.ws + WS_Y2) + (size_t)r * D) + lane;
        const f32x4* gq = (const f32x4*)((const float*)(F.ws + WS_MOD) + ((size_t)(DEPTH - 1) * 9 + (r >> 11)) * MODW + 2 * D) + lane; const f32x4* gq2 = gq + 3 * D / 4;
        f32x4 v[8]; float ss = 0.f;
#pragma unroll
        for (int j = 0; j < 8; ++j) { const u32x2 yy = __builtin_nontemporal_load(yp + 64 * j), y2 = __builtin_nontemporal_load(yp2 + 64 * j);
            const f32x4 y4 = {bf_lo(yy.x), bf_hi(yy.x), bf_lo(yy.y), bf_hi(yy.y)}, z4 = {bf_lo(y2.x), bf_hi(y2.x), bf_lo(y2.y), bf_hi(y2.y)};
            const u32x2 xw = __builtin_nontemporal_load(xb + 64 * j); v[j] = (f32x4){bf_lo(xw.x), bf_hi(xw.x), bf_lo(xw.y), bf_hi(xw.y)} + gq[64 * j] * y4; v[j] += gq2[64 * j] * z4;
            ss += (v[j].x * v[j].x + v[j].y * v[j].y) + (v[j].z * v[j].z + v[j].w * v[j].w); }
        const float rstd = rsqrtf(wave_sum(ss, lane) * (1.0f / D) + EPS);
#pragma unroll
        for (int j = 0; j < 8; ++j) xr[64 * j] = v[j] * rstd * gp[64 * j];
    }
}

__device__ __forceinline__ void unpack8(const u32x4 w, float (&f)[8]) {
    f[0] = bf_lo(w.x); f[1] = bf_hi(w.x); f[2] = bf_lo(w.y); f[3] = bf_hi(w.y); f[4] = bf_lo(w.z); f[5] = bf_hi(w.z); f[6] = bf_lo(w.w); f[7] = bf_hi(w.w);
}
__device__ __forceinline__ u32x4 pack8(const float (&f)[8]) { u32x4 w; w.x = cvt_pk_bf16(f[0], f[1]); w.y = cvt_pk_bf16(f[2], f[3]); w.z = cvt_pk_bf16(f[4], f[5]); w.w = cvt_pk_bf16(f[6], f[7]); return w; }

__device__ __forceinline__ void fft8_phase(Frame& F) {
    fresh_ids(F);
    const int gw = blockIdx.x * NWAVES + F.wave, NGW = F.G * NWAVES, lane = F.lane;
    const bf16_t* pqt = (const bf16_t*)(F.ws + WS_PQT); bf16_t* vt = (bf16_t*)(F.ws + WS_VT);
    float twc[8][4], tws[8][4];
#pragma unroll
    for (int k1 = 0; k1 < 8; ++k1)
#pragma unroll
        for (int e = 0; e < 4; ++e) { const int idx = (4 * lane + e) * k1; const float a = (float)idx * (1.0f / 1024.0f); twc[k1][e] = cospif(a); tws[k1][e] = sinpif(a); }
    constexpr float R2 = 0.70710678118654752f;
    for (int row = gw; row < NB * D; row += NGW) {
        const bf16_t* src = pqt + (size_t)row * 4096 + 4 * lane;
        u32x2 rp[8], rq[8];
#pragma unroll
        for (int l1 = 0; l1 < 8; ++l1) { rp[l1] = __builtin_nontemporal_load((const u32x2*)(src + 256 * l1)); rq[l1] = __builtin_nontemporal_load((const u32x2*)(src + 2048 + 256 * l1)); }
        const int b = row >> 11, n = row & 2047;
        bf16_t* dst = vt + (((size_t)b * 8) * 2048 + n) * 512 + 4 * lane;
        float vr[8][4], vi[8][4];
#pragma unroll
        for (int e = 0; e < 4; ++e) {
            float xr[8], xi[8];
#pragma unroll
            for (int l1 = 0; l1 < 8; ++l1) { const unsigned wp = (e < 2) ? rp[l1].x : rp[l1].y, wq = (e < 2) ? rq[l1].x : rq[l1].y; xr[l1] = (e & 1) ? bf_hi(wp) : bf_lo(wp); xi[l1] = -((e & 1) ? bf_hi(wq) : bf_lo(wq)); }
            const float a0r = xr[0] + xr[4], a0i = xi[0] + xi[4], a1r = xr[0] - xr[4], a1i = xi[0] - xi[4], a2r = xr[2] + xr[6], a2i = xi[2] + xi[6], a3r = xr[2] - xr[6], a3i = xi[2] - xi[6];
            const float a4r = xr[1] + xr[5], a4i = xi[1] + xi[5], a5r = xr[1] - xr[5], a5i = xi[1] - xi[5], a6r = xr[3] + xr[7], a6i = xi[3] + xi[7], a7r = xr[3] - xr[7], a7i = xi[3] - xi[7];
            const float b0r = a0r + a2r, b0i = a0i + a2i, b2r = a0r - a2r, b2i = a0i - a2i, b1r = a1r + a3i, b1i = a1i - a3r, b3r = a1r - a3i, b3i = a1i + a3r;
            const float c0r = a4r + a6r, c0i = a4i + a6i, c2r = a4r - a6r, c2i = a4i - a6i, c1r = a5r + a7i, c1i = a5i - a7r, c3r = a5r - a7i, c3i = a5i + a7r;
            const float d1r = (c1r + c1i) * R2, d1i = (c1i - c1r) * R2, d2r = c2i, d2i = -c2r, d3r = (c3i - c3r) * R2, d3i = -(c3r + c3i) * R2;
            float yr[8], yi[8];
            yr[0] = b0r + c0r; yi[0] = b0i + c0i; yr[4] = b0r - c0r; yi[4] = b0i - c0i;
            yr[1] = b1r + d1r; yi[1] = b1i + d1i; yr[5] = b1r - d1r; yi[5] = b1i - d1i;
            yr[2] = b2r + d2r; yi[2] = b2i + d2i; yr[6] = b2r - d2r; yi[6] = b2i - d2i;
            yr[3] = b3r + d3r; yi[3] = b3i + d3i; yr[7] = b3r - d3r; yi[7] = b3i - d3i;
#pragma unroll
            for (int k1 = 0; k1 < 8; ++k1) { const float c = twc[k1][e], sn = tws[k1][e]; vr[k1][e] = yr[k1] * c + yi[k1] * sn; vi[k1][e] = yi[k1] * c - yr[k1] * sn; }
        }
#pragma unroll
        for (int k1 = 0; k1 < 8; ++k1) { u32x2 o; o.x = cvt_pk_bf16(vr[k1][0], vr[k1][1]); o.y = cvt_pk_bf16(vr[k1][2], vr[k1][3]); *(u32x2*)(dst + (size_t)k1 * 2048 * 512) = o;
            u32x2 p; p.x = cvt_pk_bf16(vi[k1][0], vi[k1][1]); p.y = cvt_pk_bf16(vi[k1][2], vi[k1][3]); *(u32x2*)(dst + (size_t)k1 * 2048 * 512 + 256) = p; }
    }
}

__device__ __forceinline__ void ssd_conv_phase(Frame& F, int j, bool skip_ctx_c) {
    fresh_ids(F);
    const int gw = blockIdx.x * NWAVES + F.wave, NGW = F.G * NWAVES, lane = F.lane, cq = lane & 7, tq = lane >> 3;
    const bf16_t* pre = (const bf16_t*)(F.ws + WS_XBCP);
    const float* cw = F.in[I_CONVW] + (size_t)j * 3 * XBC; const float* cb_ = F.in[I_CONVB] + (size_t)j * XBC;
    bf16_t* xst = (bf16_t*)(F.ws + WS_XST); bf16_t* bm = (bf16_t*)(F.ws + WS_BM); bf16_t* bmt = (bf16_t*)(F.ws + WS_BMT); bf16_t* cm = (bf16_t*)(F.ws + WS_CM);
    constexpr int NTB = MALL / 64, NCB = XBC / 64;
    for (int job = gw; job < NTB * NCB; job += NGW) {
        const int cb = job % NCB, tb = job / NCB;
        const int rb = tb * 64;
        if (skip_ctx_c && rb >= MLAT && cb >= 80) continue;
        int seq0, T, sb;
        if (rb < MLAT) { sb = rb >> 11; seq0 = sb << 11; T = LSEQ; } else { sb = (rb - MLAT) >> 8; seq0 = MLAT + (sb << 8); T = LCTX; }
        const int tl = rb - seq0 + tq * 8;
        const int c0 = cb * 64 + cq * 8;
        float w0[8], w1[8], w2[8], bi[8];
        { const f32x4* p = (const f32x4*)(cw + c0); const f32x4 a = p[0], b = p[1]; w0[0] = a.x; w0[1] = a.y; w0[2] = a.z; w0[3] = a.w; w0[4] = b.x; w0[5] = b.y; w0[6] = b.z; w0[7] = b.w; }
        { const f32x4* p = (const f32x4*)(cw + XBC + c0); const f32x4 a = p[0], b = p[1]; w1[0] = a.x; w1[1] = a.y; w1[2] = a.z; w1[3] = a.w; w1[4] = b.x; w1[5] = b.y; w1[6] = b.z; w1[7] = b.w; }
        { const f32x4* p = (const f32x4*)(cw + 2 * XBC + c0); const f32x4 a = p[0], b = p[1]; w2[0] = a.x; w2[1] = a.y; w2[2] = a.z; w2[3] = a.w; w2[4] = b.x; w2[5] = b.y; w2[6] = b.z; w2[7] = b.w; }
        { const f32x4* p = (const f32x4*)(cb_ + c0); const f32x4 a = p[0], b = p[1]; bi[0] = a.x; bi[1] = a.y; bi[2] = a.z; bi[3] = a.w; bi[4] = b.x; bi[5] = b.y; bi[6] = b.z; bi[7] = b.w; }
        u32x4 raw[10];
#pragma unroll
        for (int i = 0; i < 10; ++i) { const int tt = tl - 1 + i; raw[i] = (tt >= 0 && tt < T) ? *(const u32x4*)(pre + (size_t)(seq0 + tt) * XBC + c0) : (u32x4){0u, 0u, 0u, 0u}; }
        float o[8][8];
        { float pa[8], pb[8], pc[8]; unpack8(raw[0], pa); unpack8(raw[1], pb);
#pragma unroll
          for (int i = 0; i < 8; ++i) { unpack8(raw[i + 2], pc);
#pragma unroll
              for (int c = 0; c < 8; ++c) o[i][c] = silu_f(bi[c] + w0[c] * pa[c] + w1[c] * pb[c] + w2[c] * pc[c]);
#pragma unroll
              for (int c = 0; c < 8; ++c) { pa[c] = pb[c]; pb[c] = pc[c]; } } }
        if (cb < 64) {
            bf16_t* dst = (rb < MLAT) ? xst + ((size_t)sb * DI + c0) * LSEQ + tl : xst + (size_t)NB * DI * LSEQ + ((size_t)sb * DI + c0) * LCTX + tl;
#pragma unroll
            for (int c = 0; c < 8; ++c) { float t8[8];
#pragma unroll
                for (int i = 0; i < 8; ++i) t8[i] = o[i][c];
                *(u32x4*)(dst + (size_t)c * T) = pack8(t8); }
        } else if (cb < 80) {
            const int cc = c0 - DI;
#pragma unroll
            for (int i = 0; i < 8; ++i) *(u32x4*)(bm + (size_t)(seq0 + tl + i) * GNW + cc) = pack8(o[i]);
            bf16_t* dst = (rb < MLAT) ? bmt + ((size_t)sb * GNW + cc) * LSEQ + tl : bmt + (size_t)NB * GNW * LSEQ + ((size_t)sb * GNW + cc) * LCTX + tl;
#pragma unroll
            for (int c = 0; c < 8; ++c) { float t8[8];
#pragma unroll
                for (int i = 0; i < 8; ++i) t8[i] = o[i][c];
                *(u32x4*)(dst + (size_t)c * T) = pack8(t8); }
        } else {
            const int cc = c0 - DI - GNW;
#pragma unroll
            for (int i = 0; i < 8; ++i) *(u32x4*)(cm + (size_t)(seq0 + tl + i) * GNW + cc) = pack8(o[i]);
        }
    }
}

__device__ __forceinline__ void ffn_conv_phase(Frame& F, int L, int nrows, bool probe_alt = false) {
    fresh_ids(F);
    const int gw = blockIdx.x * NWAVES + F.wave, NGW = F.G * NWAVES;
    const bf16_t* gate = (const bf16_t*)(F.ws + WS_GATE); bf16_t* val = (bf16_t*)(F.ws + WS_VAL);
    const float* cw = F.in[I_FCW] + (size_t)L * 9 * DFF; const float* cb_ = F.in[I_FCB] + (size_t)L * DFF;
    const int NTB = nrows / 64; constexpr int NCB = DFF / 64;
    for (int job = gw; job < NTB * NCB; job += NGW) {
        const int lane = fresh_lane(), cq = lane & 7, tq = lane >> 3;
        const int cb = job / NTB, tb = job % NTB;
        const int rb = tb * 64, c0 = cb * 64 + cq * 8;
        const bool lat = rb < MLAT;
        const int gr = lat ? (tb & 31) : 0, base = lat ? (rb - gr * 64) : (MLAT + (((rb - MLAT) >> 8) << 8)), q = lat ? 0 : (((rb - MLAT) >> 6) & 3);
        u32x4 raw[3][10], rv[8];
#define FFN_LOAD_ROW(dr) do { const bool rowok_ = lat ? (gr + (dr) - 1 >= 0 && gr + (dr) - 1 < 32) : ((dr) == 1); const int rbase_ = lat ? base + (gr + (dr) - 1) * 64 : base + q * 64; \
            _Pragma("unroll") for (int i_ = 0; i_ < 10; ++i_) { const int col_ = tq * 8 - 1 + i_; const bool ok_ = rowok_ && (lat ? (col_ >= 0 && col_ < 64) : (q * 64 + col_ >= 0 && q * 64 + col_ < LCTX)); \
                raw[dr][i_] = ok_ ? *(const u32x4*)(gate + (size_t)(rbase_ + col_) * DFF + c0) : (u32x4){0u, 0u, 0u, 0u}; } } while (0)
#define FFN_UNPK(w4_, p_) do { p_[0] = (f32x2){bf_lo(w4_.x), bf_hi(w4_.x)}; p_[1] = (f32x2){bf_lo(w4_.y), bf_hi(w4_.y)}; p_[2] = (f32x2){bf_lo(w4_.z), bf_hi(w4_.z)}; p_[3] = (f32x2){bf_lo(w4_.w), bf_hi(w4_.w)}; } while (0)
#define FFN_ACC_ROW(dr) do { f32x2 w_[3][4]; \
            _Pragma("unroll") for (int dc_ = 0; dc_ < 3; ++dc_) { const f32x4* p_ = (const f32x4*)(cw + (size_t)((dr) * 3 + dc_) * DFF + c0); const f32x4 a_ = p_[0], b_ = p_[1]; \
                w_[dc_][0] = (f32x2){a_.x, a_.y}; w_[dc_][1] = (f32x2){a_.z, a_.w}; w_[dc_][2] = (f32x2){b_.x, b_.y}; w_[dc_][3] = (f32x2){b_.z, b_.w}; } \
            f32x2 pa_[4], pb_[4], pc_[4]; FFN_UNPK(raw[dr][0], pa_); FFN_UNPK(raw[dr][1], pb_); \
            _Pragma("unroll") for (int i_ = 0; i_ < 8; ++i_) { FFN_UNPK(raw[dr][i_ + 2], pc_); \
                _Pragma("unroll") for (int c_ = 0; c_ < 4; ++c_) { acc[i_][c_] += w_[0][c_] * pa_[c_]; acc[i_][c_] += w_[1][c_] * pb_[c_]; acc[i_][c_] += w_[2][c_] * pc_[c_]; }     \
                _Pragma("unroll") for (int c_ = 0; c_ < 4; ++c_) { pa_[c_] = pb_[c_]; pb_[c_] = pc_[c_]; } } } while (0)
        FFN_LOAD_ROW(0); FFN_LOAD_ROW(1);
        f32x2 acc[8][4];
        { const f32x4* p = (const f32x4*)(cb_ + c0); const f32x4 a = p[0], b = p[1];
#pragma unroll
          for (int i = 0; i < 8; ++i) { acc[i][0] = (f32x2){a.x, a.y}; acc[i][1] = (f32x2){a.z, a.w}; acc[i][2] = (f32x2){b.x, b.y}; acc[i][3] = (f32x2){b.z, b.w}; } }
        FFN_ACC_ROW(0);
        FFN_LOAD_ROW(2);
#pragma unroll
        for (int i = 0; i < 8; ++i) rv[i] = __builtin_nontemporal_load((const u32x4*)(val + (size_t)(rb + tq * 8 + i) * DFF + c0));
        FFN_ACC_ROW(1);
        FFN_ACC_ROW(2);
#undef FFN_LOAD_ROW
#undef FFN_ACC_ROW
#undef FFN_UNPK
#pragma unroll
        for (int i = 0; i < 8; ++i) { bf16_t* vp = val + (size_t)(rb + tq * 8 + i) * DFF + c0; float v[8]; unpack8(rv[i], v);
#pragma unroll
            for (int c = 0; c < 4; ++c) { v[2 * c] *= silu_f(acc[i][c].x); v[2 * c + 1] *= silu_f(acc[i][c].y); }
            *(u32x4*)(probe_alt ? vp + (size_t)202 * MiB / 2 : vp) = pack8(v); }
    }
}

__device__ __forceinline__ void ssd_gate_norm_phase(Frame& F, int j, int nrows) {
    fresh_ids(F);
    const int gw = blockIdx.x * NWAVES + F.wave, NGW = F.G * NWAVES, lane = F.lane;
    bf16_t* yf = (bf16_t*)(F.ws + WS_XBCP); const bf16_t* yb = (const bf16_t*)(F.ws + WS_YB); const bf16_t* z = (const bf16_t*)(F.ws + WS_Z);
    const float* ng = F.in[I_SNG] + (size_t)j * DI;
    for (int r = gw; r < nrows; r += NGW) {
#pragma unroll 4
        for (int g = 0; g < 8; ++g) { const size_t off = (size_t)r * DI + g * 512 + lane * 8;
            float a[8], b[8], zz[8]; unpack8(__builtin_nontemporal_load((const u32x4*)(yf + off)), a); unpack8(__builtin_nontemporal_load((const u32x4*)(yb + off)), b); unpack8(__builtin_nontemporal_load((const u32x4*)(z + off)), zz);
            float ss = 0.f;
#pragma unroll
            for (int c = 0; c < 8; ++c) { a[c] = (a[c] + b[c]) * silu_f(zz[c]); ss += a[c] * a[c]; }
            const float rs = rsqrtf(wave_sum(ss, lane) * (1.0f / 512.0f) + EPS);
            const f32x4* gp = (const f32x4*)(ng + g * 512 + lane * 8); const f32x4 g0 = gp[0], g1 = gp[1];
            a[0] *= rs * g0.x; a[1] *= rs * g0.y; a[2] *= rs * g0.z; a[3] *= rs * g0.w; a[4] *= rs * g1.x; a[5] *= rs * g1.y; a[6] *= rs * g1.z; a[7] *= rs * g1.w;
            *(u32x4*)(yf + off) = pack8(a); }
    }
}

__device__ __forceinline__ float softplus_f(float x) { return x > 15.f ? x : __logf(1.0f + __expf(x)); }
__device__ __forceinline__ float incl_scan64(float v, int lane) {
    (void)lane;
#define ISC_SHR(c) v += __builtin_bit_cast(float, __builtin_amdgcn_update_dpp(0, __builtin_bit_cast(int, v), c, 0xf, 0xf, true))
    ISC_SHR(0x111); ISC_SHR(0x112); ISC_SHR(0x114); ISC_SHR(0x118);
#undef ISC_SHR
    v += __builtin_bit_cast(float, __builtin_amdgcn_update_dpp(0, __builtin_bit_cast(int, v), 0x142, 0xa, 0xf, false));
    v += __builtin_bit_cast(float, __builtin_amdgcn_update_dpp(0, __builtin_bit_cast(int, v), 0x143, 0xc, 0xf, false));
    return v;
}
template <int MODE> __device__ __forceinline__ void ssd_scan_phase(Frame& F, int j, bool ctx_out) {
    fresh_ids(F);
    const int w = F.wave;
    LAS unsigned char* CS = F.lds; LAS unsigned char* R0 = F.lds + 32768; LAS unsigned char* R1 = F.lds + 65536;
    LAS float* tab = (LAS float*)(F.lds + 98304 + w * 2048);
    const bf16_t* cm = (const bf16_t*)(F.ws + WS_CM); const bf16_t* bm = (const bf16_t*)(F.ws + WS_BM); const bf16_t* bmt = (const bf16_t*)(F.ws + WS_BMT); const bf16_t* xst = (const bf16_t*)(F.ws + WS_XST);
    const float* dtb = (const float*)(F.ws + WS_DT);
#define SCAN_DMA(dstbase, srcptr_row0, pitch_elems) do { _Pragma("unroll") for (int q_ = 0; q_ < 4; ++q_) { const int idx_ = tid + 512 * q_, row_ = idx_ >> 4, c16_ = (idx_ & 15) ^ (row_ & 15); \
        __builtin_amdgcn_global_load_lds((const unsigned*)((srcptr_row0) + (size_t)row_ * (pitch_elems) + c16_ * 8), (LAS unsigned*)((dstbase) + (w * 64 + 512 * q_) * 16), 16, 0, 0); } } while (0)
    for (int item = blockIdx.x; item < 256; item += F.G) {
        const int ph = item & 1, dir = (item >> 1) & 1, g = (item >> 2) & 7, b = item >> 5, h = g * 8 + w;
        const float a_h = -expf(F.in[I_ALOG][(j * 2 + dir) * NH + h]) * LOG2E;
        const float dtbias = F.in[I_DTB][(j * 2 + dir) * NH + h];
        const float dsk = dir == 0 ? F.in[I_DSK][(j * 2 + 0) * NH + h] + F.in[I_DSK][(j * 2 + 1) * NH + h] : 0.f;
        bf16_t* yout = dir == 0 ? (bf16_t*)(F.ws + WS_XBCP) : (bf16_t*)(F.ws + WS_YB);
        f32x4 hT[8][2];
#pragma unroll
        for (int nt = 0; nt < 8; ++nt) { hT[nt][0] = (f32x4){0.f, 0.f, 0.f, 0.f}; hT[nt][1] = (f32x4){0.f, 0.f, 0.f, 0.f}; }
        {
            const int tid0 = w * 64 + fresh_lane(); const int tid = tid0;
            const bool isctx0 = true; const int cc0 = dir == 0 ? 0 : 1; const int row00 = MLAT + b * LCTX + cc0 * 128;
            if (ctx_out && !(MODE & 8) && isctx0) { SCAN_DMA(CS, cm + (size_t)row00 * GNW + g * 128, GNW); SCAN_DMA(R0, bm + (size_t)row00 * GNW + g * 128, GNW); }
        }
        float dtr0, dtr1;
        { const int lane0 = fresh_lane(); const int cc0 = dir == 0 ? 0 : 1, row00 = MLAT + b * LCTX + cc0 * 128;
          dtr0 = dtb[(size_t)(row00 + lane0) * 128 + dir * 64 + h]; dtr1 = dtb[(size_t)(row00 + 64 + lane0) * 128 + dir * 64 + h]; }
        bf16x8 xf[2][4];
        { const int lane0 = fresh_lane(), fr0 = lane0 & 15, fq0 = lane0 >> 4; const int cc0 = dir == 0 ? 0 : 1;
          const bf16_t* xl0 = xst + (size_t)NB * DI * LSEQ + ((size_t)(b * DI + h * 64 + ph * 32)) * LCTX + cc0 * 128 + (size_t)fr0 * LCTX + 8 * fq0;
#pragma unroll
          for (int pt = 0; pt < 2; ++pt)
#pragma unroll
              for (int ks = 0; ks < 4; ++ks) xf[pt][ks] = *(const bf16x8*)(xl0 + (size_t)(16 * pt) * LCTX + 32 * ks); }
        for (int k = 0; k < 18; ++k) {
            const bool isctx = k < 2; const int cc = isctx ? (dir == 0 ? k : 1 - k) : (dir == 0 ? k - 2 : 17 - k);
            const int row0 = isctx ? MLAT + b * LCTX + cc * 128 : b * LSEQ + cc * 128, T = isctx ? LCTX : LSEQ;
            const bf16_t* xp = isctx ? xst + (size_t)NB * DI * LSEQ + ((size_t)(b * DI + h * 64 + ph * 32)) * LCTX + cc * 128 : xst + ((size_t)(b * DI + h * 64 + ph * 32)) * LSEQ + cc * 128;
            const bf16_t* btp = isctx ? bmt + (size_t)NB * GNW * LSEQ + ((size_t)(b * GNW + g * 128)) * LCTX + cc * 128 : bmt + ((size_t)(b * GNW + g * 128)) * LSEQ + cc * 128;
            const bool need_y = ctx_out || !isctx;
            LAS unsigned char* BS = (k & 1) ? R1 : R0; LAS unsigned char* GS = (k & 1) ? R0 : R1;
            const int lane = fresh_lane(), fr = lane & 15, fq = lane >> 4, tid = w * 64 + lane;
            const bf16_t* xl = xp + (size_t)fr * T + 8 * fq;
            float tot = -1.f;
            if (!(MODE & 16)) {
                const float dt0 = softplus_f(dtr0 + dtbias), dt1 = softplus_f(dtr1 + dtbias);
                const float dA0 = dt0 * a_h, dA1 = dt1 * a_h;
                const float p0 = incl_scan64(dA0, lane), tot0 = __builtin_bit_cast(float, __builtin_amdgcn_readlane(__builtin_bit_cast(int, p0), 63)), p1 = incl_scan64(dA1, lane) + tot0; tot = __builtin_bit_cast(float, __builtin_amdgcn_readlane(__builtin_bit_cast(int, p1), 63));
                const float c0 = dir == 0 ? p0 : tot - p0 + dA0, c1 = dir == 0 ? p1 : tot - p1 + dA1;
                tab[lane] = c0; tab[64 + lane] = c1; tab[128 + lane] = dt0; tab[192 + lane] = dt1;
                tab[256 + lane] = dt0 * exp2f(tot - c0); tab[320 + lane] = dt1 * exp2f(tot - c1);
                asm volatile("" ::: "memory");
                const int r0 = dir == 0 ? (lane | 31) : (lane & ~31);
                tab[384 + lane] = dt0 * __builtin_amdgcn_exp2f(tab[r0] - c0); tab[448 + lane] = dt1 * __builtin_amdgcn_exp2f(tab[64 + r0] - c1);
            }
            VM_WAIT(); __syncthreads();
            bf16x8 xs2[2][4];
#pragma unroll
            for (int ks = 0; ks < 4; ++ks) { const f32x4 fa = *(const LAS f32x4*)(tab + 384 + 32 * ks + 8 * fq), fb = *(const LAS f32x4*)(tab + 384 + 32 * ks + 8 * fq + 4);
#pragma unroll
                for (int pt = 0; pt < 2; ++pt) { float xv[8]; unpack8(__builtin_bit_cast(u32x4, xf[pt][ks]), xv);
                    xv[0] *= fa.x; xv[1] *= fa.y; xv[2] *= fa.z; xv[3] *= fa.w; xv[4] *= fb.x; xv[5] *= fb.y; xv[6] *= fb.z; xv[7] *= fb.w;
                    xs2[pt][ks] = __builtin_bit_cast(bf16x8, pack8(xv)); } }
            if (need_y && !(MODE & 2)) {
                bf16x8 cf[4];
#pragma unroll
                for (int ks = 0; ks < 4; ++ks) cf[ks] = *(const LAS bf16x8*)(CS + (16 * w + fr) * 256 + (((4 * ks + fq) ^ fr) << 4));
#pragma unroll 2
                for (int st = 0; st < 8; ++st) { f32x4 acc = (f32x4){0.f, 0.f, 0.f, 0.f};
#pragma unroll
                    for (int ks = 0; ks < 4; ++ks) { const bf16x8 bfr = *(const LAS bf16x8*)(BS + (16 * st + fr) * 256 + (((4 * ks + fq) ^ fr) << 4)); acc = __builtin_amdgcn_mfma_f32_16x16x32_bf16(bfr, cf[ks], acc, 0, 0, 0); }
                    u32x2 o; o.x = cvt_pk_bf16(acc[0], acc[1]); o.y = cvt_pk_bf16(acc[2], acc[3]);
                    *(LAS u32x2*)(GS + (16 * w + fr) * 256 + (((2 * st + (fq >> 1)) ^ fr) << 4) + (fq & 1) * 8) = o; }
            }
            __syncthreads();
            if (!(MODE & 8)) SCAN_DMA(BS, btp, T);
            if (need_y && !(MODE & 1)) {
                bf16x8 hf[2][4];
#pragma unroll
                for (int pt = 0; pt < 2; ++pt)
#pragma unroll
                    for (int q = 0; q < 4; ++q) { const f32x4 lo4 = hT[2 * q][pt], hi4 = hT[2 * q + 1][pt]; u32x4 o; o.x = cvt_pk_bf16(lo4[0], lo4[1]); o.y = cvt_pk_bf16(lo4[2], lo4[3]); o.z = cvt_pk_bf16(hi4[0], hi4[1]); o.w = cvt_pk_bf16(hi4[2], hi4[3]);
                        hf[pt][q] = __builtin_bit_cast(bf16x8, o); }
#pragma unroll 8
                for (int lt = 0; lt < 8; ++lt) {
                    const int l = 16 * lt + fr; const float cl = tab[l];
                    f32x4 accd[2], acco[2];
                    accd[0] = accd[1] = acco[0] = acco[1] = (f32x4){0.f, 0.f, 0.f, 0.f};
                    const int kd = lt >> 1;
                    const bf16x8 xa = *(const bf16x8*)(xl + 32 * kd), xb = *(const bf16x8*)(xl + (size_t)16 * T + 32 * kd);
#pragma unroll
                    for (int ks = 0; ks < 4; ++ks) {
                        const bool full = dir == 0 ? (ks < kd) : (ks > kd);
                        if (full) {
                            const bf16x8 gf = *(const LAS bf16x8*)(GS + l * 256 + (((4 * ks + fq) ^ fr) << 4));
                            const float f1 = __builtin_amdgcn_exp2f(cl - tab[dir == 0 ? 32 * ks + 31 : 32 * ks]);
                            const f32x4 z4 = (f32x4){0.f, 0.f, 0.f, 0.f};
                            const f32x4 t0 = __builtin_amdgcn_mfma_f32_16x16x32_bf16(xs2[0][ks], gf, z4, 0, 0, 0), t1 = __builtin_amdgcn_mfma_f32_16x16x32_bf16(xs2[1][ks], gf, z4, 0, 0, 0);
                            accd[0] += t0 * f1; accd[1] += t1 * f1;
                        }
                    }
#pragma unroll
                    for (int q = 0; q < 4; ++q) {
                        const u32x2 lo = *(const LAS u32x2*)(CS + l * 256 + (((4 * q + (fq >> 1)) ^ fr) << 4) + (fq & 1) * 8), hi = *(const LAS u32x2*)(CS + l * 256 + (((4 * q + 2 + (fq >> 1)) ^ fr) << 4) + (fq & 1) * 8);
                        u32x4 c4; c4.x = lo.x; c4.y = lo.y; c4.z = hi.x; c4.w = hi.y; const bf16x8 cfr = __builtin_bit_cast(bf16x8, c4);
                        acco[0] = __builtin_amdgcn_mfma_f32_16x16x32_bf16(hf[0][q], cfr, acco[0], 0, 0, 0);
                        acco[1] = __builtin_amdgcn_mfma_f32_16x16x32_bf16(hf[1][q], cfr, acco[1], 0, 0, 0);
                    }
                    {
                        float gg[8]; unpack8(*(const LAS u32x4*)(GS + l * 256 + (((4 * kd + fq) ^ fr) << 4)), gg);
                        const f32x4 ca = *(const LAS f32x4*)(tab + 32 * kd + 8 * fq), cb = *(const LAS f32x4*)(tab + 32 * kd + 8 * fq + 4);
                        const f32x4 da = *(const LAS f32x4*)(tab + 128 + 32 * kd + 8 * fq), db = *(const LAS f32x4*)(tab + 128 + 32 * kd + 8 * fq + 4);
                        const float cs[8] = {ca.x, ca.y, ca.z, ca.w, cb.x, cb.y, cb.z, cb.w}, ds[8] = {da.x, da.y, da.z, da.w, db.x, db.y, db.z, db.w};
                        float m[8];
#pragma unroll
                        for (int jj = 0; jj < 8; ++jj) { const int s = 32 * kd + 8 * fq + jj; const bool valid = dir == 0 ? (s <= l) : (s >= l);
                            const float e = valid ? __builtin_amdgcn_exp2f(cl - cs[jj]) : 0.f; m[jj] = gg[jj] * e * ds[jj]; if (dir == 0 && s == l) m[jj] += dsk; }
                        const bf16x8 mf = __builtin_bit_cast(bf16x8, pack8(m));
                        accd[0] = __builtin_amdgcn_mfma_f32_16x16x32_bf16(xa, mf, accd[0], 0, 0, 0);
                        accd[1] = __builtin_amdgcn_mfma_f32_16x16x32_bf16(xb, mf, accd[1], 0, 0, 0);
                    }
                    const float el = __builtin_amdgcn_exp2f(cl);
#pragma unroll
                    for (int pt = 0; pt < 2; ++pt) { const f32x4 y = accd[pt] + acco[pt] * el; u32x2 o; o.x = cvt_pk_bf16(y[0], y[1]); o.y = cvt_pk_bf16(y[2], y[3]);
                        *(u32x2*)(yout + (size_t)(row0 + l) * DI + h * 64 + ph * 32 + 16 * pt + 4 * fq) = o; }
                }
            }
            VM_WAIT(); __syncthreads();
            if (k + 1 < 18) {
                const int kn = k + 1; const bool isctxn = kn < 2; const int ccn = isctxn ? (dir == 0 ? kn : 1 - kn) : (dir == 0 ? kn - 2 : 17 - kn);
                const int row0n = isctxn ? MLAT + b * LCTX + ccn * 128 : b * LSEQ + ccn * 128;
                if ((ctx_out || !isctxn) && !(MODE & 8)) { SCAN_DMA(CS, cm + (size_t)row0n * GNW + g * 128, GNW); SCAN_DMA(GS, bm + (size_t)row0n * GNW + g * 128, GNW); }
                dtr0 = dtb[(size_t)(row0n + lane) * 128 + dir * 64 + h]; dtr1 = dtb[(size_t)(row0n + 64 + lane) * 128 + dir * 64 + h];

            }
            if (!(MODE & 4)) {
                const float dec = exp2f(tot);
#pragma unroll
                for (int nt = 0; nt < 8; ++nt) { hT[nt][0] *= dec; hT[nt][1] *= dec; }
                bf16x8 xw[2][4];
#pragma unroll
                for (int ks = 0; ks < 4; ++ks) { const float sck = __builtin_amdgcn_exp2f(tot - tab[dir == 0 ? 32 * ks + 31 : 32 * ks]);
#pragma unroll
                    for (int pt = 0; pt < 2; ++pt) { float xv[8]; unpack8(__builtin_bit_cast(u32x4, xs2[pt][ks]), xv);
#pragma unroll
                        for (int e = 0; e < 8; ++e) xv[e] *= sck;
                        xw[pt][ks] = __builtin_bit_cast(bf16x8, pack8(xv)); } }
                {
                    const int kn = k + 1 < 18 ? k + 1 : 17; const bool isctxn = kn < 2; const int ccn = isctxn ? (dir == 0 ? kn : 1 - kn) : (dir == 0 ? kn - 2 : 17 - kn); const int Tn = isctxn ? LCTX : LSEQ;
                    const bf16_t* xln = (isctxn ? xst + (size_t)NB * DI * LSEQ + ((size_t)(b * DI + h * 64 + ph * 32)) * LCTX + ccn * 128 : xst + ((size_t)(b * DI + h * 64 + ph * 32)) * LSEQ + ccn * 128) + (size_t)fr * Tn + 8 * fq;
#pragma unroll
                    for (int pt = 0; pt < 2; ++pt)
#pragma unroll
                        for (int ks = 0; ks < 4; ++ks) xf[pt][ks] = *(const bf16x8*)(xln + (size_t)(16 * pt) * Tn + 32 * ks); }
#pragma unroll
                for (int nt = 0; nt < 8; ++nt) {
#pragma unroll
                    for (int ks = 0; ks < 4; ++ks) { const bf16x8 bfr = *(const LAS bf16x8*)(BS + (16 * nt + fr) * 256 + (((4 * ks + fq) ^ fr) << 4));
                        hT[nt][0] = __builtin_amdgcn_mfma_f32_16x16x32_bf16(bfr, xw[0][ks], hT[nt][0], 0, 0, 0);
                        hT[nt][1] = __builtin_amdgcn_mfma_f32_16x16x32_bf16(bfr, xw[1][ks], hT[nt][1], 0, 0, 0); }
                    if (nt & 1) __builtin_amdgcn_sched_barrier(0);
                }
            }
        }
        __syncthreads();
    }
#undef SCAN_DMA
}

constexpr int N_PHASES = 43;
__host__ __device__ constexpr bool phase_exists(int p) {
    if (p < 2 || p == 42) return true;
    const int L = (p - 2) / 10, s = (p - 2) % 10;
    if (L & 1) return true;
    return s != 5;
}
__global__ void __launch_bounds__(NWAVES * 64, 2) trunk_fwd(Args args) {
    extern __shared__ __attribute__((aligned(16))) unsigned char lds_raw[];
    Frame F;
    F.lds = (LAS unsigned char*)lds_raw;
    F.tid = threadIdx.x; F.lane = F.tid & 63; F.wave = __builtin_amdgcn_readfirstlane(F.tid >> 6); F.G = gridDim.x;
    F.in = args.in; F.out = args.out; F.ws = args.ws;
    volatile LAS unsigned* MISC = (volatile LAS unsigned*)(F.lds + MISC_OFF);
    for (int u = F.tid; u < (LDS_BYTES - LDSCTL_OFF) / 4; u += NWAVES * 64) ((LAS unsigned*)(F.lds + LDSCTL_OFF))[u] = 0u;
    __syncthreads();
    const int lo = args.ph_lo, hi = args.ph_hi;
    XcdBarrier bar; bar.bar = (unsigned*)(F.ws + WS_CTL) + CW_BAR; bar.x = 0; bar.st = nullptr;
    if (hi - lo > 1) bar = xcd_barrier_post((unsigned*)(F.ws + WS_CTL) + CW_BAR, MISC + 8);
#ifndef ONLY_PHASE
#define ONLY_PHASE -1
#endif
#ifndef SKIP_PHASE
#define SKIP_PHASE -2
#endif
#ifndef REP_PHASE
#define REP_PHASE -3
#endif
#define PHON(id) ((id) != SKIP_PHASE && (ONLY_PHASE < 0 || ONLY_PHASE == (id)))
#define IN(k) (lo <= (k) && (k) < hi)
#define SEAM(k) do { if ((k) + 1 < hi) xcd_barrier(bar, F.wave == 0 && fresh_lane() == 0); } while (0)
    LAS unsigned char* ring = F.lds;

#define REPS(id) ((REP_PHASE == (id)) ? 2 : 1)
#define PHASE(id, k, ...) do { if (PHON(id) && IN(k)) { for (int rep_ = 0; rep_ < REPS(id); ++rep_) { __VA_ARGS__; if (rep_ + 1 < REPS(id)) xcd_barrier(bar, F.wave == 0 && fresh_lane() == 0); } SEAM(k); } } while (0)
    PHASE(0, 0, p0_prologue(F));
    PHASE(1, 1, p0b_modreduce(F));

    for (int L = 0; L < DEPTH; ++L) {
        const int pb = 2 + 10 * L; const bool ssd = (L & 1) != 0, last = (L == DEPTH - 1); const int j = L >> 1;
        if (hi <= pb || lo >= pb + 10) continue;
        const int nrows_ffn = last ? MLAT : MALL;
        PHASE(2, pb + 0, norm_mod_phase(F, L, F.in[I_NMIX] + (size_t)L * D, 0, MALL, L > 0 ? (const float*)(F.ws + WS_MOD) + (size_t)(L - 1) * 9 * MODW + 2 * D : nullptr, L > 0 ? (const float*)(F.ws + WS_MOD) + (size_t)(L - 1) * 9 * MODW + 5 * D : nullptr, L <= 1 ? F.in[I_X] : nullptr, L == 0 ? F.in[I_CTX] : nullptr));
        if (!ssd) {
            PHASE(3, pb + 1, { fresh_ids(F); SchedF1 S{F.ws}; pg8::EpiTile E; pg8::gemm_phase<pg8::EpiTile, SchedF1, false>(ring, F.wave, 256, D, 256, S, E); });
            PHASE(15, pb + 2, fft8_phase(F));
            PHASE(4, pb + 3, { fresh_ids(F); SchedF2 S{F.ws}; pg8::EpiTile E; pg8::gemm_phase<pg8::EpiTile, SchedF2, false>(ring, F.wave, 512, 512, 512, S, E);
                               tail_convert(F, 576, F.in[I_WDN] + (size_t)(L + 1) * DFF * D, (bf16_t*)(F.ws + WS_WDN) + (size_t)(L + 1) * D * DFF, DFF, D, 0, nullptr, nullptr, 64, 0); });
            PHASE(5, pb + 4, { fresh_ids(F); SchedAB<D, WS_Y> S{F.ws, WS_F, WS_WFOUR + (size_t)j * D * D * 2, 1};
                               pg8::EpiTile E; pg8::gemm_phase<pg8::EpiTile, SchedAB<D, WS_Y>, false>(ring, F.wave, D, D, D, S, E); });
        } else {
            PHASE(6, pb + 1, { fresh_ids(F); SchedIn S{F.ws, WS_WIN + (size_t)j * INP * D * 2, last ? 1 : 0}; pg8::EpiTile E; pg8::gemm_phase<pg8::EpiTile, SchedIn, false>(ring, F.wave, D, D, D, S, E);
                               if (!last) tail_convert(F, 64 * 41 + 8 * 41, F.in[I_WUP] + (size_t)L * D * 2 * DFF, (bf16_t*)(F.ws + WS_WUP) + (size_t)L * 2 * DFF * D, D, 2 * DFF, 0, nullptr, nullptr, 64, 0); });
            PHASE(7, pb + 2, ssd_conv_phase(F, j, last));
#ifndef SCAN_PROBE
#define SCAN_PROBE 0
#endif
            PHASE(8, pb + 3, { if (REPS(8) == 2 && rep_ == 0) ssd_scan_phase<SCAN_PROBE>(F, j, !last); else ssd_scan_phase<0>(F, j, !last); });
            PHASE(9, pb + 4, ssd_gate_norm_phase(F, j, last ? MLAT : MALL));
            PHASE(10, pb + 5, { fresh_ids(F); SchedAB<DI, WS_Y> S{F.ws, WS_XBCP, WS_WOUT + (size_t)j * D * DI * 2, last ? 0 : 1};
                                pg8::EpiTile E; pg8::gemm_phase<pg8::EpiTile, SchedAB<DI, WS_Y>, false>(ring, F.wave, DI, DI, DI, S, E); });
        }
        PHASE(2, pb + 6, norm_mod_phase(F, L, F.in[I_NFFN] + (size_t)L * D, 3, nrows_ffn, (const float*)(F.ws + WS_MOD) + (size_t)L * 9 * MODW + 2 * D, nullptr, L == 0 ? F.in[I_X] : nullptr, L == 0 ? F.in[I_CTX] : nullptr));
        PHASE(11, pb + 7, { fresh_ids(F); SchedUp S{F.ws, WS_WUP + (size_t)L * 2 * DFF * D * 2, nrows_ffn / 256}; pg8::EpiTile E; pg8::gemm_phase<pg8::EpiTile, SchedUp, false>(ring, F.wave, D, D, D, S, E);
                            if (L + 1 < DEPTH) { const int jn = (L + 1) >> 1;
                                if ((L + 1) & 1) tail_convert(F, (nrows_ffn / 256) * 44, F.in[I_WIN] + (size_t)jn * D * INW, (bf16_t*)(F.ws + WS_WIN) + (size_t)jn * INP * D, D, INW, 1,
                                                              F.in[I_WOUT] + (size_t)jn * DI * D, (bf16_t*)(F.ws + WS_WOUT) + (size_t)jn * D * DI, DI, D);
                                else tail_convert(F, (nrows_ffn / 256) * 44, F.in[I_FOURW] + (size_t)jn * D * D, (bf16_t*)(F.ws + WS_WFOUR) + (size_t)jn * D * D, D, D, 0,
                                                  F.in[I_WUP] + (size_t)(L + 1) * D * 2 * DFF, (bf16_t*)(F.ws + WS_WUP) + (size_t)(L + 1) * 2 * DFF * D, D, 2 * DFF); } });
        PHASE(12, pb + 8, ffn_conv_phase(F, L, nrows_ffn, REPS(12) == 2 && rep_ == 0));
        PHASE(13, pb + 9, { fresh_ids(F); SchedAB<DFF, WS_Y2> S{F.ws, WS_VAL, WS_WDN + (size_t)L * D * DFF * 2, last ? 0 : 1};
                            pg8::EpiTile E; pg8::gemm_phase<pg8::EpiTile, SchedAB<DFF, WS_Y2>, false>(ring, F.wave, DFF, DFF, DFF, S, E); });
    }
    PHASE(14, 42, final_norm_phase(F));
#undef PHASE
#undef REPS
#undef IN
#undef PHON
#undef SEAM
}

extern "C" void kernel_launch(void* const* d_in, const int* in_sizes, int n_in, void* d_out, int out_size, void* d_ws, size_t ws_size, hipStream_t stream) {
    static int grid = 0;
    if (grid == 0) {
        if (n_in != 22 || out_size != MLAT * D || ws_size < WS_END) { fprintf(stderr, "kernel_launch: unexpected problem (n_in %d, out %d, ws %zu < %zu)\n", n_in, out_size, ws_size, (size_t)WS_END); grid = -1; return; }
        int dev = 0, cus = 0, per_cu = 0;
        if (hipGetDevice(&dev) != hipSuccess || hipDeviceGetAttribute(&cus, hipDeviceAttributeMultiprocessorCount, dev) != hipSuccess) { grid = -1; return; }
        if (hipFuncSetAttribute((const void*)trunk_fwd, hipFuncAttributeMaxDynamicSharedMemorySize, LDS_BYTES) != hipSuccess) { fprintf(stderr, "kernel_launch: hipFuncSetAttribute failed\n"); grid = -1; return; }
        if (hipOccupancyMaxActiveBlocksPerMultiprocessor(&per_cu, (const void*)trunk_fwd, NWAVES * 64, LDS_BYTES) != hipSuccess || per_cu < 1) fprintf(stderr, "kernel_launch: occupancy query says %d\n", per_cu);
        (void)hipGetLastError();
        grid = cus;
    }
    if (grid < 0) return;
    (void)hipMemsetAsync((char*)d_ws + WS_CTL, 0, CTL_ZERO_BYTES, stream);
    Args a{};
    for (int i = 0; i < 22; ++i) a.in[i] = (const float*)d_in[i];
    a.out = (float*)d_out; a.ws = (unsigned char*)d_ws;
#if MK_N_LAUNCHES == 1
    a.ph_lo = 0; a.ph_hi = N_PHASES;
    hipLaunchKernelGGL(trunk_fwd, dim3(grid), dim3(NWAVES * 64), LDS_BYTES, stream, a);
#else
    for (int p = 0; p < N_PHASES; ++p) { if (!phase_exists(p)) continue; a.ph_lo = p; a.ph_hi = p + 1;
        hipLaunchKernelGGL(trunk_fwd, dim3(grid), dim3(NWAVES * 64), LDS_BYTES, stream, a); }
#endif
}
```

```cpp
#include <hip/hip_runtime.h>
#include <cstdio>
#include <cstdint>

#define LAS __attribute__((address_space(3)))
#define GAS __attribute__((address_space(1)))
typedef unsigned short bf16_t;
typedef short bf16x8 __attribute__((ext_vector_type(8)));
typedef float f32x4 __attribute__((ext_vector_type(4)));
typedef float f32x2 __attribute__((ext_vector_type(2)));
typedef unsigned u32x4 __attribute__((ext_vector_type(4)));
typedef unsigned u32x2 __attribute__((ext_vector_type(2)));

#ifndef MK_N_LAUNCHES
#define MK_N_LAUNCHES 1
#endif

constexpr int D = 2048, NB = 8, LSEQ = 2048, LCTX = 256, DEPTH = 4;
constexpr int MLAT = NB * LSEQ, MCTX = NB * LCTX, MALL = MLAT + MCTX;
constexpr int DFF = 5632, DI = 4096, GNW = 1024, NH = 64, NS = 128;
constexpr int XBC = DI + 2 * GNW;
constexpr int INW = 10368, INP = 10496;
constexpr int MODW = 6 * D;
constexpr float EPS = 1e-6f;
constexpr float LOG2E = 1.4426950408889634f;

constexpr size_t MiB = 1u << 20;
constexpr size_t WS_CTL = 0, CTL_ZERO_BYTES = 1 * MiB;
constexpr size_t WS_MOD = 1 * MiB;
constexpr size_t WS_W1 = 3 * MiB;
constexpr size_t WS_W2C = 3 * MiB + 512 * 1024;
constexpr size_t WS_W2 = 4 * MiB;
constexpr size_t WS_WFOUR = 20 * MiB;
constexpr size_t WS_WIN = 36 * MiB;
constexpr size_t WS_WOUT = 118 * MiB;
constexpr size_t WS_WUP = 150 * MiB;
constexpr size_t WS_WDN = 326 * MiB;
constexpr size_t WS_XC = 414 * MiB;
constexpr size_t WS_A = 430 * MiB;
constexpr size_t WS_R = 502 * MiB;
constexpr size_t WS_MODP = WS_R;
constexpr size_t WS_GATE = WS_R, WS_VAL = WS_R + 198 * MiB;
constexpr size_t WS_PQT = WS_R, WS_PQTC = WS_R + 128 * MiB, WS_F = WS_R + 144 * MiB;
constexpr size_t WS_VT = WS_R + 216 * MiB;
constexpr size_t WS_XBCP = WS_R;
constexpr size_t WS_Z = WS_R + 216 * MiB;
constexpr size_t WS_DT = WS_R + 360 * MiB;
constexpr size_t WS_XST = WS_R + 369 * MiB;
constexpr size_t WS_BM = WS_R + 513 * MiB;
constexpr size_t WS_BMT = WS_R + 549 * MiB;
constexpr size_t WS_CM = WS_R + 585 * MiB;
constexpr size_t WS_YB = WS_R + 621 * MiB;
constexpr size_t WS_Y = WS_R + 621 * MiB;
constexpr size_t WS_Y2 = WS_R + 400 * MiB;
constexpr size_t WS_PART = WS_R + 700 * MiB;
constexpr size_t WS_XB = WS_R + 765 * MiB;
constexpr size_t WS_END = WS_R + 829 * MiB;
constexpr int CW_BAR = 4096;

constexpr int RING_BYTES = 131072;
constexpr int LDSCTL_OFF = RING_BYTES, MISC_OFF = LDSCTL_OFF + 320;
constexpr int LDS_BYTES = 147456;
constexpr int NWAVES = 8;

typedef __bf16 bf16x2_t __attribute__((ext_vector_type(2)));
__device__ __forceinline__ unsigned cvt_pk_bf16(float lo, float hi) { const f32x2 v = {lo, hi}; return __builtin_bit_cast(unsigned, __builtin_convertvector(v, bf16x2_t)); }
__device__ __forceinline__ float bf_lo(unsigned u) { return __uint_as_float(u << 16); }
__device__ __forceinline__ float bf_hi(unsigned u) { return __uint_as_float(u & 0xffff0000u); }
__device__ __forceinline__ float silu_f(float v) { return v * __builtin_amdgcn_rcpf(1.0f + __expf(-v)); }
typedef float f32x2 __attribute__((ext_vector_type(2)));
__device__ __forceinline__ float wave_sum(float v, int lane) {
#pragma unroll
    for (int o = 1; o < 64; o <<= 1) v += __builtin_bit_cast(float, __builtin_amdgcn_ds_bpermute((lane ^ o) << 2, __builtin_bit_cast(int, v)));
    return v;
}
__device__ __forceinline__ int fresh_lane() { int l; asm volatile("v_mbcnt_lo_u32_b32 %0, -1, 0\n\tv_mbcnt_hi_u32_b32 %0, -1, %0" : "=v"(l)); return l; }
#define LDS_WAIT() asm volatile("s_waitcnt lgkmcnt(0)" ::: "memory")
#define VM_WAIT() asm volatile("s_waitcnt vmcnt(0)" ::: "memory")

namespace pg8 {
constexpr int BM = 256, BK = 64, HALF = 128, HTB = HALF * BK * 2, STAGE_BYTES = 8 * HTB, NXCD = 8, WGM = 8;
__host__ __device__ __forceinline__ int lds_byte(int r, int c) { const int st = (r >> 4) * 2 + (c >> 5), rr = r & 15, cc = c & 31, ob = rr * 64 + cc * 2; return st * 1024 + (ob ^ (((ob >> 9) & 1) << 5)); }
__host__ __device__ __forceinline__ void stage_rc(int b, int& R, int& C) { const int st = b / 1024, sb = b % 1024, swz = sb ^ (((sb >> 9) & 1) << 5); R = (st >> 1) * 16 + swz / 64; C = (st & 1) * 32 + (swz % 64) / 2; }
__host__ __device__ __forceinline__ int perm32(int rho) { const int n = rho >> 4, i = rho & 15; return 8 * (i >> 2) + 4 * n + (i & 3); }

struct Unit { int pm, pn, kq; };

template <int NN> __device__ __forceinline__ void tile_of_id(int wgid, int nM, int& pm, int& pn) {
    const int nwg = nM * NN;
    { const int q = nwg / NXCD, r = nwg % NXCD, xcd = wgid % NXCD, off = wgid / NXCD; wgid = (xcd < r ? xcd * (q + 1) : r * (q + 1) + (xcd - r) * q) + off; }
    const int nig = WGM * NN, gid = wgid / nig, fm = gid * WGM, gsz = (nM - fm) < WGM ? (nM - fm) : WGM;
    pm = fm + ((wgid % nig) % gsz); pn = (wgid % nig) / gsz;
}
template <int NN> __device__ __forceinline__ bool tile2d(int i, int nM, Unit& u) {
    const long L = (long)i * (int)gridDim.x + (int)blockIdx.x; if (L >= nM * NN) return false;
    tile_of_id<NN>((int)L, nM, u.pm, u.pn); u.kq = -1; return true;
}

struct EpiTile {
    static constexpr bool PERM = true;
    template <class Sched> __device__ __forceinline__ void operator()(const f32x4 (&acc)[2][2][4][2], const Unit& u, const Sched& S, int wr, int wc, int fr, int fq) const {
        const int rl0 = wr * 64 + fr, cl0 = wc * 32 + 8 * fq;
        char* uo; int ldo, kind; S.out(u, uo, ldo, kind);
        asm volatile("" : "+s"(ldo));
        if (kind == 0) {
            bf16_t* base = (bf16_t*)uo;
#pragma unroll
            for (int ai = 0; ai < 2; ++ai)
#pragma unroll
                for (int m = 0; m < 4; ++m) { bf16_t* rowp = base + (size_t)(rl0 + ai * HALF + m * 16) * ldo + cl0;
#pragma unroll
                    for (int bj = 0; bj < 2; ++bj) { const f32x4 v0 = acc[ai][bj][m][0], v1 = acc[ai][bj][m][1];
                        u32x4 w; w.x = cvt_pk_bf16(v0[0], v0[1]); w.y = cvt_pk_bf16(v0[2], v0[3]); w.z = cvt_pk_bf16(v1[0], v1[1]); w.w = cvt_pk_bf16(v1[2], v1[3]);
                        *(u32x4*)(rowp + bj * HALF) = w; } }
        } else {
            float* base = (float*)uo;
#pragma unroll
            for (int ai = 0; ai < 2; ++ai)
#pragma unroll
                for (int m = 0; m < 4; ++m) { float* rowp = base + (size_t)(rl0 + ai * HALF + m * 16) * ldo + cl0;
                    *(f32x4*)(rowp) = acc[ai][0][m][0]; *(f32x4*)(rowp + 4) = acc[ai][0][m][1];
                    if (kind == 2) { *(f32x4*)(rowp + HALF) = acc[ai][1][m][0]; *(f32x4*)(rowp + HALF + 4) = acc[ai][1][m][1]; } }
        }
    }
};
template <class Epi, class Sched, bool ALIGN_EPI>
__device__ __forceinline__ void gemm_phase(LAS unsigned char* lds, const int wid, const int lda_, const int ldb_, const int K_, const Sched& S, const Epi& E) {
    int lda = lda_, ldb = ldb_; (void)K_; asm volatile("" : "+s"(lda), "+s"(ldb));
    const int lane = fresh_lane(), tid = wid * 64 + lane;
    const int wr = wid >> 2, wc = wid & 3, fr = lane & 15, fq = lane >> 4;
    unsigned voffA[2], voffB[2];
#pragma unroll
    for (int i = 0; i < 2; ++i) { int R, C; stage_rc(tid * 16 + i * 8192, R, C); const int Rb = Epi::PERM ? ((R & ~31) + perm32(R & 31)) : R;
        voffA[i] = (unsigned)(R * lda + C) * 2u; voffB[i] = (unsigned)(Rb * ldb + C) * 2u; }
    const size_t kstep = (size_t)(BK * 2);
    const size_t hstepA = (size_t)HALF * lda * 2, hstepB = (size_t)HALF * ldb * 2;
    const unsigned ldsw = (unsigned)wid * 1024u;
    const int aoff = lds_byte(wr * 64 + fr, fq * 8), boff = lds_byte(wc * 32 + fr, fq * 8);
#define PG8_SA(b, h) (((b) * 2 + (h)) * HTB)
#define PG8_SB(b, h) ((4 + (b) * 2 + (h)) * HTB)
#define PG8_STAGE(bufoff, gbase, voff) do { _Pragma("unroll") for (int _i = 0; _i < 2; ++_i) \
        __builtin_amdgcn_global_load_lds((const unsigned*)((const char*)(gbase) + (voff)[_i]), (LAS unsigned*)(lds + (bufoff) + ldsw + _i * 8192), 16, 0, 0); } while (0)
#define PG8_LDA(dst, b, h) do { _Pragma("unroll") for (int m = 0; m < 4; ++m) _Pragma("unroll") for (int k = 0; k < 2; ++k) dst[m][k] = *(const LAS bf16x8*)(lds + PG8_SA(b, h) + aoff + m * 2048 + k * 1024); } while (0)
#define PG8_LDB(dst, b, h) do { _Pragma("unroll") for (int n = 0; n < 2; ++n) _Pragma("unroll") for (int k = 0; k < 2; ++k) dst[n][k] = *(const LAS bf16x8*)(lds + PG8_SB(b, h) + boff + n * 2048 + k * 1024); } while (0)
#define PG8_MMA(ai, bj, At, Bt) do { __builtin_amdgcn_s_setprio(1); _Pragma("unroll") for (int m = 0; m < 4; ++m) _Pragma("unroll") for (int n = 0; n < 2; ++n) _Pragma("unroll") for (int k = 0; k < 2; ++k) \
        acc[ai][bj][m][n] = __builtin_amdgcn_mfma_f32_16x16x32_bf16(Bt[n][k], At[m][k], acc[ai][bj][m][n], 0, 0, 0); __builtin_amdgcn_s_setprio(0); } while (0)
#define PG8_WAIT_V(n) asm volatile("s_waitcnt vmcnt(" #n ")" ::: "memory")
#define PG8_WAIT_L(n) asm volatile("s_waitcnt lgkmcnt(" #n ")" ::: "memory")
#define PG8_BAR __builtin_amdgcn_s_barrier()
#define PG8_SCHED __builtin_amdgcn_sched_barrier(0)
    Unit cur, nxt; int ui = 0;
    if (!S.next(0, cur)) return;
    f32x4 acc[2][2][4][2];
#pragma unroll
    for (int a = 0; a < 2; ++a)
#pragma unroll
        for (int b = 0; b < 2; ++b)
#pragma unroll
            for (int m = 0; m < 4; ++m)
#pragma unroll
                for (int n = 0; n < 2; ++n) acc[a][b][m][n] = (f32x4){0.f, 0.f, 0.f, 0.f};
    bf16x8 At[4][2], B0[2][2], B1[2][2];
    const char* cA = S.a(cur); const char* cB = S.b(cur);
    PG8_STAGE(PG8_SB(0, 0), cB, voffB); PG8_STAGE(PG8_SB(0, 1), cB + hstepB, voffB); PG8_STAGE(PG8_SA(0, 0), cA, voffA); PG8_STAGE(PG8_SA(0, 1), cA + hstepA, voffA);
    if (wr == 1) PG8_BAR;
    PG8_WAIT_V(2); PG8_BAR;
    PG8_STAGE(PG8_SB(1, 0), cB + kstep, voffB); PG8_STAGE(PG8_SA(1, 0), cA + kstep, voffA); PG8_STAGE(PG8_SB(1, 1), cB + hstepB + kstep, voffB);
    PG8_WAIT_V(6); PG8_BAR;
    for (;;) {
        const bool has_next = S.next(ui + 1, nxt);
        const int nt = S.nt(cur);
        const char* nA = has_next ? S.a(nxt) : cA; const char* nB = has_next ? S.b(nxt) : cB;
#pragma unroll 1
        for (int t = 0; t < nt; t += 2) {
            const bool last = (t == nt - 2);
            const char* a1 = cA + (size_t)(t + 1) * kstep;
            const char* a2 = last ? nA : cA + (size_t)(t + 2) * kstep; const char* b2 = last ? nB : cB + (size_t)(t + 2) * kstep;
            const char* a3 = a2 + kstep; const char* b3 = b2 + kstep;
            PG8_LDB(B0, 0, 0); PG8_LDB(B1, 0, 1); PG8_SCHED; PG8_LDA(At, 0, 0); PG8_STAGE(PG8_SA(1, 1), a1 + hstepA, voffA);
            PG8_WAIT_V(8); PG8_WAIT_L(0); PG8_BAR; PG8_MMA(0, 0, At, B0); PG8_MMA(0, 1, At, B1); PG8_BAR; PG8_SCHED;
            PG8_LDA(At, 0, 1); PG8_STAGE(PG8_SB(0, 0), b2, voffB); PG8_STAGE(PG8_SB(0, 1), b2 + hstepB, voffB); PG8_STAGE(PG8_SA(0, 0), a2, voffA);
            PG8_WAIT_V(8); PG8_WAIT_L(0); PG8_BAR; PG8_MMA(1, 0, At, B0); PG8_MMA(1, 1, At, B1); PG8_BAR; PG8_SCHED;
            PG8_LDB(B0, 1, 0); PG8_LDB(B1, 1, 1); PG8_SCHED; PG8_LDA(At, 1, 0); PG8_STAGE(PG8_SA(0, 1), a2 + hstepA, voffA);
            PG8_WAIT_V(8); PG8_WAIT_L(0); PG8_BAR; PG8_MMA(0, 0, At, B0); PG8_MMA(0, 1, At, B1); PG8_BAR; PG8_SCHED;
            PG8_LDA(At, 1, 1); PG8_STAGE(PG8_SB(1, 0), b3, voffB); PG8_STAGE(PG8_SB(1, 1), b3 + hstepB, voffB); PG8_STAGE(PG8_SA(1, 0), a3, voffA);
            PG8_WAIT_V(8); PG8_WAIT_L(0); PG8_BAR; PG8_MMA(1, 0, At, B0); PG8_MMA(1, 1, At, B1); PG8_BAR; PG8_SCHED;
        }
        if constexpr (ALIGN_EPI) { if (wr == 0) PG8_BAR; }
        E(acc, cur, S, wr, wc, fr, fq);
        if (!has_next) break;
#pragma unroll
        for (int a = 0; a < 2; ++a)
#pragma unroll
            for (int b = 0; b < 2; ++b)
#pragma unroll
                for (int m = 0; m < 4; ++m)
#pragma unroll
                    for (int n = 0; n < 2; ++n) acc[a][b][m][n] = (f32x4){0.f, 0.f, 0.f, 0.f};
        cur = nxt; cA = nA; cB = nB; ++ui;
        if constexpr (ALIGN_EPI) { if (wr == 1) PG8_BAR; }
    }
    PG8_WAIT_V(0);
    if constexpr (!ALIGN_EPI) { if (wr == 0) PG8_BAR; }
    PG8_BAR;
#undef PG8_SA
#undef PG8_SB
#undef PG8_STAGE
#undef PG8_LDA
#undef PG8_LDB
#undef PG8_MMA
#undef PG8_WAIT_V
#undef PG8_WAIT_L
#undef PG8_BAR
#undef PG8_SCHED
}
}

#define XB_TMO      128
#define XB_XCNT(j)  (256  + 64 * (j))
#define XB_XSUB(j)  (1280 + 64 * (j))
#define XB_XGEN(j)  (2304 + 64 * (j))
#define XB_TOP      3328
#define XB_TOPGEN   3392
#define XCD_BAR_WORDS 3456
#define XB_SPIN_CAP (1u << 18)
__device__ __forceinline__ unsigned xb_ld(unsigned* p)              { return __hip_atomic_load(p, __ATOMIC_RELAXED, __HIP_MEMORY_SCOPE_AGENT); }
__device__ __forceinline__ unsigned xb_add(unsigned* p, unsigned v) { return __hip_atomic_fetch_add(p, v, __ATOMIC_RELAXED, __HIP_MEMORY_SCOPE_AGENT); }
__device__ __forceinline__ unsigned xb_xcc_id() { return (unsigned)__builtin_amdgcn_s_getreg((3 << 11) | 20) & 0xFu; }
#define XB_SPIN(cond, bar) do { unsigned _sp = 0; while (cond) { __builtin_amdgcn_s_sleep(1); \
    if ((++_sp & 255u) == 0u) { if (xb_ld(&(bar)[XB_TMO])) break; if (_sp > XB_SPIN_CAP) { atomicAdd(&(bar)[XB_TMO], 1u); break; } } } } while (0)
struct XcdBarrier { unsigned* bar; unsigned x; volatile LAS unsigned* st; };
__device__ __forceinline__ XcdBarrier xcd_barrier_post(unsigned* bar, volatile LAS unsigned* st) {
    XcdBarrier b; b.bar = bar; b.x = xb_xcc_id(); b.st = st;
    if (threadIdx.x == 0) (void)xb_add(&bar[XB_XCNT(b.x)], 1u);
    return b;
}
__device__ __forceinline__ void xcd_barrier_complete(unsigned* bar, unsigned x, unsigned& nloc, unsigned& nx) {
    const unsigned G = gridDim.x * gridDim.y * gridDim.z;
    unsigned sum, cnt, mine, sp = 0u;
    for (;;) {
        sum = 0u; cnt = 0u; mine = 0u;
#pragma unroll
        for (unsigned j = 0; j < 16; ++j) { const unsigned c = xb_ld(&bar[XB_XCNT(j)]); sum += c; cnt += (c > 0u) ? 1u : 0u; mine = (j == x) ? c : mine; }
        if (sum == G) break;
        __builtin_amdgcn_s_sleep(1);
        if ((++sp & 255u) == 0u) { if (xb_ld(&bar[XB_TMO])) break; if (sp > XB_SPIN_CAP) { atomicAdd(&bar[XB_TMO], 1u); break; } }
    }
    nloc = mine > 0u ? mine : 1u; nx = cnt > 0u ? cnt : 1u;
}
__device__ __forceinline__ void xcd_barrier(const XcdBarrier& b, const bool leader  ) {
    asm volatile("s_waitcnt vmcnt(0)" ::: "memory");
    __syncthreads();
    if (leader) {
        unsigned* bar = b.bar;
        __builtin_amdgcn_s_waitcnt(0);
        unsigned nloc = b.st[0], nx = b.st[1];
        if (nloc == 0u) { xcd_barrier_complete(bar, b.x, nloc, nx); b.st[0] = nloc; b.st[1] = nx; }
        const unsigned old = xb_add(&bar[XB_XSUB(b.x)], 1u);
        const unsigned gen = old / nloc;
        if (old + 1u == (gen + 1u) * nloc) {
            __builtin_amdgcn_fence(__ATOMIC_RELEASE, "agent");
            asm volatile("s_waitcnt vmcnt(0)" ::: "memory");
            const unsigned og = xb_add(&bar[XB_TOP], 1u);
            const unsigned tg = og / nx;
            if (og + 1u == (tg + 1u) * nx) xb_add(&bar[XB_TOPGEN], 1u);
            else XB_SPIN(xb_ld(&bar[XB_TOPGEN]) == tg, bar);
            __builtin_amdgcn_fence(__ATOMIC_ACQUIRE, "agent");
            xb_add(&bar[XB_XGEN(b.x)], 1u);
            asm volatile("s_waitcnt vmcnt(0)" ::: "memory");
        } else {
            XB_SPIN(xb_ld(&bar[XB_XGEN(b.x)]) == gen, bar);
            __builtin_amdgcn_fence(__ATOMIC_ACQUIRE, "agent");
            asm volatile("s_waitcnt vmcnt(0)" ::: "memory");
        }
    }
    __syncthreads();
}

struct Args { const float* in[22]; float* out; unsigned char* ws; int ph_lo, ph_hi; };
struct Frame {
    LAS unsigned char* lds;
    int tid, lane, wave, G;
    const float* const* in;
    float* out; unsigned char* ws;
};
enum { I_X = 0, I_C, I_CTX, I_CCTX, I_WMOD, I_BMOD, I_NMIX, I_NFFN, I_FOURW, I_WIN, I_CONVW, I_CONVB, I_DTB, I_ALOG, I_DSK, I_SNG, I_WOUT, I_WUP, I_FCW, I_FCB, I_WDN, I_FING };

__device__ __forceinline__ void fresh_ids(Frame& F) { F.lane = fresh_lane(); F.tid = F.wave * 64 + F.lane; }

template <int K_, size_t YOFF> struct SchedAB {
    unsigned char* ws; size_t aoff, boff; int has_ctx;
    static constexpr int KT = K_ / 64;
    __device__ __forceinline__ bool next(int i, pg8::Unit& u) const {
        const int L = i * (int)gridDim.x + (int)blockIdx.x;
        if (L < 512) { pg8::tile_of_id<8>(L, 64, u.pm, u.pn); u.kq = -1; return true; }
        if (!has_ctx || L >= 768) return false;
        const int c2 = L - 512, ct = c2 >> 2; u.kq = c2 & 3; u.pm = 64 + (ct >> 3); u.pn = ct & 7; return true; }
    __device__ __forceinline__ int nt(const pg8::Unit& u) const { return u.kq < 0 ? KT : KT / 4; }
    __device__ __forceinline__ void out(const pg8::Unit& u, char*& o, int& ldo, int& kind) const { ldo = D;
        if (u.kq < 0) { o = (char*)ws + YOFF + ((size_t)u.pm * 256 * D + (size_t)u.pn * 256) * 2; kind = 0; }
        else { o = (char*)ws + WS_PART + (((size_t)u.kq * MCTX + (size_t)(u.pm - 64) * 256) * D + (size_t)u.pn * 256) * 2; kind = 0; } }
    __device__ __forceinline__ const char* a(const pg8::Unit& u) const { return (const char*)ws + aoff + (size_t)u.pm * 256 * K_ * 2 + (u.kq < 0 ? 0 : u.kq * (K_ / 4) * 2); }
    __device__ __forceinline__ const char* b(const pg8::Unit& u) const { return (const char*)ws + boff + (size_t)u.pn * 256 * K_ * 2 + (u.kq < 0 ? 0 : u.kq * (K_ / 4) * 2); }
};
struct SchedUp {
    unsigned char* ws; size_t boff; int nM;
    __device__ __forceinline__ int nt(const pg8::Unit&) const { return D / 64; }
    __device__ __forceinline__ bool next(int i, pg8::Unit& u) const { return pg8::tile2d<44>(i, nM, u); }
    __device__ __forceinline__ const char* a(const pg8::Unit& u) const { return (const char*)ws + WS_A + (size_t)u.pm * 256 * D * 2; }
    __device__ __forceinline__ const char* b(const pg8::Unit& u) const { return (const char*)ws + boff + (size_t)u.pn * 256 * D * 2; }
    __device__ __forceinline__ void out(const pg8::Unit& u, char*& o, int& ldo, int& kind) const {
        o = (char*)ws + (u.pn < 22 ? WS_GATE + (size_t)u.pn * 512 : WS_VAL + (size_t)(u.pn - 22) * 512) + (size_t)u.pm * 256 * DFF * 2; ldo = DFF; kind = 0; }
};
struct SchedIn {
    unsigned char* ws; size_t boff; int last;
    __device__ __forceinline__ int nt(const pg8::Unit&) const { return D / 64; }
    __device__ __forceinline__ bool next(int i, pg8::Unit& u) const {
        const int L = i * (int)gridDim.x + (int)blockIdx.x; u.kq = -1;
        if (L < 64 * 41) { pg8::tile_of_id<41>(L, 64, u.pm, u.pn); return true; }
        const int c2 = L - 64 * 41, nct = last ? 21 : 41; if (c2 >= 8 * nct) return false;
        u.pm = 64 + (c2 & 7); const int t = c2 >> 3; u.pn = (last && t >= 20) ? 40 : t; return true; }
    __device__ __forceinline__ const char* a(const pg8::Unit& u) const { return (const char*)ws + WS_A + (size_t)u.pm * 256 * D * 2; }
    __device__ __forceinline__ const char* b(const pg8::Unit& u) const { return (const char*)ws + boff + (size_t)u.pn * 256 * D * 2; }
    __device__ __forceinline__ void out(const pg8::Unit& u, char*& o, int& ldo, int& kind) const {
        if (u.pn < 24) { o = (char*)ws + WS_XBCP + ((size_t)u.pm * 256 * XBC + (size_t)u.pn * 256) * 2; ldo = XBC; kind = 0; }
        else if (u.pn < 40) { o = (char*)ws + WS_Z + ((size_t)u.pm * 256 * DI + (size_t)(u.pn - 24) * 256) * 2; ldo = DI; kind = 0; }
        else { o = (char*)ws + WS_DT + (size_t)u.pm * 256 * 128 * 4; ldo = 128; kind = 1; } }
};
struct SchedF1 {
    unsigned char* ws;
    __device__ __forceinline__ int nt(const pg8::Unit&) const { return 4; }
    __device__ __forceinline__ bool next(int i, pg8::Unit& u) const { return pg8::tile2d<72>(i, 16, u); }
    __device__ __forceinline__ const char* a(const pg8::Unit& u) const { return (const char*)ws + WS_W1 + (size_t)(u.pm & 1) * 256 * 256 * 2; }
    __device__ __forceinline__ const char* b(const pg8::Unit& u) const { return (const char*)ws + WS_A + ((size_t)u.pn * 256 * D + (size_t)(u.pm >> 1) * 256) * 2; }
    __device__ __forceinline__ void out(const pg8::Unit& u, char*& o, int& ldo, int& kind) const { const int g = u.pm >> 1, cs = u.pm & 1;
        if (u.pn < 64) { const int b = u.pn >> 3, p0 = (u.pn & 7) * 256; o = (char*)ws + WS_PQT + (((size_t)(b * 2048 + g * 256)) * 4096 + (size_t)cs * 2048 + p0) * 2; ldo = 4096; }
        else { const int b = u.pn - 64; o = (char*)ws + WS_PQTC + (((size_t)(b * 2048 + g * 256)) * 512 + (size_t)cs * 256) * 2; ldo = 512; }
        kind = 0; }
};
struct SchedF2 {
    unsigned char* ws;
    __device__ __forceinline__ int total() const { return 576; }
    __device__ __forceinline__ int nt(const pg8::Unit&) const { return 8; }
    __device__ __forceinline__ bool next(int i, pg8::Unit& u) const {
        const int L = i * (int)gridDim.x + (int)blockIdx.x; u.kq = -1;
        if (L < 512) { pg8::tile_of_id<8>(L, 64, u.pm, u.pn); return true; }
        if (L >= 576) return false;
        u.pm = 64 + ((L - 512) & 7); u.pn = (L - 512) >> 3; return true; }
    __device__ __forceinline__ const char* a(const pg8::Unit& u) const { return (const char*)ws + (u.pm < 64 ? WS_W2 : WS_W2C); }
    __device__ __forceinline__ const char* b(const pg8::Unit& u) const { return u.pm < 64 ? (const char*)ws + WS_VT + ((size_t)u.pm * 2048 + (size_t)u.pn * 256) * 512 * 2
                                                                                           : (const char*)ws + WS_PQTC + ((size_t)((u.pm - 64) * 2048 + u.pn * 256)) * 512 * 2; }
    __device__ __forceinline__ void out(const pg8::Unit& u, char*& o, int& ldo, int& kind) const { kind = 0;
        if (u.pm < 64) { o = (char*)ws + WS_F + (((size_t)((u.pm >> 3) * 2048 + (u.pm & 7))) * D + (size_t)u.pn * 256) * 2; ldo = 8 * D; }
        else { o = (char*)ws + WS_F + (((size_t)(MLAT + (u.pm - 64) * 256)) * D + (size_t)u.pn * 256) * 2; ldo = D; } }
};

__device__ __forceinline__ void p0_transpose_item(const float* W, int K, int N, bf16_t* WT, int k0, int n0, int drow0, LAS float* scr, int lane) {
    const int kk = lane >> 3, nq = (lane & 7) * 4;
    f32x4 v[8];
#pragma unroll
    for (int i = 0; i < 8; ++i) v[i] = __builtin_nontemporal_load((const f32x4*)(W + (size_t)(k0 + 8 * i + kk) * N + n0 + nq));
#pragma unroll
    for (int i = 0; i < 8; ++i) { LAS float* d = scr + (8 * i + kk) * 33 + nq; d[0] = v[i].x; d[1] = v[i].y; d[2] = v[i].z; d[3] = v[i].w; }
    LDS_WAIT(); asm volatile("" ::: "memory");
    const int c = lane & 7;
#pragma unroll
    for (int j = 0; j < 4; ++j) { const int n = (lane >> 3) + 8 * j; const LAS float* s = scr + (8 * c) * 33 + n;
        u32x4 o; o.x = cvt_pk_bf16(s[0 * 33], s[1 * 33]); o.y = cvt_pk_bf16(s[2 * 33], s[3 * 33]); o.z = cvt_pk_bf16(s[4 * 33], s[5 * 33]); o.w = cvt_pk_bf16(s[6 * 33], s[7 * 33]);
        *(u32x4*)(WT + (size_t)(drow0 + n) * K + k0 + 8 * c) = o; }
    LDS_WAIT(); asm volatile("" ::: "memory");
}
__device__ __forceinline__ int win_dst_row(int n0) { return n0 < 5120 ? n0 : (n0 < 5248 ? 10240 + (n0 - 5120) : n0 - 128); }

__device__ __forceinline__ void p0_prologue(Frame& F) {
    fresh_ids(F);
    LAS float* scr = (LAS float*)(F.lds + F.wave * 16384);
    const int gw = blockIdx.x * NWAVES + F.wave, NGW = F.G * NWAVES, lane = F.lane;
    unsigned char* ws = F.ws;
    {
        constexpr int NCG = MODW / 256, NKS = 8, NIT = DEPTH * NCG * NKS;
        const float* c = F.in[I_C]; const float* cc = F.in[I_CCTX]; const float* wm = F.in[I_WMOD];
        float* modp = (float*)(ws + WS_MODP);
        for (int it = gw; it < NIT; it += NGW) {
            const int ks = it % NKS, cg = (it / NKS) % NCG, L = it / (NKS * NCG), k0 = ks * 256;
            for (int e = lane; e < 9 * 256; e += 64) { const int k = e & 255, b = e >> 8; const float v = (b < 8) ? c[b * D + k0 + k] : cc[k0 + k]; scr[k * 12 + b] = silu_f(v); }
            LDS_WAIT(); asm volatile("" ::: "memory");
            f32x4 acc[9];
#pragma unroll
            for (int b = 0; b < 9; ++b) acc[b] = (f32x4){0.f, 0.f, 0.f, 0.f};
            const float* wp = wm + ((size_t)L * D + k0) * MODW + cg * 256 + lane * 4;
#pragma unroll 8
            for (int k = 0; k < 256; ++k) {
                const f32x4 wv = __builtin_nontemporal_load((const f32x4*)(wp + (size_t)k * MODW));
                const f32x4 s0 = *(const LAS f32x4*)(scr + k * 12), s1 = *(const LAS f32x4*)(scr + k * 12 + 4); const float s2 = scr[k * 12 + 8];
                acc[0] += wv * s0[0]; acc[1] += wv * s0[1]; acc[2] += wv * s0[2]; acc[3] += wv * s0[3];
                acc[4] += wv * s1[0]; acc[5] += wv * s1[1]; acc[6] += wv * s1[2]; acc[7] += wv * s1[3]; acc[8] += wv * s2;
            }
#pragma unroll
            for (int b = 0; b < 9; ++b) *(f32x4*)(modp + (((size_t)ks * DEPTH + L) * 9 + b) * MODW + cg * 256 + lane * 4) = acc[b];
            LDS_WAIT(); asm volatile("" ::: "memory");
        }
    }
    {
        constexpr int I_F = (D / 64) * (D / 32);
        constexpr int I_I = (D / 64) * (INW / 32);
        constexpr int I_O = (DI / 64) * (D / 32);
        constexpr int I_U = (D / 64) * (2 * DFF / 32);
        constexpr int I_D = (DFF / 64) * (D / 32);
        constexpr int NIT = I_F + 2 * I_U + 2 * I_D; (void)I_I; (void)I_O;
        for (int it = gw; it < NIT; it += NGW) {
            int r = it;
            if (r < I_F) { const int nblk = D / 32, kb = r / nblk, nb = r % nblk;
                p0_transpose_item(F.in[I_FOURW], D, D, (bf16_t*)(ws + WS_WFOUR), 64 * kb, 32 * nb, 32 * nb, scr, lane); continue; } r -= I_F;
            if (r < 2 * I_U) { const int jj = r / I_U; r -= jj * I_U; const int j = jj * (DEPTH - 1); const int nblk = 2 * DFF / 32, kb = r / nblk, nb = r % nblk;
                p0_transpose_item(F.in[I_WUP] + (size_t)j * D * 2 * DFF, D, 2 * DFF, (bf16_t*)(ws + WS_WUP) + (size_t)j * 2 * DFF * D, 64 * kb, 32 * nb, 32 * nb, scr, lane); continue; } r -= 2 * I_U;
            { const int jj = r / I_D; r -= jj * I_D; const int j = 2 * jj; const int nblk = D / 32, kb = r / nblk, nb = r % nblk;
                p0_transpose_item(F.in[I_WDN] + (size_t)j * DFF * D, DFF, D, (bf16_t*)(ws + WS_WDN) + (size_t)j * D * DFF, 64 * kb, 32 * nb, 32 * nb, scr, lane); }
        }
    }
    const size_t gt = (size_t)blockIdx.x * 512 + F.tid, NT = (size_t)F.G * 512;
    for (size_t i = gt; i < (size_t)2 * 128 * D / 8; i += NT) { const size_t j = i / (128 * D / 8), e = i % (128 * D / 8);
        *(u32x4*)((bf16_t*)(ws + WS_WIN) + ((size_t)j * INP + INW) * D + e * 8) = (u32x4){0u, 0u, 0u, 0u}; }
    {
        bf16_t* W1 = (bf16_t*)(ws + WS_W1);
        for (size_t i = gt; i < (size_t)512 * 256 / 2; i += NT) { const int m = (int)(i / 128), c0 = (int)(i % 128) * 2; float v[2];
#pragma unroll
            for (int e = 0; e < 2; ++e) { const int idx = ((m & 255) * (c0 + e)) & 255; const float a = (float)idx * (1.0f / 128.0f); v[e] = (m < 256) ? cospif(a) : sinpif(a); }
            *(unsigned*)(W1 + (size_t)m * 256 + c0) = cvt_pk_bf16(v[0], v[1]); }
        bf16_t* W2c = (bf16_t*)(ws + WS_W2C);
        for (size_t i = gt; i < (size_t)256 * 512 / 2; i += NT) { const int k1 = (int)(i / 256), c0 = (int)(i % 256) * 2; float v[2];
#pragma unroll
            for (int e = 0; e < 2; ++e) { const int cc = c0 + e, l = cc & 255; const int idx = (k1 * l) & 255; const float a = (float)idx * (1.0f / 128.0f); v[e] = ((cc < 256) ? cospif(a) : -sinpif(a)) * (1.0f / 256.0f); }
            *(unsigned*)(W2c + (size_t)k1 * 512 + c0) = cvt_pk_bf16(v[0], v[1]); }
        bf16_t* W2 = (bf16_t*)(ws + WS_W2); const float sc = 0.0013810679320049757f;
        for (size_t i = gt; i < (size_t)256 * 512 / 2; i += NT) { const int k2 = (int)(i / 256), c0 = (int)(i % 256) * 2; float v[2];
#pragma unroll
            for (int e = 0; e < 2; ++e) { const int cc = c0 + e, l = cc & 255; const int idx = (k2 * l) & 255; const float a = (float)idx * (1.0f / 128.0f); v[e] = ((cc < 256) ? cospif(a) : sinpif(a)) * sc; }
            *(unsigned*)(W2 + (size_t)k2 * 512 + c0) = cvt_pk_bf16(v[0], v[1]); }
    }
}
__device__ __forceinline__ void tail_convert(Frame& F, int total_units, const float* W0, bf16_t* WT0, int K0, int N0, int perm0, const float* W1, bf16_t* WT1, int K1, int N1) {
    const int rem = total_units % F.G;
    if ((int)blockIdx.x < rem) return;
    const int lane = fresh_lane();
    LAS float* scr = (LAS float*)(F.lds + F.wave * 16384);
    const int slot = ((int)blockIdx.x - rem) * NWAVES + F.wave, nslots = (F.G - rem) * NWAVES;
    const int n0 = (K0 / 64) * (N0 / 32), n1 = (K1 / 64) * (N1 / 32);
    const int kk = lane >> 3, nq = (lane & 7) * 4, c = lane & 7;
#define TC_ITEM(it_, W_, WT_, K_, N_, k0_, n0_, dr_) do { const bool first_ = (it_) < n0; const int r_ = first_ ? (it_) : (it_) - n0; \
        W_ = first_ ? W0 : W1; WT_ = first_ ? WT0 : WT1; K_ = first_ ? K0 : K1; N_ = first_ ? N0 : N1; \
        const int nblk_ = N_ / 32, kb_ = r_ / nblk_, nb_ = r_ - kb_ * nblk_; k0_ = 64 * kb_; n0_ = 32 * nb_; dr_ = (first_ && perm0) ? win_dst_row(32 * nb_) : 32 * nb_; } while (0)
    f32x4 v[8];
    int it = slot;
    if (it < n0 + n1) { const float* W; bf16_t* WT; int K, N, k0, nn0, dr; TC_ITEM(it, W, WT, K, N, k0, nn0, dr); (void)WT; (void)K; (void)dr;
#pragma unroll
        for (int i = 0; i < 8; ++i) v[i] = __builtin_nontemporal_load((const f32x4*)(W + (size_t)(k0 + 8 * i + kk) * N + nn0 + nq)); }
    for (; it < n0 + n1; it += nslots) {
        const float* W; bf16_t* WT; int K, N, k0, nn0, dr; TC_ITEM(it, W, WT, K, N, k0, nn0, dr); (void)W;
#pragma unroll
        for (int i = 0; i < 8; ++i) { LAS float* d = scr + (8 * i + kk) * 33 + nq; d[0] = v[i].x; d[1] = v[i].y; d[2] = v[i].z; d[3] = v[i].w; }
        const int itn = it + nslots;
        if (itn < n0 + n1) { const float* Wn; bf16_t* WTn; int Kn, Nn, k0n, n0n, drn; TC_ITEM(itn, Wn, WTn, Kn, Nn, k0n, n0n, drn); (void)WTn; (void)Kn; (void)drn;
#pragma unroll
            for (int i = 0; i < 8; ++i) v[i] = __builtin_nontemporal_load((const f32x4*)(Wn + (size_t)(k0n + 8 * i + kk) * Nn + n0n + nq)); }
        LDS_WAIT(); asm volatile("" ::: "memory");
#pragma unroll
        for (int j = 0; j < 4; ++j) { const int n = (lane >> 3) + 8 * j; const LAS float* sp = scr + (8 * c) * 33 + n;
            u32x4 o; o.x = cvt_pk_bf16(sp[0 * 33], sp[1 * 33]); o.y = cvt_pk_bf16(sp[2 * 33], sp[3 * 33]); o.z = cvt_pk_bf16(sp[4 * 33], sp[5 * 33]); o.w = cvt_pk_bf16(sp[6 * 33], sp[7 * 33]);
            *(u32x4*)(WT + (size_t)(dr + n) * K + k0 + 8 * c) = o; }
        LDS_WAIT(); asm volatile("" ::: "memory");
    }
#undef TC_ITEM
}
__device__ __forceinline__ void p0b_modreduce(Frame& F) {
    fresh_ids(F);
    const size_t gt = (size_t)blockIdx.x * 512 + F.tid, NT = (size_t)F.G * 512;
    const float* modp = (const float*)(F.ws + WS_MODP); float* mod = (float*)(F.ws + WS_MOD); const float* bm = F.in[I_BMOD];
    constexpr size_t PER = (size_t)DEPTH * 9 * MODW;
    for (size_t i = gt; i < PER / 4; i += NT) { const size_t e = i * 4; const int n = (int)(e % MODW), L = (int)(e / ((size_t)9 * MODW));
        f32x4 s = *(const f32x4*)(bm + (size_t)L * MODW + n);
#pragma unroll
        for (int ks = 0; ks < 8; ++ks) s += *(const f32x4*)(modp + (size_t)ks * PER + e);
        *(f32x4*)(mod + e) = s; }
}

__device__ __forceinline__ void norm_mod_phase(Frame& F, int L, const float* gvec, int sh_chunk, int nrows, const float* pg, const float* pg2, const float* xlat, const float* xctx) {
    fresh_ids(F);
    const int G_ = F.G, wg = (int)blockIdx.x, latper = (MLAT + G_ - 1) / G_, nctx = nrows - MLAT, ctxper = (nctx + G_ - 1) / G_;
    const int l0 = wg * latper < MLAT ? wg * latper : MLAT, l1 = l0 + latper < MLAT ? l0 + latper : MLAT;
    const int c0 = MLAT + (wg * ctxper < nctx ? wg * ctxper : nctx), c1 = MLAT + ((wg + 1) * ctxper < nctx ? (wg + 1) * ctxper : nctx);
    const int b0 = l0 >> 11, nbl = l1 > l0 ? ((l1 - 1) >> 11) - b0 + 1 : 0;
    const float* mod = (const float*)(F.ws + WS_MOD) + (size_t)L * 9 * MODW; bf16_t* A = (bf16_t*)(F.ws + WS_A);
    LAS float* V = (LAS float*)F.lds;
    for (int i = F.tid; i < 3 * 512; i += NWAVES * 64) { const int bs = i >> 9, c4 = i & 511, b = bs < 2 ? b0 + bs : 8;
        if (bs < 2 ? (bs < nbl) : (c1 > c0)) {
            const f32x4 g = ((const f32x4*)gvec)[c4], sh = ((const f32x4*)(mod + (size_t)b * MODW + sh_chunk * D))[c4], sc = ((const f32x4*)(mod + (size_t)b * MODW + sh_chunk * D + D))[c4];
            LAS f32x4* d = (LAS f32x4*)(V + (size_t)bs * 4 * D) + c4;
            d[0] = g * (sc + 1.0f); d[D / 4] = sh;
            if (pg != nullptr) d[2 * (D / 4)] = ((const f32x4*)(((b == 8 && pg2 != nullptr) ? pg2 : pg) + (size_t)b * MODW))[c4];
            if (pg2 != nullptr) d[3 * (D / 4)] = ((const f32x4*)(pg2 + (size_t)b * MODW))[c4]; } }
    __syncthreads();
    const int lane = F.lane, nl = l1 - l0, ntot = nl + (c1 - c0);
    for (int i = F.wave; i < ntot; i += NWAVES) {
        const int r = i < nl ? l0 + i : c0 + (i - nl);
        const LAS f32x4* vq = (const LAS f32x4*)(V + (size_t)(r < MLAT ? (r >> 11) - b0 : 2) * 4 * D) + lane;
        f32x4 v[8]; float ss = 0.f;
        const bool lat = r < MLAT, xbf = lat ? (xlat == nullptr) : (xctx == nullptr);
        const bool h1 = pg != nullptr && lat, h2 = pg2 != nullptr && lat, hc = pg != nullptr && !lat;
        u32x4 xraw[8]; u32x2 aux[4][8];
        if (xbf) { const u32x2* xb = (const u32x2*)((const bf16_t*)(F.ws + (lat ? WS_XB : WS_XC)) + (size_t)(lat ? r : r - MLAT) * D) + lane;
#pragma unroll
            for (int j = 0; j < 8; ++j) { const u32x2 w = __builtin_nontemporal_load(xb + 64 * j); xraw[j].x = w.x; xraw[j].y = w.y; }
        } else { const u32x4* xr = (const u32x4*)(lat ? xlat + (size_t)r * D : xctx + (size_t)(r - MLAT) * D) + lane;
#pragma unroll
            for (int j = 0; j < 8; ++j) xraw[j] = __builtin_nontemporal_load(xr + 64 * j); }
        if (h1) { const u32x2* yp = (const u32x2*)((const bf16_t*)(F.ws + WS_Y) + (size_t)r * D) + lane;
#pragma unroll
            for (int j = 0; j < 8; ++j) aux[0][j] = __builtin_nontemporal_load(yp + 64 * j); }
        if (h2) { const u32x2* yp = (const u32x2*)((const bf16_t*)(F.ws + WS_Y2) + (size_t)r * D) + lane;
#pragma unroll
            for (int j = 0; j < 8; ++j) aux[1][j] = __builtin_nontemporal_load(yp + 64 * j); }
        if (hc) { const u32x2* pp = (const u32x2*)((const bf16_t*)(F.ws + WS_PART) + (size_t)(r - MLAT) * D) + lane;
#pragma unroll
            for (int q = 0; q < 4; ++q)
#pragma unroll
                for (int j = 0; j < 8; ++j) aux[q][j] = pp[64 * j + (size_t)q * MCTX * D / 4]; }
        if (xbf) {
#pragma unroll
            for (int j = 0; j < 8; ++j) v[j] = (f32x4){bf_lo(xraw[j].x), bf_hi(xraw[j].x), bf_lo(xraw[j].y), bf_hi(xraw[j].y)};
        } else {
#pragma unroll
            for (int j = 0; j < 8; ++j) v[j] = __builtin_bit_cast(f32x4, xraw[j]);
        }
        if (h1) {
            const LAS f32x4* gq = vq + 2 * (D / 4);
#pragma unroll
            for (int j = 0; j < 8; ++j) { const u32x2 yy = aux[0][j]; const f32x4 y4 = {bf_lo(yy.x), bf_hi(yy.x), bf_lo(yy.y), bf_hi(yy.y)}; v[j] += gq[64 * j] * y4; }
        }
        if (h2) {
            const LAS f32x4* gq = vq + 3 * (D / 4); u32x2* xw_ = (u32x2*)((bf16_t*)(F.ws + WS_XB) + (size_t)r * D) + lane;
#pragma unroll
            for (int j = 0; j < 8; ++j) { const u32x2 yy = aux[1][j]; const f32x4 y4 = {bf_lo(yy.x), bf_hi(yy.x), bf_lo(yy.y), bf_hi(yy.y)}; v[j] += gq[64 * j] * y4; u32x2 w; w.x = cvt_pk_bf16(v[j].x, v[j].y); w.y = cvt_pk_bf16(v[j].z, v[j].w); xw_[64 * j] = w; }
        }
        if (hc) {
            const LAS f32x4* gq = vq + 2 * (D / 4); u32x2* xw_ = (u32x2*)((bf16_t*)(F.ws + WS_XC) + (size_t)(r - MLAT) * D) + lane;
#pragma unroll
            for (int j = 0; j < 8; ++j) { f32x4 p = {0.f, 0.f, 0.f, 0.f};
#pragma unroll
                for (int q = 0; q < 4; ++q) { const u32x2 w = aux[q][j]; p += (f32x4){bf_lo(w.x), bf_hi(w.x), bf_lo(w.y), bf_hi(w.y)}; }
                v[j] += gq[64 * j] * p; u32x2 w; w.x = cvt_pk_bf16(v[j].x, v[j].y); w.y = cvt_pk_bf16(v[j].z, v[j].w); xw_[64 * j] = w; }
        }
#pragma unroll
        for (int j = 0; j < 8; ++j) ss += (v[j].x * v[j].x + v[j].y * v[j].y) + (v[j].z * v[j].z + v[j].w * v[j].w);
        const float rstd = rsqrtf(wave_sum(ss, lane) * (1.0f / D) + EPS);
        u32x2* o = (u32x2*)(A + (size_t)r * D) + lane;
#pragma unroll
        for (int j = 0; j < 8; ++j) { const f32x4 y = v[j] * rstd * vq[64 * j] + vq[64 * j + D / 4];
            u32x2 w; w.x = cvt_pk_bf16(y.x, y.y); w.y = cvt_pk_bf16(y.z, y.w); o[64 * j] = w; }
    }
}
__device__ __forceinline__ void final_norm_phase(Frame& F) {
    fresh_ids(F);
    const int gw = blockIdx.x * NWAVES + F.wave, NGW = F.G * NWAVES, lane = F.lane;
    const f32x4* gp = (const f32x4*)F.in[I_FING] + lane;
    for (int r = gw; r < MLAT; r += NGW) {
        f32x4* xr = (f32x4*)(F.out + (size_t)r * D) + lane; const u32x2* xb = (const u32x2*)((const bf16_t*)(F.ws + WS_XB) + (size_t)r * D) + lane;
        const u32x2* yp = (const u32x2*)((const bf16_t*)(F.ws + WS_Y) + (size_t)r * D) + lane; const u32x2* yp2 = (const u32x2*)((const bf16_t*)(F.ws + WS_Y2) + (size_t)r * D) + lane;
        const f32x4* gq = (const f32x4*)((const float*)(F.ws + WS_MOD) + ((size_t)(DEPTH - 1) * 9 + (r >> 11)) * MODW + 2 * D) + lane; const f32x4* gq2 = gq + 3 * D / 4;
        f32x4 v[8]; float ss = 0.f;
#pragma unroll
        for (int j = 0; j < 8; ++j) { const u32x2 yy = __builtin_nontemporal_load(yp + 64 * j), y2 = __builtin_nontemporal_load(yp2 + 64 * j);
            const f32x4 y4 = {bf_lo(yy.x), bf_hi(yy.x), bf_lo(yy.y), bf_hi(yy.y)}, z4 = {bf_lo(y2.x), bf_hi(y2.x), bf_lo(y2.y), bf_hi(y2.y)};
            const u32x2 xw = __builtin_nontemporal_load(xb + 64 * j); v[j] = (f32x4){bf_lo(xw.x), bf_hi(xw.x), bf_lo(xw.y), bf_hi(xw.y)} + gq[64 * j] * y4; v[j] += gq2[64 * j] * z4;
            ss += (v[j].x * v[j].x + v[j].y * v[j].y) + (v[j].z * v[j].z + v[j].w * v[j].w); }
        const float rstd = rsqrtf(wave_sum(ss, lane) * (1.0f / D) + EPS);
#pragma unroll
        for (int j = 0; j < 8; ++j) xr[64 * j] = v[j] * rstd * gp[64 * j];
    }
}

__device__ __forceinline__ void unpack8(const u32x4 w, float (&f)[8]) {
    f[0] = bf_lo(w.x); f[1] = bf_hi(w.x); f[2] = bf_lo(w.y); f[3] = bf_hi(w.y); f[4] = bf_lo(w.z); f[5] = bf_hi(w.z); f[6] = bf_lo(w.w); f[7] = bf_hi(w.w);
}
__device__ __forceinline__ u32x4 pack8(const float (&f)[8]) { u32x4 w; w.x = cvt_pk_bf16(f[0], f[1]); w.y = cvt_pk_bf16(f[2], f[3]); w.z = cvt_pk_bf16(f[4], f[5]); w.w = cvt_pk_bf16(f[6], f[7]); return w; }

__device__ __forceinline__ void fft8_phase(Frame& F) {
    fresh_ids(F);
    const int gw = blockIdx.x * NWAVES + F.wave, NGW = F.G * NWAVES, lane = F.lane;
    const bf16_t* pqt = (const bf16_t*)(F.ws + WS_PQT); bf16_t* vt = (bf16_t*)(F.ws + WS_VT);
    float twc[8][4], tws[8][4];
#pragma unroll
    for (int k1 = 0; k1 < 8; ++k1)
#pragma unroll
        for (int e = 0; e < 4; ++e) { const int idx = (4 * lane + e) * k1; const float a = (float)idx * (1.0f / 1024.0f); twc[k1][e] = cospif(a); tws[k1][e] = sinpif(a); }
    constexpr float R2 = 0.70710678118654752f;
    for (int row = gw; row < NB * D; row += NGW) {
        const bf16_t* src = pqt + (size_t)row * 4096 + 4 * lane;
        u32x2 rp[8], rq[8];
#pragma unroll
        for (int l1 = 0; l1 < 8; ++l1) { rp[l1] = __builtin_nontemporal_load((const u32x2*)(src + 256 * l1)); rq[l1] = __builtin_nontemporal_load((const u32x2*)(src + 2048 + 256 * l1)); }
        const int b = row >> 11, n = row & 2047;
        bf16_t* dst = vt + (((size_t)b * 8) * 2048 + n) * 512 + 4 * lane;
        float vr[8][4], vi[8][4];
#pragma unroll
        for (int e = 0; e < 4; ++e) {
            float xr[8], xi[8];
#pragma unroll
            for (int l1 = 0; l1 < 8; ++l1) { const unsigned wp = (e < 2) ? rp[l1].x : rp[l1].y, wq = (e < 2) ? rq[l1].x : rq[l1].y; xr[l1] = (e & 1) ? bf_hi(wp) : bf_lo(wp); xi[l1] = -((e & 1) ? bf_hi(wq) : bf_lo(wq)); }
            const float a0r = xr[0] + xr[4], a0i = xi[0] + xi[4], a1r = xr[0] - xr[4], a1i = xi[0] - xi[4], a2r = xr[2] + xr[6], a2i = xi[2] + xi[6], a3r = xr[2] - xr[6], a3i = xi[2] - xi[6];
            const float a4r = xr[1] + xr[5], a4i = xi[1] + xi[5], a5r = xr[1] - xr[5], a5i = xi[1] - xi[5], a6r = xr[3] + xr[7], a6i = xi[3] + xi[7], a7r = xr[3] - xr[7], a7i = xi[3] - xi[7];
            const float b0r = a0r + a2r, b0i = a0i + a2i, b2r = a0r - a2r, b2i = a0i - a2i, b1r = a1r + a3i, b1i = a1i - a3r, b3r = a1r - a3i, b3i = a1i + a3r;
            const float c0r = a4r + a6r, c0i = a4i + a6i, c2r = a4r - a6r, c2i = a4i - a6i, c1r = a5r + a7i, c1i = a5i - a7r, c3r = a5r - a7i, c3i = a5i + a7r;
            const float d1r = (c1r + c1i) * R2, d1i = (c1i - c1r) * R2, d2r = c2i, d2i = -c2r, d3r = (c3i - c3r) * R2, d3i = -(c3r + c3i) * R2;
            float yr[8], yi[8];
            yr[0] = b0r + c0r; yi[0] = b0i + c0i; yr[4] = b0r - c0r; yi[4] = b0i - c0i;
            yr[1] = b1r + d1r; yi[1] = b1i + d1i; yr[5] = b1r - d1r; yi[5] = b1i - d1i;
            yr[2] = b2r + d2r; yi[2] = b2i + d2i; yr[6] = b2r - d2r; yi[6] = b2i - d2i;
            yr[3] = b3r + d3r; yi[3] = b3i + d3i; yr[7] = b3r - d3r; yi[7] = b3i - d3i;
#pragma unroll
            for (int k1 = 0; k1 < 8; ++k1) { const float c = twc[k1][e], sn = tws[k1][e]; vr[k1][e] = yr[k1] * c + yi[k1] * sn; vi[k1][e] = yi[k1] * c - yr[k1] * sn; }
        }
#pragma unroll
        for (int k1 = 0; k1 < 8; ++k1) { u32x2 o; o.x = cvt_pk_bf16(vr[k1][0], vr[k1][1]); o.y = cvt_pk_bf16(vr[k1][2], vr[k1][3]); *(u32x2*)(dst + (size_t)k1 * 2048 * 512) = o;
            u32x2 p; p.x = cvt_pk_bf16(vi[k1][0], vi[k1][1]); p.y = cvt_pk_bf16(vi[k1][2], vi[k1][3]); *(u32x2*)(dst + (size_t)k1 * 2048 * 512 + 256) = p; }
    }
}

__device__ __forceinline__ void ssd_conv_phase(Frame& F, int j, bool skip_ctx_c) {
    fresh_ids(F);
    const int gw = blockIdx.x * NWAVES + F.wave, NGW = F.G * NWAVES, lane = F.lane, cq = lane & 7, tq = lane >> 3;
    const bf16_t* pre = (const bf16_t*)(F.ws + WS_XBCP);
    const float* cw = F.in[I_CONVW] + (size_t)j * 3 * XBC; const float* cb_ = F.in[I_CONVB] + (size_t)j * XBC;
    bf16_t* xst = (bf16_t*)(F.ws + WS_XST); bf16_t* bm = (bf16_t*)(F.ws + WS_BM); bf16_t* bmt = (bf16_t*)(F.ws + WS_BMT); bf16_t* cm = (bf16_t*)(F.ws + WS_CM);
    constexpr int NTB = MALL / 64, NCB = XBC / 64;
    for (int job = gw; job < NTB * NCB; job += NGW) {
        const int cb = job % NCB, tb = job / NCB;
        const int rb = tb * 64;
        if (skip_ctx_c && rb >= MLAT && cb >= 80) continue;
        int seq0, T, sb;
        if (rb < MLAT) { sb = rb >> 11; seq0 = sb << 11; T = LSEQ; } else { sb = (rb - MLAT) >> 8; seq0 = MLAT + (sb << 8); T = LCTX; }
        const int tl = rb - seq0 + tq * 8;
        const int c0 = cb * 64 + cq * 8;
        float w0[8], w1[8], w2[8], bi[8];
        { const f32x4* p = (const f32x4*)(cw + c0); const f32x4 a = p[0], b = p[1]; w0[0] = a.x; w0[1] = a.y; w0[2] = a.z; w0[3] = a.w; w0[4] = b.x; w0[5] = b.y; w0[6] = b.z; w0[7] = b.w; }
        { const f32x4* p = (const f32x4*)(cw + XBC + c0); const f32x4 a = p[0], b = p[1]; w1[0] = a.x; w1[1] = a.y; w1[2] = a.z; w1[3] = a.w; w1[4] = b.x; w1[5] = b.y; w1[6] = b.z; w1[7] = b.w; }
        { const f32x4* p = (const f32x4*)(cw + 2 * XBC + c0); const f32x4 a = p[0], b = p[1]; w2[0] = a.x; w2[1] = a.y; w2[2] = a.z; w2[3] = a.w; w2[4] = b.x; w2[5] = b.y; w2[6] = b.z; w2[7] = b.w; }
        { const f32x4* p = (const f32x4*)(cb_ + c0); const f32x4 a = p[0], b = p[1]; bi[0] = a.x; bi[1] = a.y; bi[2] = a.z; bi[3] = a.w; bi[4] = b.x; bi[5] = b.y; bi[6] = b.z; bi[7] = b.w; }
        u32x4 raw[10];
#pragma unroll
        for (int i = 0; i < 10; ++i) { const int tt = tl - 1 + i; raw[i] = (tt >= 0 && tt < T) ? *(const u32x4*)(pre + (size_t)(seq0 + tt) * XBC + c0) : (u32x4){0u, 0u, 0u, 0u}; }
        float o[8][8];
        { float pa[8], pb[8], pc[8]; unpack8(raw[0], pa); unpack8(raw[1], pb);
#pragma unroll
          for (int i = 0; i < 8; ++i) { unpack8(raw[i + 2], pc);
#pragma unroll
              for (int c = 0; c < 8; ++c) o[i][c] = silu_f(bi[c] + w0[c] * pa[c] + w1[c] * pb[c] + w2[c] * pc[c]);
#pragma unroll
              for (int c = 0; c < 8; ++c) { pa[c] = pb[c]; pb[c] = pc[c]; } } }
        if (cb < 64) {
            bf16_t* dst = (rb < MLAT) ? xst + ((size_t)sb * DI + c0) * LSEQ + tl : xst + (size_t)NB * DI * LSEQ + ((size_t)sb * DI + c0) * LCTX + tl;
#pragma unroll
            for (int c = 0; c < 8; ++c) { float t8[8];
#pragma unroll
                for (int i = 0; i < 8; ++i) t8[i] = o[i][c];
                *(u32x4*)(dst + (size_t)c * T) = pack8(t8); }
        } else if (cb < 80) {
            const int cc = c0 - DI;
#pragma unroll
            for (int i = 0; i < 8; ++i) *(u32x4*)(bm + (size_t)(seq0 + tl + i) * GNW + cc) = pack8(o[i]);
            bf16_t* dst = (rb < MLAT) ? bmt + ((size_t)sb * GNW + cc) * LSEQ + tl : bmt + (size_t)NB * GNW * LSEQ + ((size_t)sb * GNW + cc) * LCTX + tl;
#pragma unroll
            for (int c = 0; c < 8; ++c) { float t8[8];
#pragma unroll
                for (int i = 0; i < 8; ++i) t8[i] = o[i][c];
                *(u32x4*)(dst + (size_t)c * T) = pack8(t8); }
        } else {
            const int cc = c0 - DI - GNW;
#pragma unroll
            for (int i = 0; i < 8; ++i) *(u32x4*)(cm + (size_t)(seq0 + tl + i) * GNW + cc) = pack8(o[i]);
        }
    }
}

__device__ __forceinline__ void ffn_conv_phase(Frame& F, int L, int nrows, bool probe_alt = false) {
    fresh_ids(F);
    const int gw = blockIdx.x * NWAVES + F.wave, NGW = F.G * NWAVES;
    const bf16_t* gate = (const bf16_t*)(F.ws + WS_GATE); bf16_t* val = (bf16_t*)(F.ws + WS_VAL);
    const float* cw = F.in[I_FCW] + (size_t)L * 9 * DFF; const float* cb_ = F.in[I_FCB] + (size_t)L * DFF;
    const int NTB = nrows / 64; constexpr int NCB = DFF / 64;
    for (int job = gw; job < NTB * NCB; job += NGW) {
        const int lane = fresh_lane(), cq = lane & 7, tq = lane >> 3;
        const int cb = job / NTB, tb = job % NTB;
        const int rb = tb * 64, c0 = cb * 64 + cq * 8;
        const bool lat = rb < MLAT;
        const int gr = lat ? (tb & 31) : 0, base = lat ? (rb - gr * 64) : (MLAT + (((rb - MLAT) >> 8) << 8)), q = lat ? 0 : (((rb - MLAT) >> 6) & 3);
        u32x4 raw[3][10], rv[8];
#define FFN_LOAD_ROW(dr) do { const bool rowok_ = lat ? (gr + (dr) - 1 >= 0 && gr + (dr) - 1 < 32) : ((dr) == 1); const int rbase_ = lat ? base + (gr + (dr) - 1) * 64 : base + q * 64; \
            _Pragma("unroll") for (int i_ = 0; i_ < 10; ++i_) { const int col_ = tq * 8 - 1 + i_; const bool ok_ = rowok_ && (lat ? (col_ >= 0 && col_ < 64) : (q * 64 + col_ >= 0 && q * 64 + col_ < LCTX)); \
                raw[dr][i_] = ok_ ? *(const u32x4*)(gate + (size_t)(rbase_ + col_) * DFF + c0) : (u32x4){0u, 0u, 0u, 0u}; } } while (0)
#define FFN_UNPK(w4_, p_) do { p_[0] = (f32x2){bf_lo(w4_.x), bf_hi(w4_.x)}; p_[1] = (f32x2){bf_lo(w4_.y), bf_hi(w4_.y)}; p_[2] = (f32x2){bf_lo(w4_.z), bf_hi(w4_.z)}; p_[3] = (f32x2){bf_lo(w4_.w), bf_hi(w4_.w)}; } while (0)
#define FFN_ACC_ROW(dr) do { f32x2 w_[3][4]; \
            _Pragma("unroll") for (int dc_ = 0; dc_ < 3; ++dc_) { const f32x4* p_ = (const f32x4*)(cw + (size_t)((dr) * 3 + dc_) * DFF + c0); const f32x4 a_ = p_[0], b_ = p_[1]; \
                w_[dc_][0] = (f32x2){a_.x, a_.y}; w_[dc_][1] = (f32x2){a_.z, a_.w}; w_[dc_][2] = (f32x2){b_.x, b_.y}; w_[dc_][3] = (f32x2){b_.z, b_.w}; } \
            f32x2 pa_[4], pb_[4], pc_[4]; FFN_UNPK(raw[dr][0], pa_); FFN_UNPK(raw[dr][1], pb_); \
            _Pragma("unroll") for (int i_ = 0; i_ < 8; ++i_) { FFN_UNPK(raw[dr][i_ + 2], pc_); \
                _Pragma("unroll") for (int c_ = 0; c_ < 4; ++c_) { acc[i_][c_] += w_[0][c_] * pa_[c_]; acc[i_][c_] += w_[1][c_] * pb_[c_]; acc[i_][c_] += w_[2][c_] * pc_[c_]; }     \
                _Pragma("unroll") for (int c_ = 0; c_ < 4; ++c_) { pa_[c_] = pb_[c_]; pb_[c_] = pc_[c_]; } } } while (0)
        FFN_LOAD_ROW(0); FFN_LOAD_ROW(1);
        f32x2 acc[8][4];
        { const f32x4* p = (const f32x4*)(cb_ + c0); const f32x4 a = p[0], b = p[1];
#pragma unroll
          for (int i = 0; i < 8; ++i) { acc[i][0] = (f32x2){a.x, a.y}; acc[i][1] = (f32x2){a.z, a.w}; acc[i][2] = (f32x2){b.x, b.y}; acc[i][3] = (f32x2){b.z, b.w}; } }
        FFN_ACC_ROW(0);
        FFN_LOAD_ROW(2);
#pragma unroll
        for (int i = 0; i < 8; ++i) rv[i] = __builtin_nontemporal_load((const u32x4*)(val + (size_t)(rb + tq * 8 + i) * DFF + c0));
        FFN_ACC_ROW(1);
        FFN_ACC_ROW(2);
#undef FFN_LOAD_ROW
#undef FFN_ACC_ROW
#undef FFN_UNPK
#pragma unroll
        for (int i = 0; i < 8; ++i) { bf16_t* vp = val + (size_t)(rb + tq * 8 + i) * DFF + c0; float v[8]; unpack8(rv[i], v);
#pragma unroll
            for (int c = 0; c < 4; ++c) { v[2 * c] *= silu_f(acc[i][c].x); v[2 * c + 1] *= silu_f(acc[i][c].y); }
            *(u32x4*)(probe_alt ? vp + (size_t)202 * MiB / 2 : vp) = pack8(v); }
    }
}

__device__ __forceinline__ void ssd_gate_norm_phase(Frame& F, int j, int nrows) {
    fresh_ids(F);
    const int gw = blockIdx.x * NWAVES + F.wave, NGW = F.G * NWAVES, lane = F.lane;
    bf16_t* yf = (bf16_t*)(F.ws + WS_XBCP); const bf16_t* yb = (const bf16_t*)(F.ws + WS_YB); const bf16_t* z = (const bf16_t*)(F.ws + WS_Z);
    const float* ng = F.in[I_SNG] + (size_t)j * DI;
    for (int r = gw; r < nrows; r += NGW) {
#pragma unroll 4
        for (int g = 0; g < 8; ++g) { const size_t off = (size_t)r * DI + g * 512 + lane * 8;
            float a[8], b[8], zz[8]; unpack8(__builtin_nontemporal_load((const u32x4*)(yf + off)), a); unpack8(__builtin_nontemporal_load((const u32x4*)(yb + off)), b); unpack8(__builtin_nontemporal_load((const u32x4*)(z + off)), zz);
            float ss = 0.f;
#pragma unroll
            for (int c = 0; c < 8; ++c) { a[c] = (a[c] + b[c]) * silu_f(zz[c]); ss += a[c] * a[c]; }
            const float rs = rsqrtf(wave_sum(ss, lane) * (1.0f / 512.0f) + EPS);
            const f32x4* gp = (const f32x4*)(ng + g * 512 + lane * 8); const f32x4 g0 = gp[0], g1 = gp[1];
            a[0] *= rs * g0.x; a[1] *= rs * g0.y; a[2] *= rs * g0.z; a[3] *= rs * g0.w; a[4] *= rs * g1.x; a[5] *= rs * g1.y; a[6] *= rs * g1.z; a[7] *= rs * g1.w;
            *(u32x4*)(yf + off) = pack8(a); }
    }
}

__device__ __forceinline__ float softplus_f(float x) { return x > 15.f ? x : __logf(1.0f + __expf(x)); }
__device__ __forceinline__ float incl_scan64(float v, int lane) {
    (void)lane;
#define ISC_SHR(c) v += __builtin_bit_cast(float, __builtin_amdgcn_update_dpp(0, __builtin_bit_cast(int, v), c, 0xf, 0xf, true))
    ISC_SHR(0x111); ISC_SHR(0x112); ISC_SHR(0x114); ISC_SHR(0x118);
#undef ISC_SHR
    v += __builtin_bit_cast(float, __builtin_amdgcn_update_dpp(0, __builtin_bit_cast(int, v), 0x142, 0xa, 0xf, false));
    v += __builtin_bit_cast(float, __builtin_amdgcn_update_dpp(0, __builtin_bit_cast(int, v), 0x143, 0xc, 0xf, false));
    return v;
}
template <int MODE> __device__ __forceinline__ void ssd_scan_phase(Frame& F, int j, bool ctx_out) {
    fresh_ids(F);
    const int w = F.wave;
    LAS unsigned char* CS = F.lds; LAS unsigned char* R0 = F.lds + 32768; LAS unsigned char* R1 = F.lds + 65536;
    LAS float* tab = (LAS float*)(F.lds + 98304 + w * 2048);
    const bf16_t* cm = (const bf16_t*)(F.ws + WS_CM); const bf16_t* bm = (const bf16_t*)(F.ws + WS_BM); const bf16_t* bmt = (const bf16_t*)(F.ws + WS_BMT); const bf16_t* xst = (const bf16_t*)(F.ws + WS_XST);
    const float* dtb = (const float*)(F.ws + WS_DT);
#define SCAN_DMA(dstbase, srcptr_row0, pitch_elems) do { _Pragma("unroll") for (int q_ = 0; q_ < 4; ++q_) { const int idx_ = tid + 512 * q_, row_ = idx_ >> 4, c16_ = (idx_ & 15) ^ (row_ & 15); \
        __builtin_amdgcn_global_load_lds((const unsigned*)((srcptr_row0) + (size_t)row_ * (pitch_elems) + c16_ * 8), (LAS unsigned*)((dstbase) + (w * 64 + 512 * q_) * 16), 16, 0, 0); } } while (0)
    for (int item = blockIdx.x; item < 256; item += F.G) {
        const int ph = item & 1, dir = (item >> 1) & 1, g = (item >> 2) & 7, b = item >> 5, h = g * 8 + w;
        const float a_h = -expf(F.in[I_ALOG][(j * 2 + dir) * NH + h]) * LOG2E;
        const float dtbias = F.in[I_DTB][(j * 2 + dir) * NH + h];
        const float dsk = dir == 0 ? F.in[I_DSK][(j * 2 + 0) * NH + h] + F.in[I_DSK][(j * 2 + 1) * NH + h] : 0.f;
        bf16_t* yout = dir == 0 ? (bf16_t*)(F.ws + WS_XBCP) : (bf16_t*)(F.ws + WS_YB);
        f32x4 hT[8][2];
#pragma unroll
        for (int nt = 0; nt < 8; ++nt) { hT[nt][0] = (f32x4){0.f, 0.f, 0.f, 0.f}; hT[nt][1] = (f32x4){0.f, 0.f, 0.f, 0.f}; }
        {
            const int tid0 = w * 64 + fresh_lane(); const int tid = tid0;
            const bool isctx0 = true; const int cc0 = dir == 0 ? 0 : 1; const int row00 = MLAT + b * LCTX + cc0 * 128;
            if (ctx_out && !(MODE & 8) && isctx0) { SCAN_DMA(CS, cm + (size_t)row00 * GNW + g * 128, GNW); SCAN_DMA(R0, bm + (size_t)row00 * GNW + g * 128, GNW); }
        }
        float dtr0, dtr1;
        { const int lane0 = fresh_lane(); const int cc0 = dir == 0 ? 0 : 1, row00 = MLAT + b * LCTX + cc0 * 128;
          dtr0 = dtb[(size_t)(row00 + lane0) * 128 + dir * 64 + h]; dtr1 = dtb[(size_t)(row00 + 64 + lane0) * 128 + dir * 64 + h]; }
        bf16x8 xf[2][4];
        { const int lane0 = fresh_lane(), fr0 = lane0 & 15, fq0 = lane0 >> 4; const int cc0 = dir == 0 ? 0 : 1;
          const bf16_t* xl0 = xst + (size_t)NB * DI * LSEQ + ((size_t)(b * DI + h * 64 + ph * 32)) * LCTX + cc0 * 128 + (size_t)fr0 * LCTX + 8 * fq0;
#pragma unroll
          for (int pt = 0; pt < 2; ++pt)
#pragma unroll
              for (int ks = 0; ks < 4; ++ks) xf[pt][ks] = *(const bf16x8*)(xl0 + (size_t)(16 * pt) * LCTX + 32 * ks); }
        for (int k = 0; k < 18; ++k) {
            const bool isctx = k < 2; const int cc = isctx ? (dir == 0 ? k : 1 - k) : (dir == 0 ? k - 2 : 17 - k);
            const int row0 = isctx ? MLAT + b * LCTX + cc * 128 : b * LSEQ + cc * 128, T = isctx ? LCTX : LSEQ;
            const bf16_t* xp = isctx ? xst + (size_t)NB * DI * LSEQ + ((size_t)(b * DI + h * 64 + ph * 32)) * LCTX + cc * 128 : xst + ((size_t)(b * DI + h * 64 + ph * 32)) * LSEQ + cc * 128;
            const bf16_t* btp = isctx ? bmt + (size_t)NB * GNW * LSEQ + ((size_t)(b * GNW + g * 128)) * LCTX + cc * 128 : bmt + ((size_t)(b * GNW + g * 128)) * LSEQ + cc * 128;
            const bool need_y = ctx_out || !isctx;
            LAS unsigned char* BS = (k & 1) ? R1 : R0; LAS unsigned char* GS = (k & 1) ? R0 : R1;
            const int lane = fresh_lane(), fr = lane & 15, fq = lane >> 4, tid = w * 64 + lane;
            const bf16_t* xl = xp + (size_t)fr * T + 8 * fq;
            float tot = -1.f;
            if (!(MODE & 16)) {
                const float dt0 = softplus_f(dtr0 + dtbias), dt1 = softplus_f(dtr1 + dtbias);
                const float dA0 = dt0 * a_h, dA1 = dt1 * a_h;
                const float p0 = incl_scan64(dA0, lane), tot0 = __builtin_bit_cast(float, __builtin_amdgcn_readlane(__builtin_bit_cast(int, p0), 63)), p1 = incl_scan64(dA1, lane) + tot0; tot = __builtin_bit_cast(float, __builtin_amdgcn_readlane(__builtin_bit_cast(int, p1), 63));
                const float c0 = dir == 0 ? p0 : tot - p0 + dA0, c1 = dir == 0 ? p1 : tot - p1 + dA1;
                tab[lane] = c0; tab[64 + lane] = c1; tab[128 + lane] = dt0; tab[192 + lane] = dt1;
                tab[256 + lane] = dt0 * exp2f(tot - c0); tab[320 + lane] = dt1 * exp2f(tot - c1);
                asm volatile("" ::: "memory");
                const int r0 = dir == 0 ? (lane | 31) : (lane & ~31);
                tab[384 + lane] = dt0 * __builtin_amdgcn_exp2f(tab[r0] - c0); tab[448 + lane] = dt1 * __builtin_amdgcn_exp2f(tab[64 + r0] - c1);
            }
            VM_WAIT(); __syncthreads();
            bf16x8 xs2[2][4];
#pragma unroll
            for (int ks = 0; ks < 4; ++ks) { const f32x4 fa = *(const LAS f32x4*)(tab + 384 + 32 * ks + 8 * fq), fb = *(const LAS f32x4*)(tab + 384 + 32 * ks + 8 * fq + 4);
#pragma unroll
                for (int pt = 0; pt < 2; ++pt) { float xv[8]; unpack8(__builtin_bit_cast(u32x4, xf[pt][ks]), xv);
                    xv[0] *= fa.x; xv[1] *= fa.y; xv[2] *= fa.z; xv[3] *= fa.w; xv[4] *= fb.x; xv[5] *= fb.y; xv[6] *= fb.z; xv[7] *= fb.w;
                    xs2[pt][ks] = __builtin_bit_cast(bf16x8, pack8(xv)); } }
            if (need_y && !(MODE & 2)) {
                bf16x8 cf[4];
#pragma unroll
                for (int ks = 0; ks < 4; ++ks) cf[ks] = *(const LAS bf16x8*)(CS + (16 * w + fr) * 256 + (((4 * ks + fq) ^ fr) << 4));
#pragma unroll 2
                for (int st = 0; st < 8; ++st) { f32x4 acc = (f32x4){0.f, 0.f, 0.f, 0.f};
#pragma unroll
                    for (int ks = 0; ks < 4; ++ks) { const bf16x8 bfr = *(const LAS bf16x8*)(BS + (16 * st + fr) * 256 + (((4 * ks + fq) ^ fr) << 4)); acc = __builtin_amdgcn_mfma_f32_16x16x32_bf16(bfr, cf[ks], acc, 0, 0, 0); }
                    u32x2 o; o.x = cvt_pk_bf16(acc[0], acc[1]); o.y = cvt_pk_bf16(acc[2], acc[3]);
                    *(LAS u32x2*)(GS + (16 * w + fr) * 256 + (((2 * st + (fq >> 1)) ^ fr) << 4) + (fq & 1) * 8) = o; }
            }
            __syncthreads();
            if (!(MODE & 8)) SCAN_DMA(BS, btp, T);
            if (need_y && !(MODE & 1)) {
                bf16x8 hf[2][4];
#pragma unroll
                for (int pt = 0; pt < 2; ++pt)
#pragma unroll
                    for (int q = 0; q < 4; ++q) { const f32x4 lo4 = hT[2 * q][pt], hi4 = hT[2 * q + 1][pt]; u32x4 o; o.x = cvt_pk_bf16(lo4[0], lo4[1]); o.y = cvt_pk_bf16(lo4[2], lo4[3]); o.z = cvt_pk_bf16(hi4[0], hi4[1]); o.w = cvt_pk_bf16(hi4[2], hi4[3]);
                        hf[pt][q] = __builtin_bit_cast(bf16x8, o); }
#pragma unroll 8
                for (int lt = 0; lt < 8; ++lt) {
                    const int l = 16 * lt + fr; const float cl = tab[l];
                    f32x4 accd[2], acco[2];
                    accd[0] = accd[1] = acco[0] = acco[1] = (f32x4){0.f, 0.f, 0.f, 0.f};
                    const int kd = lt >> 1;
                    const bf16x8 xa = *(const bf16x8*)(xl + 32 * kd), xb = *(const bf16x8*)(xl + (size_t)16 * T + 32 * kd);
#pragma unroll
                    for (int ks = 0; ks < 4; ++ks) {
                        const bool full = dir == 0 ? (ks < kd) : (ks > kd);
                        if (full) {
                            const bf16x8 gf = *(const LAS bf16x8*)(GS + l * 256 + (((4 * ks + fq) ^ fr) << 4));
                            const float f1 = __builtin_amdgcn_exp2f(cl - tab[dir == 0 ? 32 * ks + 31 : 32 * ks]);
                            const f32x4 z4 = (f32x4){0.f, 0.f, 0.f, 0.f};
                            const f32x4 t0 = __builtin_amdgcn_mfma_f32_16x16x32_bf16(xs2[0][ks], gf, z4, 0, 0, 0), t1 = __builtin_amdgcn_mfma_f32_16x16x32_bf16(xs2[1][ks], gf, z4, 0, 0, 0);
                            accd[0] += t0 * f1; accd[1] += t1 * f1;
                        }
                    }
#pragma unroll
                    for (int q = 0; q < 4; ++q) {
                        const u32x2 lo = *(const LAS u32x2*)(CS + l * 256 + (((4 * q + (fq >> 1)) ^ fr) << 4) + (fq & 1) * 8), hi = *(const LAS u32x2*)(CS + l * 256 + (((4 * q + 2 + (fq >> 1)) ^ fr) << 4) + (fq & 1) * 8);
                        u32x4 c4; c4.x = lo.x; c4.y = lo.y; c4.z = hi.x; c4.w = hi.y; const bf16x8 cfr = __builtin_bit_cast(bf16x8, c4);
                        acco[0] = __builtin_amdgcn_mfma_f32_16x16x32_bf16(hf[0][q], cfr, acco[0], 0, 0, 0);
                        acco[1] = __builtin_amdgcn_mfma_f32_16x16x32_bf16(hf[1][q], cfr, acco[1], 0, 0, 0);
                    }
                    {
                        float gg[8]; unpack8(*(const LAS u32x4*)(GS + l * 256 + (((4 * kd + fq) ^ fr) << 4)), gg);
                        const f32x4 ca = *(const LAS f32x4*)(tab + 32 * kd + 8 * fq), cb = *(const LAS f32x4*)(tab + 32 * kd + 8 * fq + 4);
                        const f32x4 da = *(const LAS f32x4*)(tab + 128 + 32 * kd + 8 * fq), db = *(const LAS f32x4*)(tab + 128 + 32 * kd + 8 * fq + 4);
                        const float cs[8] = {ca.x, ca.y, ca.z, ca.w, cb.x, cb.y, cb.z, cb.w}, ds[8] = {da.x, da.y, da.z, da.w, db.x, db.y, db.z, db.w};
                        float m[8];
#pragma unroll
                        for (int jj = 0; jj < 8; ++jj) { const int s = 32 * kd + 8 * fq + jj; const bool valid = dir == 0 ? (s <= l) : (s >= l);
                            const float e = valid ? __builtin_amdgcn_exp2f(cl - cs[jj]) : 0.f; m[jj] = gg[jj] * e * ds[jj]; if (dir == 0 && s == l) m[jj] += dsk; }
                        const bf16x8 mf = __builtin_bit_cast(bf16x8, pack8(m));
                        accd[0] = __builtin_amdgcn_mfma_f32_16x16x32_bf16(xa, mf, accd[0], 0, 0, 0);
                        accd[1] = __builtin_amdgcn_mfma_f32_16x16x32_bf16(xb, mf, accd[1], 0, 0, 0);
                    }
                    const float el = __builtin_amdgcn_exp2f(cl);
#pragma unroll
                    for (int pt = 0; pt < 2; ++pt) { const f32x4 y = accd[pt] + acco[pt] * el; u32x2 o; o.x = cvt_pk_bf16(y[0], y[1]); o.y = cvt_pk_bf16(y[2], y[3]);
                        *(u32x2*)(yout + (size_t)(row0 + l) * DI + h * 64 + ph * 32 + 16 * pt + 4 * fq) = o; }
                }
            }
            VM_WAIT(); __syncthreads();
            if (k + 1 < 18) {
                const int kn = k + 1; const bool isctxn = kn < 2; const int ccn = isctxn ? (dir == 0 ? kn : 1 - kn) : (dir == 0 ? kn - 2 : 17 - kn);
                const int row0n = isctxn ? MLAT + b * LCTX + ccn * 128 : b * LSEQ + ccn * 128;
                if ((ctx_out || !isctxn) && !(MODE & 8)) { SCAN_DMA(CS, cm + (size_t)row0n * GNW + g * 128, GNW); SCAN_DMA(GS, bm + (size_t)row0n * GNW + g * 128, GNW); }
                dtr0 = dtb[(size_t)(row0n + lane) * 128 + dir * 64 + h]; dtr1 = dtb[(size_t)(row0n + 64 + lane) * 128 + dir * 64 + h];

            }
            if (!(MODE & 4)) {
                const float dec = exp2f(tot);
#pragma unroll
                for (int nt = 0; nt < 8; ++nt) { hT[nt][0] *= dec; hT[nt][1] *= dec; }
                bf16x8 xw[2][4];
#pragma unroll
                for (int ks = 0; ks < 4; ++ks) { const float sck = __builtin_amdgcn_exp2f(tot - tab[dir == 0 ? 32 * ks + 31 : 32 * ks]);
#pragma unroll
                    for (int pt = 0; pt < 2; ++pt) { float xv[8]; unpack8(__builtin_bit_cast(u32x4, xs2[pt][ks]), xv);
#pragma unroll
                        for (int e = 0; e < 8; ++e) xv[e] *= sck;
                        xw[pt][ks] = __builtin_bit_cast(bf16x8, pack8(xv)); } }
                {
                    const int kn = k + 1 < 18 ? k + 1 : 17; const bool isctxn = kn < 2; const int ccn = isctxn ? (dir == 0 ? kn : 1 - kn) : (dir == 0 ? kn - 2 : 17 - kn); const int Tn = isctxn ? LCTX : LSEQ;
                    const bf16_t* xln = (isctxn ? xst + (size_t)NB * DI * LSEQ + ((size_t)(b * DI + h * 64 + ph * 32)) * LCTX + ccn * 128 : xst + ((size_t)(b * DI + h * 64 + ph * 32)) * LSEQ + ccn * 128) + (size_t)fr * Tn + 8 * fq;
#pragma unroll
                    for (int pt = 0; pt < 2; ++pt)
#pragma unroll
                        for (int ks = 0; ks < 4; ++ks) xf[pt][ks] = *(const bf16x8*)(xln + (size_t)(16 * pt) * Tn + 32 * ks); }
#pragma unroll
                for (int nt = 0; nt < 8; ++nt) {
#pragma unroll
                    for (int ks = 0; ks < 4; ++ks) { const bf16x8 bfr = *(const LAS bf16x8*)(BS + (16 * nt + fr) * 256 + (((4 * ks + fq) ^ fr) << 4));
                        hT[nt][0] = __builtin_amdgcn_mfma_f32_16x16x32_bf16(bfr, xw[0][ks], hT[nt][0], 0, 0, 0);
                        hT[nt][1] = __builtin_amdgcn_mfma_f32_16x16x32_bf16(bfr, xw[1][ks], hT[nt][1], 0, 0, 0); }
                    if (nt & 1) __builtin_amdgcn_sched_barrier(0);
                }
            }
        }
        __syncthreads();
    }
#undef SCAN_DMA
}

constexpr int N_PHASES = 43;
__host__ __device__ constexpr bool phase_exists(int p) {
    if (p < 2 || p == 42) return true;
    const int L = (p - 2) / 10, s = (p - 2) % 10;
    if (L & 1) return true;
    return s != 5;
}
__global__ void __launch_bounds__(NWAVES * 64, 2) trunk_fwd(Args args) {
    extern __shared__ __attribute__((aligned(16))) unsigned char lds_raw[];
    Frame F;
    F.lds = (LAS unsigned char*)lds_raw;
    F.tid = threadIdx.x; F.lane = F.tid & 63; F.wave = __builtin_amdgcn_readfirstlane(F.tid >> 6); F.G = gridDim.x;
    F.in = args.in; F.out = args.out; F.ws = args.ws;
    volatile LAS unsigned* MISC = (volatile LAS unsigned*)(F.lds + MISC_OFF);
    for (int u = F.tid; u < (LDS_BYTES - LDSCTL_OFF) / 4; u += NWAVES * 64) ((LAS unsigned*)(F.lds + LDSCTL_OFF))[u] = 0u;
    __syncthreads();
    const int lo = args.ph_lo, hi = args.ph_hi;
    XcdBarrier bar; bar.bar = (unsigned*)(F.ws + WS_CTL) + CW_BAR; bar.x = 0; bar.st = nullptr;
    if (hi - lo > 1) bar = xcd_barrier_post((unsigned*)(F.ws + WS_CTL) + CW_BAR, MISC + 8);
#ifndef ONLY_PHASE
#define ONLY_PHASE -1
#endif
#ifndef SKIP_PHASE
#define SKIP_PHASE -2
#endif
#ifndef REP_PHASE
#define REP_PHASE -3
#endif
#define PHON(id) ((id) != SKIP_PHASE && (ONLY_PHASE < 0 || ONLY_PHASE == (id)))
#define IN(k) (lo <= (k) && (k) < hi)
#define SEAM(k) do { if ((k) + 1 < hi) xcd_barrier(bar, F.wave == 0 && fresh_lane() == 0); } while (0)
    LAS unsigned char* ring = F.lds;

#define REPS(id) ((REP_PHASE == (id)) ? 2 : 1)
#define PHASE(id, k, ...) do { if (PHON(id) && IN(k)) { for (int rep_ = 0; rep_ < REPS(id); ++rep_) { __VA_ARGS__; if (rep_ + 1 < REPS(id)) xcd_barrier(bar, F.wave == 0 && fresh_lane() == 0); } SEAM(k); } } while (0)
    PHASE(0, 0, p0_prologue(F));
    PHASE(1, 1, p0b_modreduce(F));

    for (int L = 0; L < DEPTH; ++L) {
        const int pb = 2 + 10 * L; const bool ssd = (L & 1) != 0, last = (L == DEPTH - 1); const int j = L >> 1;
        if (hi <= pb || lo >= pb + 10) continue;
        const int nrows_ffn = last ? MLAT : MALL;
        PHASE(2, pb + 0, norm_mod_phase(F, L, F.in[I_NMIX] + (size_t)L * D, 0, MALL, L > 0 ? (const float*)(F.ws + WS_MOD) + (size_t)(L - 1) * 9 * MODW + 2 * D : nullptr, L > 0 ? (const float*)(F.ws + WS_MOD) + (size_t)(L - 1) * 9 * MODW + 5 * D : nullptr, L <= 1 ? F.in[I_X] : nullptr, L == 0 ? F.in[I_CTX] : nullptr));
        if (!ssd) {
            PHASE(3, pb + 1, { fresh_ids(F); SchedF1 S{F.ws}; pg8::EpiTile E; pg8::gemm_phase<pg8::EpiTile, SchedF1, false>(ring, F.wave, 256, D, 256, S, E); });
            PHASE(15, pb + 2, fft8_phase(F));
            PHASE(4, pb + 3, { fresh_ids(F); SchedF2 S{F.ws}; pg8::EpiTile E; pg8::gemm_phase<pg8::EpiTile, SchedF2, false>(ring, F.wave, 512, 512, 512, S, E);
                               tail_convert(F, 576, F.in[I_WDN] + (size_t)(L + 1) * DFF * D, (bf16_t*)(F.ws + WS_WDN) + (size_t)(L + 1) * D * DFF, DFF, D, 0, nullptr, nullptr, 64, 0); });
            PHASE(5, pb + 4, { fresh_ids(F); SchedAB<D, WS_Y> S{F.ws, WS_F, WS_WFOUR + (size_t)j * D * D * 2, 1};
                               pg8::EpiTile E; pg8::gemm_phase<pg8::EpiTile, SchedAB<D, WS_Y>, false>(ring, F.wave, D, D, D, S, E); });
        } else {
            PHASE(6, pb + 1, { fresh_ids(F); SchedIn S{F.ws, WS_WIN + (size_t)j * INP * D * 2, last ? 1 : 0}; pg8::EpiTile E; pg8::gemm_phase<pg8::EpiTile, SchedIn, false>(ring, F.wave, D, D, D, S, E);
                               if (!last) tail_convert(F, 64 * 41 + 8 * 41, F.in[I_WUP] + (size_t)L * D * 2 * DFF, (bf16_t*)(F.ws + WS_WUP) + (size_t)L * 2 * DFF * D, D, 2 * DFF, 0, nullptr, nullptr, 64, 0); });
            PHASE(7, pb + 2, ssd_conv_phase(F, j, last));
#ifndef SCAN_PROBE
#define SCAN_PROBE 0
#endif
            PHASE(8, pb + 3, { if (REPS(8) == 2 && rep_ == 0) ssd_scan_phase<SCAN_PROBE>(F, j, !last); else ssd_scan_phase<0>(F, j, !last); });
            PHASE(9, pb + 4, ssd_gate_norm_phase(F, j, last ? MLAT : MALL));
            PHASE(10, pb + 5, { fresh_ids(F); SchedAB<DI, WS_Y> S{F.ws, WS_XBCP, WS_WOUT + (size_t)j * D * DI * 2, last ? 0 : 1};
                                pg8::EpiTile E; pg8::gemm_phase<pg8::EpiTile, SchedAB<DI, WS_Y>, false>(ring, F.wave, DI, DI, DI, S, E); });
        }
        PHASE(2, pb + 6, norm_mod_phase(F, L, F.in[I_NFFN] + (size_t)L * D, 3, nrows_ffn, (const float*)(F.ws + WS_MOD) + (size_t)L * 9 * MODW + 2 * D, nullptr, L == 0 ? F.in[I_X] : nullptr, L == 0 ? F.in[I_CTX] : nullptr));
        PHASE(11, pb + 7, { fresh_ids(F); SchedUp S{F.ws, WS_WUP + (size_t)L * 2 * DFF * D * 2, nrows_ffn / 256}; pg8::EpiTile E; pg8::gemm_phase<pg8::EpiTile, SchedUp, false>(ring, F.wave, D, D, D, S, E);
                            if (L + 1 < DEPTH) { const int jn = (L + 1) >> 1;
                                if ((L + 1) & 1) tail_convert(F, (nrows_ffn / 256) * 44, F.in[I_WIN] + (size_t)jn * D * INW, (bf16_t*)(F.ws + WS_WIN) + (size_t)jn * INP * D, D, INW, 1,
                                                              F.in[I_WOUT] + (size_t)jn * DI * D, (bf16_t*)(F.ws + WS_WOUT) + (size_t)jn * D * DI, DI, D);
                                else tail_convert(F, (nrows_ffn / 256) * 44, F.in[I_FOURW] + (size_t)jn * D * D, (bf16_t*)(F.ws + WS_WFOUR) + (size_t)jn * D * D, D, D, 0,
                                                  F.in[I_WUP] + (size_t)(L + 1) * D * 2 * DFF, (bf16_t*)(F.ws + WS_WUP) + (size_t)(L + 1) * 2 * DFF * D, D, 2 * DFF); } });
        PHASE(12, pb + 8, ffn_conv_phase(F, L, nrows_ffn, REPS(12) == 2 && rep_ == 0));
        PHASE(13, pb + 9, { fresh_ids(F); SchedAB<DFF, WS_Y2> S{F.ws, WS_VAL, WS_WDN + (size_t)L * D * DFF * 2, last ? 0 : 1};
                            pg8::EpiTile E; pg8::gemm_phase<pg8::EpiTile, SchedAB<DFF, WS_Y2>, false>(ring, F.wave, DFF, DFF, DFF, S, E); });
    }
    PHASE(14, 42, final_norm_phase(F));
#undef PHASE
#undef REPS
#undef IN
#undef PHON
#undef SEAM
}

extern "C" void kernel_launch(void* const* d_in, const int* in_sizes, int n_in, void* d_out, int out_size, void* d_ws, size_t ws_size, hipStream_t stream) {
    static int grid = 0;
    if (grid == 0) {
        if (n_in != 22 || out_size != MLAT * D || ws_size < WS_END) { fprintf(stderr, "kernel_launch: unexpected problem (n_in %d, out %d, ws %zu < %zu)\n", n_in, out_size, ws_size, (size_t)WS_END); grid = -1; return; }
        int dev = 0, cus = 0, per_cu = 0;
        if (hipGetDevice(&dev) != hipSuccess || hipDeviceGetAttribute(&cus, hipDeviceAttributeMultiprocessorCount, dev) != hipSuccess) { grid = -1; return; }
        if (hipFuncSetAttribute((const void*)trunk_fwd, hipFuncAttributeMaxDynamicSharedMemorySize, LDS_BYTES) != hipSuccess) { fprintf(stderr, "kernel_launch: hipFuncSetAttribute failed\n"); grid = -1; return; }
        if (hipOccupancyMaxActiveBlocksPerMultiprocessor(&per_cu, (const void*)trunk_fwd, NWAVES * 64, LDS_BYTES) != hipSuccess || per_cu < 1) fprintf(stderr, "kernel_launch: occupancy query says %d\n", per_cu);
        (void)hipGetLastError();
        grid = cus;
    }
    if (grid < 0) return;
    (void)hipMemsetAsync((char*)d_ws + WS_CTL, 0, CTL_ZERO_BYTES, stream);
    Args a{};
    for (int i = 0; i < 22; ++i) a.in[i] = (const float*)d_in[i];
    a.out = (float*)d_out; a.ws = (unsigned char*)d_ws;
#if MK_N_LAUNCHES == 1
    a.ph_lo = 0; a.ph_hi = N_PHASES;
    hipLaunchKernelGGL(trunk_fwd, dim3(grid), dim3(NWAVES * 64), LDS_BYTES, stream, a);
#else
    for (int p = 0; p < N_PHASES; ++p) { if (!phase_exists(p)) continue; a.ph_lo = p; a.ph_hi = p + 1;
        hipLaunchKernelGGL(trunk_fwd, dim3(grid), dim3(NWAVES * 64), LDS_BYTES, stream, a); }
#endif
}
```

```cpp
#include <hip/hip_runtime.h>
#include <cstdio>
#include <cstdint>

#define LAS __attribute__((address_space(3)))
#define GAS __attribute__((address_space(1)))
typedef unsigned short bf16_t;
typedef short bf16x8 __attribute__((ext_vector_type(8)));
typedef float f32x4 __attribute__((ext_vector_type(4)));
typedef float f32x2 __attribute__((ext_vector_type(2)));
typedef unsigned u32x4 __attribute__((ext_vector_type(4)));
typedef unsigned u32x2 __attribute__((ext_vector_type(2)));

#ifndef MK_N_LAUNCHES
#define MK_N_LAUNCHES 1
#endif

constexpr int D = 2048, NB = 8, LSEQ = 2048, LCTX = 256, DEPTH = 4;
constexpr int MLAT = NB * LSEQ, MCTX = NB * LCTX, MALL = MLAT + MCTX;
constexpr int DFF = 5632, DI = 4096, GNW = 1024, NH = 64, NS = 128;
constexpr int XBC = DI + 2 * GNW;
constexpr int INW = 10368, INP = 10496;
constexpr int MODW = 6 * D;
constexpr float EPS = 1e-6f;
constexpr float LOG2E = 1.4426950408889634f;

constexpr size_t MiB = 1u << 20;
constexpr size_t WS_CTL = 0, CTL_ZERO_BYTES = 1 * MiB;
constexpr size_t WS_MOD = 1 * MiB;
constexpr size_t WS_W1 = 3 * MiB;
constexpr size_t WS_W2C = 3 * MiB + 512 * 1024;
constexpr size_t WS_W2 = 4 * MiB;
constexpr size_t WS_WFOUR = 20 * MiB;
constexpr size_t WS_WIN = 36 * MiB;
constexpr size_t WS_WOUT = 118 * MiB;
constexpr size_t WS_WUP = 150 * MiB;
constexpr size_t WS_WDN = 326 * MiB;
constexpr size_t WS_XC = 414 * MiB;
constexpr size_t WS_A = 430 * MiB;
constexpr size_t WS_R = 502 * MiB;
constexpr size_t WS_MODP = WS_R;
constexpr size_t WS_GATE = WS_R, WS_VAL = WS_R + 198 * MiB;
constexpr size_t WS_PQT = WS_R, WS_PQTC = WS_R + 128 * MiB, WS_F = WS_R + 144 * MiB;
constexpr size_t WS_VT = WS_R + 216 * MiB;
constexpr size_t WS_XBCP = WS_R;
constexpr size_t WS_Z = WS_R + 216 * MiB;
constexpr size_t WS_DT = WS_R + 360 * MiB;
constexpr size_t WS_XST = WS_R + 369 * MiB;
constexpr size_t WS_BM = WS_R + 513 * MiB;
constexpr size_t WS_BMT = WS_R + 549 * MiB;
constexpr size_t WS_CM = WS_R + 585 * MiB;
constexpr size_t WS_YB = WS_R + 621 * MiB;
constexpr size_t WS_Y = WS_R + 621 * MiB;
constexpr size_t WS_Y2 = WS_R + 400 * MiB;
constexpr size_t WS_PART = WS_R + 700 * MiB;
constexpr size_t WS_XB = WS_R + 765 * MiB;
constexpr size_t WS_END = WS_R + 829 * MiB;
constexpr int CW_BAR = 4096;

constexpr int RING_BYTES = 131072;
constexpr int LDSCTL_OFF = RING_BYTES, MISC_OFF = LDSCTL_OFF + 320;
constexpr int LDS_BYTES = 147456;
constexpr int NWAVES = 8;

typedef __bf16 bf16x2_t __attribute__((ext_vector_type(2)));
__device__ __forceinline__ unsigned cvt_pk_bf16(float lo, float hi) { const f32x2 v = {lo, hi}; return __builtin_bit_cast(unsigned, __builtin_convertvector(v, bf16x2_t)); }
__device__ __forceinline__ float bf_lo(unsigned u) { return __uint_as_float(u << 16); }
__device__ __forceinline__ float bf_hi(unsigned u) { return __uint_as_float(u & 0xffff0000u); }
__device__ __forceinline__ float silu_f(float v) { return v * __builtin_amdgcn_rcpf(1.0f + __expf(-v)); }
typedef float f32x2 __attribute__((ext_vector_type(2)));
__device__ __forceinline__ float wave_sum(float v, int lane) {
    (void)lane;
#define WS_SHR(c) v += __builtin_bit_cast(float, __builtin_amdgcn_update_dpp(0, __builtin_bit_cast(int, v), c, 0xf, 0xf, true))
    WS_SHR(0x111); WS_SHR(0x112); WS_SHR(0x114); WS_SHR(0x118);
#undef WS_SHR
    v += __builtin_bit_cast(float, __builtin_amdgcn_update_dpp(0, __builtin_bit_cast(int, v), 0x142, 0xa, 0xf, false));
    v += __builtin_bit_cast(float, __builtin_amdgcn_update_dpp(0, __builtin_bit_cast(int, v), 0x143, 0xc, 0xf, false));
    return __builtin_bit_cast(float, __builtin_amdgcn_readlane(__builtin_bit_cast(int, v), 63));
}
__device__ __forceinline__ int fresh_lane() { int l; asm volatile("v_mbcnt_lo_u32_b32 %0, -1, 0\n\tv_mbcnt_hi_u32_b32 %0, -1, %0" : "=v"(l)); return l; }
#define LDS_WAIT() asm volatile("s_waitcnt lgkmcnt(0)" ::: "memory")
#define VM_WAIT() asm volatile("s_waitcnt vmcnt(0)" ::: "memory")

namespace pg8 {
constexpr int BM = 256, BK = 64, HALF = 128, HTB = HALF * BK * 2, STAGE_BYTES = 8 * HTB, NXCD = 8, WGM = 8;
__host__ __device__ __forceinline__ int lds_byte(int r, int c) { const int st = (r >> 4) * 2 + (c >> 5), rr = r & 15, cc = c & 31, ob = rr * 64 + cc * 2; return st * 1024 + (ob ^ (((ob >> 9) & 1) << 5)); }
__host__ __device__ __forceinline__ void stage_rc(int b, int& R, int& C) { const int st = b / 1024, sb = b % 1024, swz = sb ^ (((sb >> 9) & 1) << 5); R = (st >> 1) * 16 + swz / 64; C = (st & 1) * 32 + (swz % 64) / 2; }
__host__ __device__ __forceinline__ int perm32(int rho) { const int n = rho >> 4, i = rho & 15; return 8 * (i >> 2) + 4 * n + (i & 3); }

struct Unit { int pm, pn, kq; };

template <int NN> __device__ __forceinline__ void tile_of_id(int wgid, int nM, int& pm, int& pn) {
    const int nwg = nM * NN;
    { const int q = nwg / NXCD, r = nwg % NXCD, xcd = wgid % NXCD, off = wgid / NXCD; wgid = (xcd < r ? xcd * (q + 1) : r * (q + 1) + (xcd - r) * q) + off; }
    const int nig = WGM * NN, gid = wgid / nig, fm = gid * WGM, gsz = (nM - fm) < WGM ? (nM - fm) : WGM;
    pm = fm + ((wgid % nig) % gsz); pn = (wgid % nig) / gsz;
}
template <int NN> __device__ __forceinline__ bool tile2d(int i, int nM, Unit& u) {
    const long L = (long)i * (int)gridDim.x + (int)blockIdx.x; if (L >= nM * NN) return false;
    tile_of_id<NN>((int)L, nM, u.pm, u.pn); u.kq = -1; return true;
}

struct EpiTile {
    static constexpr bool PERM = true;
    template <class Sched> __device__ __forceinline__ void operator()(const f32x4 (&acc)[2][2][4][2], const Unit& u, const Sched& S, int wr, int wc, int fr, int fq) const {
        const int rl0 = wr * 64 + fr, cl0 = wc * 32 + 8 * fq;
        char* uo; int ldo, kind; S.out(u, uo, ldo, kind);
        asm volatile("" : "+s"(ldo));
        if (kind == 0) {
            bf16_t* base = (bf16_t*)uo;
#pragma unroll
            for (int ai = 0; ai < 2; ++ai)
#pragma unroll
                for (int m = 0; m < 4; ++m) { bf16_t* rowp = base + (size_t)(rl0 + ai * HALF + m * 16) * ldo + cl0;
#pragma unroll
                    for (int bj = 0; bj < 2; ++bj) { const f32x4 v0 = acc[ai][bj][m][0], v1 = acc[ai][bj][m][1];
                        u32x4 w; w.x = cvt_pk_bf16(v0[0], v0[1]); w.y = cvt_pk_bf16(v0[2], v0[3]); w.z = cvt_pk_bf16(v1[0], v1[1]); w.w = cvt_pk_bf16(v1[2], v1[3]);
                        *(u32x4*)(rowp + bj * HALF) = w; } }
        } else {
            float* base = (float*)uo;
#pragma unroll
            for (int ai = 0; ai < 2; ++ai)
#pragma unroll
                for (int m = 0; m < 4; ++m) { float* rowp = base + (size_t)(rl0 + ai * HALF + m * 16) * ldo + cl0;
                    *(f32x4*)(rowp) = acc[ai][0][m][0]; *(f32x4*)(rowp + 4) = acc[ai][0][m][1];
                    if (kind == 2) { *(f32x4*)(rowp + HALF) = acc[ai][1][m][0]; *(f32x4*)(rowp + HALF + 4) = acc[ai][1][m][1]; } }
        }
    }
};
template <class Epi, class Sched, bool ALIGN_EPI>
__device__ __forceinline__ void gemm_phase(LAS unsigned char* lds, const int wid, const int lda_, const int ldb_, const int K_, const Sched& S, const Epi& E) {
    int lda = lda_, ldb = ldb_; (void)K_; asm volatile("" : "+s"(lda), "+s"(ldb));
    const int lane = fresh_lane(), tid = wid * 64 + lane;
    const int wr = wid >> 2, wc = wid & 3, fr = lane & 15, fq = lane >> 4;
    unsigned voffA[2], voffB[2];
#pragma unroll
    for (int i = 0; i < 2; ++i) { int R, C; stage_rc(tid * 16 + i * 8192, R, C); const int Rb = Epi::PERM ? ((R & ~31) + perm32(R & 31)) : R;
        voffA[i] = (unsigned)(R * lda + C) * 2u; voffB[i] = (unsigned)(Rb * ldb + C) * 2u; }
    const size_t kstep = (size_t)(BK * 2);
    const size_t hstepA = (size_t)HALF * lda * 2, hstepB = (size_t)HALF * ldb * 2;
    const unsigned ldsw = (unsigned)wid * 1024u;
    const int aoff = lds_byte(wr * 64 + fr, fq * 8), boff = lds_byte(wc * 32 + fr, fq * 8);
#define PG8_SA(b, h) (((b) * 2 + (h)) * HTB)
#define PG8_SB(b, h) ((4 + (b) * 2 + (h)) * HTB)
#define PG8_STAGE(bufoff, gbase, voff) do { _Pragma("unroll") for (int _i = 0; _i < 2; ++_i) \
        __builtin_amdgcn_global_load_lds((const unsigned*)((const char*)(gbase) + (voff)[_i]), (LAS unsigned*)(lds + (bufoff) + ldsw + _i * 8192), 16, 0, 0); } while (0)
#define PG8_LDA(dst, b, h) do { _Pragma("unroll") for (int m = 0; m < 4; ++m) _Pragma("unroll") for (int k = 0; k < 2; ++k) dst[m][k] = *(const LAS bf16x8*)(lds + PG8_SA(b, h) + aoff + m * 2048 + k * 1024); } while (0)
#define PG8_LDB(dst, b, h) do { _Pragma("unroll") for (int n = 0; n < 2; ++n) _Pragma("unroll") for (int k = 0; k < 2; ++k) dst[n][k] = *(const LAS bf16x8*)(lds + PG8_SB(b, h) + boff + n * 2048 + k * 1024); } while (0)
#define PG8_MMA(ai, bj, At, Bt) do { __builtin_amdgcn_s_setprio(1); _Pragma("unroll") for (int m = 0; m < 4; ++m) _Pragma("unroll") for (int n = 0; n < 2; ++n) _Pragma("unroll") for (int k = 0; k < 2; ++k) \
        acc[ai][bj][m][n] = __builtin_amdgcn_mfma_f32_16x16x32_bf16(Bt[n][k], At[m][k], acc[ai][bj][m][n], 0, 0, 0); __builtin_amdgcn_s_setprio(0); } while (0)
#define PG8_WAIT_V(n) asm volatile("s_waitcnt vmcnt(" #n ")" ::: "memory")
#define PG8_WAIT_L(n) asm volatile("s_waitcnt lgkmcnt(" #n ")" ::: "memory")
#define PG8_BAR __builtin_amdgcn_s_barrier()
#define PG8_SCHED __builtin_amdgcn_sched_barrier(0)
    Unit cur, nxt; int ui = 0;
    if (!S.next(0, cur)) return;
    f32x4 acc[2][2][4][2];
#pragma unroll
    for (int a = 0; a < 2; ++a)
#pragma unroll
        for (int b = 0; b < 2; ++b)
#pragma unroll
            for (int m = 0; m < 4; ++m)
#pragma unroll
                for (int n = 0; n < 2; ++n) acc[a][b][m][n] = (f32x4){0.f, 0.f, 0.f, 0.f};
    bf16x8 At[4][2], B0[2][2], B1[2][2];
    const char* cA = S.a(cur); const char* cB = S.b(cur);
    PG8_STAGE(PG8_SB(0, 0), cB, voffB); PG8_STAGE(PG8_SB(0, 1), cB + hstepB, voffB); PG8_STAGE(PG8_SA(0, 0), cA, voffA); PG8_STAGE(PG8_SA(0, 1), cA + hstepA, voffA);
    if (wr == 1) PG8_BAR;
    PG8_WAIT_V(2); PG8_BAR;
    PG8_STAGE(PG8_SB(1, 0), cB + kstep, voffB); PG8_STAGE(PG8_SA(1, 0), cA + kstep, voffA); PG8_STAGE(PG8_SB(1, 1), cB + hstepB + kstep, voffB);
    PG8_WAIT_V(6); PG8_BAR;
    for (;;) {
        const bool has_next = S.next(ui + 1, nxt);
        const int nt = S.nt(cur);
        const char* nA = has_next ? S.a(nxt) : cA; const char* nB = has_next ? S.b(nxt) : cB;
#pragma unroll 1
        for (int t = 0; t < nt; t += 2) {
            const bool last = (t == nt - 2);
            const char* a1 = cA + (size_t)(t + 1) * kstep;
            const char* a2 = last ? nA : cA + (size_t)(t + 2) * kstep; const char* b2 = last ? nB : cB + (size_t)(t + 2) * kstep;
            const char* a3 = a2 + kstep; const char* b3 = b2 + kstep;
            PG8_LDB(B0, 0, 0); PG8_LDB(B1, 0, 1); PG8_SCHED; PG8_LDA(At, 0, 0); PG8_STAGE(PG8_SA(1, 1), a1 + hstepA, voffA);
            PG8_WAIT_V(8); PG8_WAIT_L(0); PG8_BAR; PG8_MMA(0, 0, At, B0); PG8_MMA(0, 1, At, B1); PG8_BAR; PG8_SCHED;
            PG8_LDA(At, 0, 1); PG8_STAGE(PG8_SB(0, 0), b2, voffB); PG8_STAGE(PG8_SB(0, 1), b2 + hstepB, voffB); PG8_STAGE(PG8_SA(0, 0), a2, voffA);
            PG8_WAIT_V(8); PG8_WAIT_L(0); PG8_BAR; PG8_MMA(1, 0, At, B0); PG8_MMA(1, 1, At, B1); PG8_BAR; PG8_SCHED;
            PG8_LDB(B0, 1, 0); PG8_LDB(B1, 1, 1); PG8_SCHED; PG8_LDA(At, 1, 0); PG8_STAGE(PG8_SA(0, 1), a2 + hstepA, voffA);
            PG8_WAIT_V(8); PG8_WAIT_L(0); PG8_BAR; PG8_MMA(0, 0, At, B0); PG8_MMA(0, 1, At, B1); PG8_BAR; PG8_SCHED;
            PG8_LDA(At, 1, 1); PG8_STAGE(PG8_SB(1, 0), b3, voffB); PG8_STAGE(PG8_SB(1, 1), b3 + hstepB, voffB); PG8_STAGE(PG8_SA(1, 0), a3, voffA);
            PG8_WAIT_V(8); PG8_WAIT_L(0); PG8_BAR; PG8_MMA(1, 0, At, B0); PG8_MMA(1, 1, At, B1); PG8_BAR; PG8_SCHED;
        }
        if constexpr (ALIGN_EPI) { if (wr == 0) PG8_BAR; }
        E(acc, cur, S, wr, wc, fr, fq);
        if (!has_next) break;
#pragma unroll
        for (int a = 0; a < 2; ++a)
#pragma unroll
            for (int b = 0; b < 2; ++b)
#pragma unroll
                for (int m = 0; m < 4; ++m)
#pragma unroll
                    for (int n = 0; n < 2; ++n) acc[a][b][m][n] = (f32x4){0.f, 0.f, 0.f, 0.f};
        cur = nxt; cA = nA; cB = nB; ++ui;
        if constexpr (ALIGN_EPI) { if (wr == 1) PG8_BAR; }
    }
    PG8_WAIT_V(0);
    if constexpr (!ALIGN_EPI) { if (wr == 0) PG8_BAR; }
    PG8_BAR;
#undef PG8_SA
#undef PG8_SB
#undef PG8_STAGE
#undef PG8_LDA
#undef PG8_LDB
#undef PG8_MMA
#undef PG8_WAIT_V
#undef PG8_WAIT_L
#undef PG8_BAR
#undef PG8_SCHED
}
}

#define XB_TMO      128
#define XB_XCNT(j)  (256  + 64 * (j))
#define XB_XSUB(j)  (1280 + 64 * (j))
#define XB_XGEN(j)  (2304 + 64 * (j))
#define XB_TOP      3328
#define XB_TOPGEN   3392
#define XCD_BAR_WORDS 3456
#define XB_SPIN_CAP (1u << 18)
__device__ __forceinline__ unsigned xb_ld(unsigned* p)              { return __hip_atomic_load(p, __ATOMIC_RELAXED, __HIP_MEMORY_SCOPE_AGENT); }
__device__ __forceinline__ unsigned xb_add(unsigned* p, unsigned v) { return __hip_atomic_fetch_add(p, v, __ATOMIC_RELAXED, __HIP_MEMORY_SCOPE_AGENT); }
__device__ __forceinline__ unsigned xb_xcc_id() { return (unsigned)__builtin_amdgcn_s_getreg((3 << 11) | 20) & 0xFu; }
#define XB_SPIN(cond, bar) do { unsigned _sp = 0; while (cond) { __builtin_amdgcn_s_sleep(1); \
    if ((++_sp & 255u) == 0u) { if (xb_ld(&(bar)[XB_TMO])) break; if (_sp > XB_SPIN_CAP) { atomicAdd(&(bar)[XB_TMO], 1u); break; } } } } while (0)
struct XcdBarrier { unsigned* bar; unsigned x; volatile LAS unsigned* st; };
__device__ __forceinline__ XcdBarrier xcd_barrier_post(unsigned* bar, volatile LAS unsigned* st) {
    XcdBarrier b; b.bar = bar; b.x = xb_xcc_id(); b.st = st;
    if (threadIdx.x == 0) (void)xb_add(&bar[XB_XCNT(b.x)], 1u);
    return b;
}
__device__ __forceinline__ void xcd_barrier_complete(unsigned* bar, unsigned x, unsigned& nloc, unsigned& nx) {
    const unsigned G = gridDim.x * gridDim.y * gridDim.z;
    unsigned sum, cnt, mine, sp = 0u;
    for (;;) {
        sum = 0u; cnt = 0u; mine = 0u;
#pragma unroll
        for (unsigned j = 0; j < 16; ++j) { const unsigned c = xb_ld(&bar[XB_XCNT(j)]); sum += c; cnt += (c > 0u) ? 1u : 0u; mine = (j == x) ? c : mine; }
        if (sum == G) break;
        __builtin_amdgcn_s_sleep(1);
        if ((++sp & 255u) == 0u) { if (xb_ld(&bar[XB_TMO])) break; if (sp > XB_SPIN_CAP) { atomicAdd(&bar[XB_TMO], 1u); break; } }
    }
    nloc = mine > 0u ? mine : 1u; nx = cnt > 0u ? cnt : 1u;
}
__device__ __forceinline__ void xcd_barrier(const XcdBarrier& b, const bool leader  ) {
    asm volatile("s_waitcnt vmcnt(0)" ::: "memory");
    __syncthreads();
    if (leader) {
        unsigned* bar = b.bar;
        __builtin_amdgcn_s_waitcnt(0);
        unsigned nloc = b.st[0], nx = b.st[1];
        if (nloc == 0u) { xcd_barrier_complete(bar, b.x, nloc, nx); b.st[0] = nloc; b.st[1] = nx; }
        const unsigned old = xb_add(&bar[XB_XSUB(b.x)], 1u);
        const unsigned gen = old / nloc;
        if (old + 1u == (gen + 1u) * nloc) {
            __builtin_amdgcn_fence(__ATOMIC_RELEASE, "agent");
            asm volatile("s_waitcnt vmcnt(0)" ::: "memory");
            const unsigned og = xb_add(&bar[XB_TOP], 1u);
            const unsigned tg = og / nx;
            if (og + 1u == (tg + 1u) * nx) xb_add(&bar[XB_TOPGEN], 1u);
            else XB_SPIN(xb_ld(&bar[XB_TOPGEN]) == tg, bar);
            __builtin_amdgcn_fence(__ATOMIC_ACQUIRE, "agent");
            xb_add(&bar[XB_XGEN(b.x)], 1u);
            asm volatile("s_waitcnt vmcnt(0)" ::: "memory");
        } else {
            XB_SPIN(xb_ld(&bar[XB_XGEN(b.x)]) == gen, bar);
            __builtin_amdgcn_fence(__ATOMIC_ACQUIRE, "agent");
            asm volatile("s_waitcnt vmcnt(0)" ::: "memory");
        }
    }
    __syncthreads();
}

struct Args { const float* in[22]; float* out; unsigned char* ws; int ph_lo, ph_hi; };
struct Frame {
    LAS unsigned char* lds;
    int tid, lane, wave, G;
    const float* const* in;
    float* out; unsigned char* ws;
};
enum { I_X = 0, I_C, I_CTX, I_CCTX, I_WMOD, I_BMOD, I_NMIX, I_NFFN, I_FOURW, I_WIN, I_CONVW, I_CONVB, I_DTB, I_ALOG, I_DSK, I_SNG, I_WOUT, I_WUP, I_FCW, I_FCB, I_WDN, I_FING };

__device__ __forceinline__ void fresh_ids(Frame& F) { F.lane = fresh_lane(); F.tid = F.wave * 64 + F.lane; }

template <int K_, size_t YOFF> struct SchedAB {
    unsigned char* ws; size_t aoff, boff; int has_ctx;
    static constexpr int KT = K_ / 64;
    __device__ __forceinline__ bool next(int i, pg8::Unit& u) const {
        const int L = i * (int)gridDim.x + (int)blockIdx.x;
        if (L < 512) { pg8::tile_of_id<8>(L, 64, u.pm, u.pn); u.kq = -1; return true; }
        if (!has_ctx || L >= 768) return false;
        const int c2 = L - 512, ct = c2 >> 2; u.kq = c2 & 3; u.pm = 64 + (ct >> 3); u.pn = ct & 7; return true; }
    __device__ __forceinline__ int nt(const pg8::Unit& u) const { return u.kq < 0 ? KT : KT / 4; }
    __device__ __forceinline__ void out(const pg8::Unit& u, char*& o, int& ldo, int& kind) const { ldo = D;
        if (u.kq < 0) { o = (char*)ws + YOFF + ((size_t)u.pm * 256 * D + (size_t)u.pn * 256) * 2; kind = 0; }
        else { o = (char*)ws + WS_PART + (((size_t)u.kq * MCTX + (size_t)(u.pm - 64) * 256) * D + (size_t)u.pn * 256) * 2; kind = 0; } }
    __device__ __forceinline__ const char* a(const pg8::Unit& u) const { return (const char*)ws + aoff + (size_t)u.pm * 256 * K_ * 2 + (u.kq < 0 ? 0 : u.kq * (K_ / 4) * 2); }
    __device__ __forceinline__ const char* b(const pg8::Unit& u) const { return (const char*)ws + boff + (size_t)u.pn * 256 * K_ * 2 + (u.kq < 0 ? 0 : u.kq * (K_ / 4) * 2); }
};
struct SchedUp {
    unsigned char* ws; size_t boff; int nM;
    __device__ __forceinline__ int nt(const pg8::Unit&) const { return D / 64; }
    __device__ __forceinline__ bool next(int i, pg8::Unit& u) const { return pg8::tile2d<44>(i, nM, u); }
    __device__ __forceinline__ const char* a(const pg8::Unit& u) const { return (const char*)ws + WS_A + (size_t)u.pm * 256 * D * 2; }
    __device__ __forceinline__ const char* b(const pg8::Unit& u) const { return (const char*)ws + boff + (size_t)u.pn * 256 * D * 2; }
    __device__ __forceinline__ void out(const pg8::Unit& u, char*& o, int& ldo, int& kind) const {
        o = (char*)ws + (u.pn < 22 ? WS_GATE + (size_t)u.pn * 512 : WS_VAL + (size_t)(u.pn - 22) * 512) + (size_t)u.pm * 256 * DFF * 2; ldo = DFF; kind = 0; }
};
struct SchedIn {
    unsigned char* ws; size_t boff; int last;
    __device__ __forceinline__ int nt(const pg8::Unit&) const { return D / 64; }
    __device__ __forceinline__ bool next(int i, pg8::Unit& u) const {
        const int L = i * (int)gridDim.x + (int)blockIdx.x; u.kq = -1;
        if (L < 64 * 41) { pg8::tile_of_id<41>(L, 64, u.pm, u.pn); return true; }
        const int c2 = L - 64 * 41, nct = last ? 21 : 41; if (c2 >= 8 * nct) return false;
        u.pm = 64 + (c2 & 7); const int t = c2 >> 3; u.pn = (last && t >= 20) ? 40 : t; return true; }
    __device__ __forceinline__ const char* a(const pg8::Unit& u) const { return (const char*)ws + WS_A + (size_t)u.pm * 256 * D * 2; }
    __device__ __forceinline__ const char* b(const pg8::Unit& u) const { return (const char*)ws + boff + (size_t)u.pn * 256 * D * 2; }
    __device__ __forceinline__ void out(const pg8::Unit& u, char*& o, int& ldo, int& kind) const {
        if (u.pn < 24) { o = (char*)ws + WS_XBCP + ((size_t)u.pm * 256 * XBC + (size_t)u.pn * 256) * 2; ldo = XBC; kind = 0; }
        else if (u.pn < 40) { o = (char*)ws + WS_Z + ((size_t)u.pm * 256 * DI + (size_t)(u.pn - 24) * 256) * 2; ldo = DI; kind = 0; }
        else { o = (char*)ws + WS_DT + (size_t)u.pm * 256 * 128 * 4; ldo = 128; kind = 1; } }
};
struct SchedF1 {
    unsigned char* ws;
    __device__ __forceinline__ int nt(const pg8::Unit&) const { return 4; }
    __device__ __forceinline__ bool next(int i, pg8::Unit& u) const { return pg8::tile2d<72>(i, 16, u); }
    __device__ __forceinline__ const char* a(const pg8::Unit& u) const { return (const char*)ws + WS_W1 + (size_t)(u.pm & 1) * 256 * 256 * 2; }
    __device__ __forceinline__ const char* b(const pg8::Unit& u) const { return (const char*)ws + WS_A + ((size_t)u.pn * 256 * D + (size_t)(u.pm >> 1) * 256) * 2; }
    __device__ __forceinline__ void out(const pg8::Unit& u, char*& o, int& ldo, int& kind) const { const int g = u.pm >> 1, cs = u.pm & 1;
        if (u.pn < 64) { const int b = u.pn >> 3, p0 = (u.pn & 7) * 256; o = (char*)ws + WS_PQT + (((size_t)(b * 2048 + g * 256)) * 4096 + (size_t)cs * 2048 + p0) * 2; ldo = 4096; }
        else { const int b = u.pn - 64; o = (char*)ws + WS_PQTC + (((size_t)(b * 2048 + g * 256)) * 512 + (size_t)cs * 256) * 2; ldo = 512; }
        kind = 0; }
};
struct SchedF2 {
    unsigned char* ws;
    __device__ __forceinline__ int total() const { return 576; }
    __device__ __forceinline__ int nt(const pg8::Unit&) const { return 8; }
    __device__ __forceinline__ bool next(int i, pg8::Unit& u) const {
        const int L = i * (int)gridDim.x + (int)blockIdx.x; u.kq = -1;
        if (L < 512) { pg8::tile_of_id<8>(L, 64, u.pm, u.pn); return true; }
        if (L >= 576) return false;
        u.pm = 64 + ((L - 512) & 7); u.pn = (L - 512) >> 3; return true; }
    __device__ __forceinline__ const char* a(const pg8::Unit& u) const { return (const char*)ws + (u.pm < 64 ? WS_W2 : WS_W2C); }
    __device__ __forceinline__ const char* b(const pg8::Unit& u) const { return u.pm < 64 ? (const char*)ws + WS_VT + ((size_t)u.pm * 2048 + (size_t)u.pn * 256) * 512 * 2
                                                                                           : (const char*)ws + WS_PQTC + ((size_t)((u.pm - 64) * 2048 + u.pn * 256)) * 512 * 2; }
    __device__ __forceinline__ void out(const pg8::Unit& u, char*& o, int& ldo, int& kind) const { kind = 0;
        if (u.pm < 64) { o = (char*)ws + WS_F + (((size_t)((u.pm >> 3) * 2048 + (u.pm & 7))) * D + (size_t)u.pn * 256) * 2; ldo = 8 * D; }
        else { o = (char*)ws + WS_F + (((size_t)(MLAT + (u.pm - 64) * 256)) * D + (size_t)u.pn * 256) * 2; ldo = D; } }
};

__device__ __forceinline__ void p0_transpose_item(const float* W, int K, int N, bf16_t* WT, int k0, int n0, int drow0, LAS float* scr, int lane) {
    const int kk = lane >> 3, nq = (lane & 7) * 4;
    f32x4 v[8];
#pragma unroll
    for (int i = 0; i < 8; ++i) v[i] = __builtin_nontemporal_load((const f32x4*)(W + (size_t)(k0 + 8 * i + kk) * N + n0 + nq));
#pragma unroll
    for (int i = 0; i < 8; ++i) { LAS float* d = scr + (8 * i + kk) * 33 + nq; d[0] = v[i].x; d[1] = v[i].y; d[2] = v[i].z; d[3] = v[i].w; }
    LDS_WAIT(); asm volatile("" ::: "memory");
    const int c = lane & 7;
#pragma unroll
    for (int j = 0; j < 4; ++j) { const int n = (lane >> 3) + 8 * j; const LAS float* s = scr + (8 * c) * 33 + n;
        u32x4 o; o.x = cvt_pk_bf16(s[0 * 33], s[1 * 33]); o.y = cvt_pk_bf16(s[2 * 33], s[3 * 33]); o.z = cvt_pk_bf16(s[4 * 33], s[5 * 33]); o.w = cvt_pk_bf16(s[6 * 33], s[7 * 33]);
        *(u32x4*)(WT + (size_t)(drow0 + n) * K + k0 + 8 * c) = o; }
    LDS_WAIT(); asm volatile("" ::: "memory");
}
__device__ __forceinline__ int win_dst_row(int n0) { return n0 < 5120 ? n0 : (n0 < 5248 ? 10240 + (n0 - 5120) : n0 - 128); }

__device__ __forceinline__ void p0_prologue(Frame& F) {
    fresh_ids(F);
    LAS float* scr = (LAS float*)(F.lds + F.wave * 16384);
    const int gw = blockIdx.x * NWAVES + F.wave, NGW = F.G * NWAVES, lane = F.lane;
    unsigned char* ws = F.ws;
    {
        constexpr int NCG = MODW / 256, NKS = 8, NIT = DEPTH * NCG * NKS;
        const float* c = F.in[I_C]; const float* cc = F.in[I_CCTX]; const float* wm = F.in[I_WMOD];
        float* modp = (float*)(ws + WS_MODP);
        for (int it = gw; it < NIT; it += NGW) {
            const int ks = it % NKS, cg = (it / NKS) % NCG, L = it / (NKS * NCG), k0 = ks * 256;
            for (int e = lane; e < 9 * 256; e += 64) { const int k = e & 255, b = e >> 8; const float v = (b < 8) ? c[b * D + k0 + k] : cc[k0 + k]; scr[k * 12 + b] = silu_f(v); }
            LDS_WAIT(); asm volatile("" ::: "memory");
            f32x4 acc[9];
#pragma unroll
            for (int b = 0; b < 9; ++b) acc[b] = (f32x4){0.f, 0.f, 0.f, 0.f};
            const float* wp = wm + ((size_t)L * D + k0) * MODW + cg * 256 + lane * 4;
#pragma unroll 8
            for (int k = 0; k < 256; ++k) {
                const f32x4 wv = __builtin_nontemporal_load((const f32x4*)(wp + (size_t)k * MODW));
                const f32x4 s0 = *(const LAS f32x4*)(scr + k * 12), s1 = *(const LAS f32x4*)(scr + k * 12 + 4); const float s2 = scr[k * 12 + 8];
                acc[0] += wv * s0[0]; acc[1] += wv * s0[1]; acc[2] += wv * s0[2]; acc[3] += wv * s0[3];
                acc[4] += wv * s1[0]; acc[5] += wv * s1[1]; acc[6] += wv * s1[2]; acc[7] += wv * s1[3]; acc[8] += wv * s2;
            }
#pragma unroll
            for (int b = 0; b < 9; ++b) *(f32x4*)(modp + (((size_t)ks * DEPTH + L) * 9 + b) * MODW + cg * 256 + lane * 4) = acc[b];
            LDS_WAIT(); asm volatile("" ::: "memory");
        }
    }
    {
        constexpr int I_F = (D / 64) * (D / 32);
        constexpr int I_I = (D / 64) * (INW / 32);
        constexpr int I_O = (DI / 64) * (D / 32);
        constexpr int I_U = (D / 64) * (2 * DFF / 32);
        constexpr int I_D = (DFF / 64) * (D / 32);
        constexpr int NIT = I_F + 2 * I_U + 2 * I_D; (void)I_I; (void)I_O;
        for (int it = gw; it < NIT; it += NGW) {
            int r = it;
            if (r < I_F) { const int nblk = D / 32, kb = r / nblk, nb = r % nblk;
                p0_transpose_item(F.in[I_FOURW], D, D, (bf16_t*)(ws + WS_WFOUR), 64 * kb, 32 * nb, 32 * nb, scr, lane); continue; } r -= I_F;
            if (r < 2 * I_U) { const int jj = r / I_U; r -= jj * I_U; const int j = jj * (DEPTH - 1); const int nblk = 2 * DFF / 32, kb = r / nblk, nb = r % nblk;
                p0_transpose_item(F.in[I_WUP] + (size_t)j * D * 2 * DFF, D, 2 * DFF, (bf16_t*)(ws + WS_WUP) + (size_t)j * 2 * DFF * D, 64 * kb, 32 * nb, 32 * nb, scr, lane); continue; } r -= 2 * I_U;
            { const int jj = r / I_D; r -= jj * I_D; const int j = 2 * jj; const int nblk = D / 32, kb = r / nblk, nb = r % nblk;
                p0_transpose_item(F.in[I_WDN] + (size_t)j * DFF * D, DFF, D, (bf16_t*)(ws + WS_WDN) + (size_t)j * D * DFF, 64 * kb, 32 * nb, 32 * nb, scr, lane); }
        }
    }
    const size_t gt = (size_t)blockIdx.x * 512 + F.tid, NT = (size_t)F.G * 512;
    for (size_t i = gt; i < (size_t)2 * 128 * D / 8; i += NT) { const size_t j = i / (128 * D / 8), e = i % (128 * D / 8);
        *(u32x4*)((bf16_t*)(ws + WS_WIN) + ((size_t)j * INP + INW) * D + e * 8) = (u32x4){0u, 0u, 0u, 0u}; }
    {
        bf16_t* W1 = (bf16_t*)(ws + WS_W1);
        for (size_t i = gt; i < (size_t)512 * 256 / 2; i += NT) { const int m = (int)(i / 128), c0 = (int)(i % 128) * 2; float v[2];
#pragma unroll
            for (int e = 0; e < 2; ++e) { const int idx = ((m & 255) * (c0 + e)) & 255; const float a = (float)idx * (1.0f / 128.0f); v[e] = (m < 256) ? cospif(a) : sinpif(a); }
            *(unsigned*)(W1 + (size_t)m * 256 + c0) = cvt_pk_bf16(v[0], v[1]); }
        bf16_t* W2c = (bf16_t*)(ws + WS_W2C);
        for (size_t i = gt; i < (size_t)256 * 512 / 2; i += NT) { const int k1 = (int)(i / 256), c0 = (int)(i % 256) * 2; float v[2];
#pragma unroll
            for (int e = 0; e < 2; ++e) { const int cc = c0 + e, l = cc & 255; const int idx = (k1 * l) & 255; const float a = (float)idx * (1.0f / 128.0f); v[e] = ((cc < 256) ? cospif(a) : -sinpif(a)) * (1.0f / 256.0f); }
            *(unsigned*)(W2c + (size_t)k1 * 512 + c0) = cvt_pk_bf16(v[0], v[1]); }
        bf16_t* W2 = (bf16_t*)(ws + WS_W2); const float sc = 0.0013810679320049757f;
        for (size_t i = gt; i < (size_t)256 * 512 / 2; i += NT) { const int k2 = (int)(i / 256), c0 = (int)(i % 256) * 2; float v[2];
#pragma unroll
            for (int e = 0; e < 2; ++e) { const int cc = c0 + e, l = cc & 255; const int idx = (k2 * l) & 255; const float a = (float)idx * (1.0f / 128.0f); v[e] = ((cc < 256) ? cospif(a) : sinpif(a)) * sc; }
            *(unsigned*)(W2 + (size_t)k2 * 512 + c0) = cvt_pk_bf16(v[0], v[1]); }
    }
}
__device__ __forceinline__ void tail_convert(Frame& F, int total_units, const float* W0, bf16_t* WT0, int K0, int N0, int perm0, const float* W1, bf16_t* WT1, int K1, int N1) {
    const int rem = total_units % F.G;
    if ((int)blockIdx.x < rem) return;
    const int lane = fresh_lane();
    LAS float* scr = (LAS float*)(F.lds + F.wave * 16384);
    const int slot = ((int)blockIdx.x - rem) * NWAVES + F.wave, nslots = (F.G - rem) * NWAVES;
    const int n0 = (K0 / 64) * (N0 / 32), n1 = (K1 / 64) * (N1 / 32);
    const int kk = lane >> 3, nq = (lane & 7) * 4, c = lane & 7;
#define TC_ITEM(it_, W_, WT_, K_, N_, k0_, n0_, dr_) do { const bool first_ = (it_) < n0; const int r_ = first_ ? (it_) : (it_) - n0; \
        W_ = first_ ? W0 : W1; WT_ = first_ ? WT0 : WT1; K_ = first_ ? K0 : K1; N_ = first_ ? N0 : N1; \
        const int nblk_ = N_ / 32, kb_ = r_ / nblk_, nb_ = r_ - kb_ * nblk_; k0_ = 64 * kb_; n0_ = 32 * nb_; dr_ = (first_ && perm0) ? win_dst_row(32 * nb_) : 32 * nb_; } while (0)
    f32x4 v[8];
    int it = slot;
    if (it < n0 + n1) { const float* W; bf16_t* WT; int K, N, k0, nn0, dr; TC_ITEM(it, W, WT, K, N, k0, nn0, dr); (void)WT; (void)K; (void)dr;
#pragma unroll
        for (int i = 0; i < 8; ++i) v[i] = __builtin_nontemporal_load((const f32x4*)(W + (size_t)(k0 + 8 * i + kk) * N + nn0 + nq)); }
    for (; it < n0 + n1; it += nslots) {
        const float* W; bf16_t* WT; int K, N, k0, nn0, dr; TC_ITEM(it, W, WT, K, N, k0, nn0, dr); (void)W;
#pragma unroll
        for (int i = 0; i < 8; ++i) { LAS float* d = scr + (8 * i + kk) * 33 + nq; d[0] = v[i].x; d[1] = v[i].y; d[2] = v[i].z; d[3] = v[i].w; }
        const int itn = it + nslots;
        if (itn < n0 + n1) { const float* Wn; bf16_t* WTn; int Kn, Nn, k0n, n0n, drn; TC_ITEM(itn, Wn, WTn, Kn, Nn, k0n, n0n, drn); (void)WTn; (void)Kn; (void)drn;
#pragma unroll
            for (int i = 0; i < 8; ++i) v[i] = __builtin_nontemporal_load((const f32x4*)(Wn + (size_t)(k0n + 8 * i + kk) * Nn + n0n + nq)); }
        LDS_WAIT(); asm volatile("" ::: "memory");
#pragma unroll
        for (int j = 0; j < 4; ++j) { const int n = (lane >> 3) + 8 * j; const LAS float* sp = scr + (8 * c) * 33 + n;
            u32x4 o; o.x = cvt_pk_bf16(sp[0 * 33], sp[1 * 33]); o.y = cvt_pk_bf16(sp[2 * 33], sp[3 * 33]); o.z = cvt_pk_bf16(sp[4 * 33], sp[5 * 33]); o.w = cvt_pk_bf16(sp[6 * 33], sp[7 * 33]);
            *(u32x4*)(WT + (size_t)(dr + n) * K + k0 + 8 * c) = o; }
        LDS_WAIT(); asm volatile("" ::: "memory");
    }
#undef TC_ITEM
}
__device__ __forceinline__ void p0b_modreduce(Frame& F) {
    fresh_ids(F);
    const size_t gt = (size_t)blockIdx.x * 512 + F.tid, NT = (size_t)F.G * 512;
    const float* modp = (const float*)(F.ws + WS_MODP); float* mod = (float*)(F.ws + WS_MOD); const float* bm = F.in[I_BMOD];
    constexpr size_t PER = (size_t)DEPTH * 9 * MODW;
    for (size_t i = gt; i < PER / 4; i += NT) { const size_t e = i * 4; const int n = (int)(e % MODW), L = (int)(e / ((size_t)9 * MODW));
        f32x4 s = *(const f32x4*)(bm + (size_t)L * MODW + n);
#pragma unroll
        for (int ks = 0; ks < 8; ++ks) s += *(const f32x4*)(modp + (size_t)ks * PER + e);
        *(f32x4*)(mod + e) = s; }
}

__device__ __forceinline__ void norm_mod_phase(Frame& F, int L, const float* gvec, int sh_chunk, int nrows, const float* pg, const float* pg2, const float* xlat, const float* xctx) {
    fresh_ids(F);
    const int G_ = F.G, wg = (int)blockIdx.x, latper = (MLAT + G_ - 1) / G_, nctx = nrows - MLAT, ctxper = (nctx + G_ - 1) / G_;
    const int l0 = wg * latper < MLAT ? wg * latper : MLAT, l1 = l0 + latper < MLAT ? l0 + latper : MLAT;
    const int c0 = MLAT + (wg * ctxper < nctx ? wg * ctxper : nctx), c1 = MLAT + ((wg + 1) * ctxper < nctx ? (wg + 1) * ctxper : nctx);
    const int b0 = l0 >> 11, nbl = l1 > l0 ? ((l1 - 1) >> 11) - b0 + 1 : 0;
    const float* mod = (const float*)(F.ws + WS_MOD) + (size_t)L * 9 * MODW; bf16_t* A = (bf16_t*)(F.ws + WS_A);
    LAS float* V = (LAS float*)F.lds;
    for (int i = F.tid; i < 3 * 512; i += NWAVES * 64) { const int bs = i >> 9, c4 = i & 511, b = bs < 2 ? b0 + bs : 8;
        if (bs < 2 ? (bs < nbl) : (c1 > c0)) {
            const f32x4 g = ((const f32x4*)gvec)[c4], sh = ((const f32x4*)(mod + (size_t)b * MODW + sh_chunk * D))[c4], sc = ((const f32x4*)(mod + (size_t)b * MODW + sh_chunk * D + D))[c4];
            LAS f32x4* d = (LAS f32x4*)(V + (size_t)bs * 4 * D) + c4;
            d[0] = g * (sc + 1.0f); d[D / 4] = sh;
            if (pg != nullptr) d[2 * (D / 4)] = ((const f32x4*)(((b == 8 && pg2 != nullptr) ? pg2 : pg) + (size_t)b * MODW))[c4];
            if (pg2 != nullptr) d[3 * (D / 4)] = ((const f32x4*)(pg2 + (size_t)b * MODW))[c4]; } }
    __syncthreads();
    const int lane = F.lane, nl = l1 - l0, ntot = nl + (c1 - c0);
    for (int i = F.wave; i < ntot; i += NWAVES) {
        const int r = i < nl ? l0 + i : c0 + (i - nl);
        const LAS f32x4* vq = (const LAS f32x4*)(V + (size_t)(r < MLAT ? (r >> 11) - b0 : 2) * 4 * D) + lane;
        f32x4 v[8]; float ss = 0.f;
        const bool lat = r < MLAT, xbf = lat ? (xlat == nullptr) : (xctx == nullptr);
        const bool h1 = pg != nullptr && lat, h2 = pg2 != nullptr && lat, hc = pg != nullptr && !lat;
        u32x4 xraw[8]; u32x2 aux[4][8];
        if (xbf) { const u32x2* xb = (const u32x2*)((const bf16_t*)(F.ws + (lat ? WS_XB : WS_XC)) + (size_t)(lat ? r : r - MLAT) * D) + lane;
#pragma unroll
            for (int j = 0; j < 8; ++j) { const u32x2 w = __builtin_nontemporal_load(xb + 64 * j); xraw[j].x = w.x; xraw[j].y = w.y; }
        } else { const u32x4* xr = (const u32x4*)(lat ? xlat + (size_t)r * D : xctx + (size_t)(r - MLAT) * D) + lane;
#pragma unroll
            for (int j = 0; j < 8; ++j) xraw[j] = __builtin_nontemporal_load(xr + 64 * j); }
        if (h1) { const u32x2* yp = (const u32x2*)((const bf16_t*)(F.ws + WS_Y) + (size_t)r * D) + lane;
#pragma unroll
            for (int j = 0; j < 8; ++j) aux[0][j] = __builtin_nontemporal_load(yp + 64 * j); }
        if (h2) { const u32x2* yp = (const u32x2*)((const bf16_t*)(F.ws + WS_Y2) + (size_t)r * D) + lane;
#pragma unroll
            for (int j = 0; j < 8; ++j) aux[1][j] = __builtin_nontemporal_load(yp + 64 * j); }
        if (hc) { const u32x2* pp = (const u32x2*)((const bf16_t*)(F.ws + WS_PART) + (size_t)(r - MLAT) * D) + lane;
#pragma unroll
            for (int q = 0; q < 4; ++q)
#pragma unroll
                for (int j = 0; j < 8; ++j) aux[q][j] = pp[64 * j + (size_t)q * MCTX * D / 4]; }
        if (xbf) {
#pragma unroll
            for (int j = 0; j < 8; ++j) v[j] = (f32x4){bf_lo(xraw[j].x), bf_hi(xraw[j].x), bf_lo(xraw[j].y), bf_hi(xraw[j].y)};
        } else {
#pragma unroll
            for (int j = 0; j < 8; ++j) v[j] = __builtin_bit_cast(f32x4, xraw[j]);
        }
        if (h1) {
            const LAS f32x4* gq = vq + 2 * (D / 4);
#pragma unroll
            for (int j = 0; j < 8; ++j) { const u32x2 yy = aux[0][j]; const f32x4 y4 = {bf_lo(yy.x), bf_hi(yy.x), bf_lo(yy.y), bf_hi(yy.y)}; v[j] += gq[64 * j] * y4; }
        }
        if (h2) {
            const LAS f32x4* gq = vq + 3 * (D / 4); u32x2* xw_ = (u32x2*)((bf16_t*)(F.ws + WS_XB) + (size_t)r * D) + lane;
#pragma unroll
            for (int j = 0; j < 8; ++j) { const u32x2 yy = aux[1][j]; const f32x4 y4 = {bf_lo(yy.x), bf_hi(yy.x), bf_lo(yy.y), bf_hi(yy.y)}; v[j] += gq[64 * j] * y4; u32x2 w; w.x = cvt_pk_bf16(v[j].x, v[j].y); w.y = cvt_pk_bf16(v[j].z, v[j].w); xw_[64 * j] = w; }
        }
        if (hc) {
            const LAS f32x4* gq = vq + 2 * (D / 4); u32x2* xw_ = (u32x2*)((bf16_t*)(F.ws + WS_XC) + (size_t)(r - MLAT) * D) + lane;
#pragma unroll
            for (int j = 0; j < 8; ++j) { f32x4 p = {0.f, 0.f, 0.f, 0.f};
#pragma unroll
                for (int q = 0; q < 4; ++q) { const u32x2 w = aux[q][j]; p += (f32x4){bf_lo(w.x), bf_hi(w.x), bf_lo(w.y), bf_hi(w.y)}; }
                v[j] += gq[64 * j] * p; u32x2 w; w.x = cvt_pk_bf16(v[j].x, v[j].y); w.y = cvt_pk_bf16(v[j].z, v[j].w); xw_[64 * j] = w; }
        }
#pragma unroll
        for (int j = 0; j < 8; ++j) ss += (v[j].x * v[j].x + v[j].y * v[j].y) + (v[j].z * v[j].z + v[j].w * v[j].w);
        const float rstd = rsqrtf(wave_sum(ss, lane) * (1.0f / D) + EPS);
        u32x2* o = (u32x2*)(A + (size_t)r * D) + lane;
#pragma unroll
        for (int j = 0; j < 8; ++j) { const f32x4 y = v[j] * rstd * vq[64 * j] + vq[64 * j + D / 4];
            u32x2 w; w.x = cvt_pk_bf16(y.x, y.y); w.y = cvt_pk_bf16(y.z, y.w); o[64 * j] = w; }
    }
}
__device__ __forceinline__ void final_norm_phase(Frame& F) {
    fresh_ids(F);
    const int gw = blockIdx.x * NWAVES + F.wave, NGW = F.G * NWAVES, lane = F.lane;
    const f32x4* gp = (const f32x4*)F.in[I_FING] + lane;
    for (int r = gw; r < MLAT; r += NGW) {
        f32x4* xr = (f32x4*)(F.out + (size_t)r * D) + lane; const u32x2* xb = (const u32x2*)((const bf16_t*)(F.ws + WS_XB) + (size_t)r * D) + lane;
        const u32x2* yp = (const u32x2*)((const bf16_t*)(F.ws + WS_Y) + (size_t)r * D) + lane; const u32x2* yp2 = (const u32x2*)((const bf16_t*)(F.ws + WS_Y2) + (size_t)r * D) + lane;
        const f32x4* gq = (const f32x4*)((const float*)(F.ws + WS_MOD) + ((size_t)(DEPTH - 1) * 9 + (r >> 11)) * MODW + 2 * D) + lane; const f32x4* gq2 = gq + 3 * D / 4;
        f32x4 v[8]; float ss = 0.f;
#pragma unroll
        for (int j = 0; j < 8; ++j) { const u32x2 yy = __builtin_nontemporal_load(yp + 64 * j), y2 = __builtin_nontemporal_load(yp2 + 64 * j);
            const f32x4 y4 = {bf_lo(yy.x), bf_hi(yy.x), bf_lo(yy.y), bf_hi(yy.y)}, z4 = {bf_lo(y2.x), bf_hi(y2.x), bf_lo(y2.y), bf_hi(y2.y)};
            const u32x2 xw = __builtin_nontemporal_load(xb + 64 * j); v[j] = (f32x4){bf_lo(xw.x), bf_hi(xw.x), bf_lo(xw.y), bf_hi(xw.y)} + gq[64 * j] * y4; v[j] += gq2[64 * j] * z4;
            ss += (v[j].x * v[j].x + v[j].y * v[j].y) + (v[j].z * v[j].z + v[j].w * v[j].w); }
        const float rstd = rsqrtf(wave_sum(ss, lane) * (1.0f / D) + EPS);
#pragma unroll
        for (int j = 0; j < 8; ++j) xr[64 * j] = v[j] * rstd * gp[64 * j];
    }
}

__device__ __forceinline__ void unpack8(const u32x4 w, float (&f)[8]) {
    f[0] = bf_lo(w.x); f[1] = bf_hi(w.x); f[2] = bf_lo(w.y); f[3] = bf_hi(w.y); f[4] = bf_lo(w.z); f[5] = bf_hi(w.z); f[6] = bf_lo(w.w); f[7] = bf_hi(w.w);
}
__device__ __forceinline__ u32x4 pack8(const float (&f)[8]) { u32x4 w; w.x = cvt_pk_bf16(f[0], f[1]); w.y = cvt_pk_bf16(f[2], f[3]); w.z = cvt_pk_bf16(f[4], f[5]); w.w = cvt_pk_bf16(f[6], f[7]); return w; }

__device__ __forceinline__ void fft8_phase(Frame& F) {
    fresh_ids(F);
    const int gw = blockIdx.x * NWAVES + F.wave, NGW = F.G * NWAVES, lane = F.lane;
    const bf16_t* pqt = (const bf16_t*)(F.ws + WS_PQT); bf16_t* vt = (bf16_t*)(F.ws + WS_VT);
    float twc[8][4], tws[8][4];
#pragma unroll
    for (int k1 = 0; k1 < 8; ++k1)
#pragma unroll
        for (int e = 0; e < 4; ++e) { const int idx = (4 * lane + e) * k1; const float a = (float)idx * (1.0f / 1024.0f); twc[k1][e] = cospif(a); tws[k1][e] = sinpif(a); }
    constexpr float R2 = 0.70710678118654752f;
    for (int row = gw; row < NB * D; row += NGW) {
        const bf16_t* src = pqt + (size_t)row * 4096 + 4 * lane;
        u32x2 rp[8], rq[8];
#pragma unroll
        for (int l1 = 0; l1 < 8; ++l1) { rp[l1] = __builtin_nontemporal_load((const u32x2*)(src + 256 * l1)); rq[l1] = __builtin_nontemporal_load((const u32x2*)(src + 2048 + 256 * l1)); }
        const int b = row >> 11, n = row & 2047;
        bf16_t* dst = vt + (((size_t)b * 8) * 2048 + n) * 512 + 4 * lane;
        float vr[8][4], vi[8][4];
#pragma unroll
        for (int e = 0; e < 4; ++e) {
            float xr[8], xi[8];
#pragma unroll
            for (int l1 = 0; l1 < 8; ++l1) { const unsigned wp = (e < 2) ? rp[l1].x : rp[l1].y, wq = (e < 2) ? rq[l1].x : rq[l1].y; xr[l1] = (e & 1) ? bf_hi(wp) : bf_lo(wp); xi[l1] = -((e & 1) ? bf_hi(wq) : bf_lo(wq)); }
            const float a0r = xr[0] + xr[4], a0i = xi[0] + xi[4], a1r = xr[0] - xr[4], a1i = xi[0] - xi[4], a2r = xr[2] + xr[6], a2i = xi[2] + xi[6], a3r = xr[2] - xr[6], a3i = xi[2] - xi[6];
            const float a4r = xr[1] + xr[5], a4i = xi[1] + xi[5], a5r = xr[1] - xr[5], a5i = xi[1] - xi[5], a6r = xr[3] + xr[7], a6i = xi[3] + xi[7], a7r = xr[3] - xr[7], a7i = xi[3] - xi[7];
            const float b0r = a0r + a2r, b0i = a0i + a2i, b2r = a0r - a2r, b2i = a0i - a2i, b1r = a1r + a3i, b1i = a1i - a3r, b3r = a1r - a3i, b3i = a1i + a3r;
            const float c0r = a4r + a6r, c0i = a4i + a6i, c2r = a4r - a6r, c2i = a4i - a6i, c1r = a5r + a7i, c1i = a5i - a7r, c3r = a5r - a7i, c3i = a5i + a7r;
            const float d1r = (c1r + c1i) * R2, d1i = (c1i - c1r) * R2, d2r = c2i, d2i = -c2r, d3r = (c3i - c3r) * R2, d3i = -(c3r + c3i) * R2;
            float yr[8], yi[8];
            yr[0] = b0r + c0r; yi[0] = b0i + c0i; yr[4] = b0r - c0r; yi[4] = b0i - c0i;
            yr[1] = b1r + d1r; yi[1] = b1i + d1i; yr[5] = b1r - d1r; yi[5] = b1i - d1i;
            yr[2] = b2r + d2r; yi[2] = b2i + d2i; yr[6] = b2r - d2r; yi[6] = b2i - d2i;
            yr[3] = b3r + d3r; yi[3] = b3i + d3i; yr[7] = b3r - d3r; yi[7] = b3i - d3i;
#pragma unroll
            for (int k1 = 0; k1 < 8; ++k1) { const float c = twc[k1][e], sn = tws[k1][e]; vr[k1][e] = yr[k1] * c + yi[k1] * sn; vi[k1][e] = yi[k1] * c - yr[k1] * sn; }
        }
#pragma unroll
        for (int k1 = 0; k1 < 8; ++k1) { u32x2 o; o.x = cvt_pk_bf16(vr[k1][0], vr[k1][1]); o.y = cvt_pk_bf16(vr[k1][2], vr[k1][3]); *(u32x2*)(dst + (size_t)k1 * 2048 * 512) = o;
            u32x2 p; p.x = cvt_pk_bf16(vi[k1][0], vi[k1][1]); p.y = cvt_pk_bf16(vi[k1][2], vi[k1][3]); *(u32x2*)(dst + (size_t)k1 * 2048 * 512 + 256) = p; }
    }
}

__device__ __forceinline__ void ssd_conv_phase(Frame& F, int j, bool skip_ctx_c) {
    fresh_ids(F);
    const int gw = blockIdx.x * NWAVES + F.wave, NGW = F.G * NWAVES, lane = F.lane, cq = lane & 7, tq = lane >> 3;
    const bf16_t* pre = (const bf16_t*)(F.ws + WS_XBCP);
    const float* cw = F.in[I_CONVW] + (size_t)j * 3 * XBC; const float* cb_ = F.in[I_CONVB] + (size_t)j * XBC;
    bf16_t* xst = (bf16_t*)(F.ws + WS_XST); bf16_t* bm = (bf16_t*)(F.ws + WS_BM); bf16_t* bmt = (bf16_t*)(F.ws + WS_BMT); bf16_t* cm = (bf16_t*)(F.ws + WS_CM);
    constexpr int NTB = MALL / 64, NCB = XBC / 64;
    for (int job = gw; job < NTB * NCB; job += NGW) {
        const int cb = job % NCB, tb = job / NCB;
        const int rb = tb * 64;
        if (skip_ctx_c && rb >= MLAT && cb >= 80) continue;
        int seq0, T, sb;
        if (rb < MLAT) { sb = rb >> 11; seq0 = sb << 11; T = LSEQ; } else { sb = (rb - MLAT) >> 8; seq0 = MLAT + (sb << 8); T = LCTX; }
        const int tl = rb - seq0 + tq * 8;
        const int c0 = cb * 64 + cq * 8;
        float w0[8], w1[8], w2[8], bi[8];
        { const f32x4* p = (const f32x4*)(cw + c0); const f32x4 a = p[0], b = p[1]; w0[0] = a.x; w0[1] = a.y; w0[2] = a.z; w0[3] = a.w; w0[4] = b.x; w0[5] = b.y; w0[6] = b.z; w0[7] = b.w; }
        { const f32x4* p = (const f32x4*)(cw + XBC + c0); const f32x4 a = p[0], b = p[1]; w1[0] = a.x; w1[1] = a.y; w1[2] = a.z; w1[3] = a.w; w1[4] = b.x; w1[5] = b.y; w1[6] = b.z; w1[7] = b.w; }
        { const f32x4* p = (const f32x4*)(cw + 2 * XBC + c0); const f32x4 a = p[0], b = p[1]; w2[0] = a.x; w2[1] = a.y; w2[2] = a.z; w2[3] = a.w; w2[4] = b.x; w2[5] = b.y; w2[6] = b.z; w2[7] = b.w; }
        { const f32x4* p = (const f32x4*)(cb_ + c0); const f32x4 a = p[0], b = p[1]; bi[0] = a.x; bi[1] = a.y; bi[2] = a.z; bi[3] = a.w; bi[4] = b.x; bi[5] = b.y; bi[6] = b.z; bi[7] = b.w; }
        u32x4 raw[10];
#pragma unroll
        for (int i = 0; i < 10; ++i) { const int tt = tl - 1 + i; raw[i] = (tt >= 0 && tt < T) ? *(const u32x4*)(pre + (size_t)(seq0 + tt) * XBC + c0) : (u32x4){0u, 0u, 0u, 0u}; }
        float o[8][8];
        { float pa[8], pb[8], pc[8]; unpack8(raw[0], pa); unpack8(raw[1], pb);
#pragma unroll
          for (int i = 0; i < 8; ++i) { unpack8(raw[i + 2], pc);
#pragma unroll
              for (int c = 0; c < 8; ++c) o[i][c] = silu_f(bi[c] + w0[c] * pa[c] + w1[c] * pb[c] + w2[c] * pc[c]);
#pragma unroll
              for (int c = 0; c < 8; ++c) { pa[c] = pb[c]; pb[c] = pc[c]; } } }
        if (cb < 64) {
            bf16_t* dst = (rb < MLAT) ? xst + ((size_t)sb * DI + c0) * LSEQ + tl : xst + (size_t)NB * DI * LSEQ + ((size_t)sb * DI + c0) * LCTX + tl;
#pragma unroll
            for (int c = 0; c < 8; ++c) { float t8[8];
#pragma unroll
                for (int i = 0; i < 8; ++i) t8[i] = o[i][c];
                *(u32x4*)(dst + (size_t)c * T) = pack8(t8); }
        } else if (cb < 80) {
            const int cc = c0 - DI;
#pragma unroll
            for (int i = 0; i < 8; ++i) *(u32x4*)(bm + (size_t)(seq0 + tl + i) * GNW + cc) = pack8(o[i]);
            bf16_t* dst = (rb < MLAT) ? bmt + ((size_t)sb * GNW + cc) * LSEQ + tl : bmt + (size_t)NB * GNW * LSEQ + ((size_t)sb * GNW + cc) * LCTX + tl;
#pragma unroll
            for (int c = 0; c < 8; ++c) { float t8[8];
#pragma unroll
                for (int i = 0; i < 8; ++i) t8[i] = o[i][c];
                *(u32x4*)(dst + (size_t)c * T) = pack8(t8); }
        } else {
            const int cc = c0 - DI - GNW;
#pragma unroll
            for (int i = 0; i < 8; ++i) *(u32x4*)(cm + (size_t)(seq0 + tl + i) * GNW + cc) = pack8(o[i]);
        }
    }
}

__device__ __forceinline__ void ffn_conv_phase(Frame& F, int L, int nrows, bool probe_alt = false) {
    fresh_ids(F);
    const int gw = blockIdx.x * NWAVES + F.wave, NGW = F.G * NWAVES;
    const bf16_t* gate = (const bf16_t*)(F.ws + WS_GATE); bf16_t* val = (bf16_t*)(F.ws + WS_VAL);
    const float* cw = F.in[I_FCW] + (size_t)L * 9 * DFF; const float* cb_ = F.in[I_FCB] + (size_t)L * DFF;
    const int NTB = nrows / 64; constexpr int NCB = DFF / 64;
    for (int job = gw; job < NTB * NCB; job += NGW) {
        const int lane = fresh_lane(), cq = lane & 7, tq = lane >> 3;
        const int cb = job / NTB, tb = job % NTB;
        const int rb = tb * 64, c0 = cb * 64 + cq * 8;
        const bool lat = rb < MLAT;
        const int gr = lat ? (tb & 31) : 0, base = lat ? (rb - gr * 64) : (MLAT + (((rb - MLAT) >> 8) << 8)), q = lat ? 0 : (((rb - MLAT) >> 6) & 3);
        u32x4 raw[3][10], rv[8];
#define FFN_LOAD_ROW(dr) do { const bool rowok_ = lat ? (gr + (dr) - 1 >= 0 && gr + (dr) - 1 < 32) : ((dr) == 1); const int rbase_ = lat ? base + (gr + (dr) - 1) * 64 : base + q * 64; \
            _Pragma("unroll") for (int i_ = 0; i_ < 10; ++i_) { const int col_ = tq * 8 - 1 + i_; const bool ok_ = rowok_ && (lat ? (col_ >= 0 && col_ < 64) : (q * 64 + col_ >= 0 && q * 64 + col_ < LCTX)); \
                raw[dr][i_] = ok_ ? *(const u32x4*)(gate + (size_t)(rbase_ + col_) * DFF + c0) : (u32x4){0u, 0u, 0u, 0u}; } } while (0)
#define FFN_UNPK(w4_, p_) do { p_[0] = (f32x2){bf_lo(w4_.x), bf_hi(w4_.x)}; p_[1] = (f32x2){bf_lo(w4_.y), bf_hi(w4_.y)}; p_[2] = (f32x2){bf_lo(w4_.z), bf_hi(w4_.z)}; p_[3] = (f32x2){bf_lo(w4_.w), bf_hi(w4_.w)}; } while (0)
#define FFN_ACC_ROW(dr) do { f32x2 w_[3][4]; \
            _Pragma("unroll") for (int dc_ = 0; dc_ < 3; ++dc_) { const f32x4* p_ = (const f32x4*)(cw + (size_t)((dr) * 3 + dc_) * DFF + c0); const f32x4 a_ = p_[0], b_ = p_[1]; \
                w_[dc_][0] = (f32x2){a_.x, a_.y}; w_[dc_][1] = (f32x2){a_.z, a_.w}; w_[dc_][2] = (f32x2){b_.x, b_.y}; w_[dc_][3] = (f32x2){b_.z, b_.w}; } \
            f32x2 pa_[4], pb_[4], pc_[4]; FFN_UNPK(raw[dr][0], pa_); FFN_UNPK(raw[dr][1], pb_); \
            _Pragma("unroll") for (int i_ = 0; i_ < 8; ++i_) { FFN_UNPK(raw[dr][i_ + 2], pc_); \
                _Pragma("unroll") for (int c_ = 0; c_ < 4; ++c_) { acc[i_][c_] += w_[0][c_] * pa_[c_]; acc[i_][c_] += w_[1][c_] * pb_[c_]; acc[i_][c_] += w_[2][c_] * pc_[c_]; }     \
                _Pragma("unroll") for (int c_ = 0; c_ < 4; ++c_) { pa_[c_] = pb_[c_]; pb_[c_] = pc_[c_]; } } } while (0)
        FFN_LOAD_ROW(0); FFN_LOAD_ROW(1);
        f32x2 acc[8][4];
        { const f32x4* p = (const f32x4*)(cb_ + c0); const f32x4 a = p[0], b = p[1];
#pragma unroll
          for (int i = 0; i < 8; ++i) { acc[i][0] = (f32x2){a.x, a.y}; acc[i][1] = (f32x2){a.z, a.w}; acc[i][2] = (f32x2){b.x, b.y}; acc[i][3] = (f32x2){b.z, b.w}; } }
        FFN_ACC_ROW(0);
        FFN_LOAD_ROW(2);
#pragma unroll
        for (int i = 0; i < 8; ++i) rv[i] = __builtin_nontemporal_load((const u32x4*)(val + (size_t)(rb + tq * 8 + i) * DFF + c0));
        FFN_ACC_ROW(1);
        FFN_ACC_ROW(2);
#undef FFN_LOAD_ROW
#undef FFN_ACC_ROW
#undef FFN_UNPK
#pragma unroll
        for (int i = 0; i < 8; ++i) { bf16_t* vp = val + (size_t)(rb + tq * 8 + i) * DFF + c0; float v[8]; unpack8(rv[i], v);
#pragma unroll
            for (int c = 0; c < 4; ++c) { v[2 * c] *= silu_f(acc[i][c].x); v[2 * c + 1] *= silu_f(acc[i][c].y); }
            *(u32x4*)(probe_alt ? vp + (size_t)202 * MiB / 2 : vp) = pack8(v); }
    }
}

__device__ __forceinline__ void ssd_gate_norm_phase(Frame& F, int j, int nrows) {
    fresh_ids(F);
    const int gw = blockIdx.x * NWAVES + F.wave, NGW = F.G * NWAVES, lane = F.lane;
    bf16_t* yf = (bf16_t*)(F.ws + WS_XBCP); const bf16_t* yb = (const bf16_t*)(F.ws + WS_YB); const bf16_t* z = (const bf16_t*)(F.ws + WS_Z);
    const float* ng = F.in[I_SNG] + (size_t)j * DI;
    for (int r = gw; r < nrows; r += NGW) {
#pragma unroll 4
        for (int g = 0; g < 8; ++g) { const size_t off = (size_t)r * DI + g * 512 + lane * 8;
            float a[8], b[8], zz[8]; unpack8(__builtin_nontemporal_load((const u32x4*)(yf + off)), a); unpack8(__builtin_nontemporal_load((const u32x4*)(yb + off)), b); unpack8(__builtin_nontemporal_load((const u32x4*)(z + off)), zz);
            float ss = 0.f;
#pragma unroll
            for (int c = 0; c < 8; ++c) { a[c] = (a[c] + b[c]) * silu_f(zz[c]); ss += a[c] * a[c]; }
            const float rs = rsqrtf(wave_sum(ss, lane) * (1.0f / 512.0f) + EPS);
            const f32x4* gp = (const f32x4*)(ng + g * 512 + lane * 8); const f32x4 g0 = gp[0], g1 = gp[1];
            a[0] *= rs * g0.x; a[1] *= rs * g0.y; a[2] *= rs * g0.z; a[3] *= rs * g0.w; a[4] *= rs * g1.x; a[5] *= rs * g1.y; a[6] *= rs * g1.z; a[7] *= rs * g1.w;
            *(u32x4*)(yf + off) = pack8(a); }
    }
}

__device__ __forceinline__ float softplus_f(float x) { return x > 15.f ? x : __logf(1.0f + __expf(x)); }
__device__ __forceinline__ float incl_scan64(float v, int lane) {
    (void)lane;
#define ISC_SHR(c) v += __builtin_bit_cast(float, __builtin_amdgcn_update_dpp(0, __builtin_bit_cast(int, v), c, 0xf, 0xf, true))
    ISC_SHR(0x111); ISC_SHR(0x112); ISC_SHR(0x114); ISC_SHR(0x118);
#undef ISC_SHR
    v += __builtin_bit_cast(float, __builtin_amdgcn_update_dpp(0, __builtin_bit_cast(int, v), 0x142, 0xa, 0xf, false));
    v += __builtin_bit_cast(float, __builtin_amdgcn_update_dpp(0, __builtin_bit_cast(int, v), 0x143, 0xc, 0xf, false));
    return v;
}
template <int MODE> __device__ __forceinline__ void ssd_scan_phase(Frame& F, int j, bool ctx_out) {
    fresh_ids(F);
    const int w = F.wave;
    LAS unsigned char* CS = F.lds; LAS unsigned char* R0 = F.lds + 32768; LAS unsigned char* R1 = F.lds + 65536;
    LAS float* tab = (LAS float*)(F.lds + 98304 + w * 2048);
    const bf16_t* cm = (const bf16_t*)(F.ws + WS_CM); const bf16_t* bm = (const bf16_t*)(F.ws + WS_BM); const bf16_t* bmt = (const bf16_t*)(F.ws + WS_BMT); const bf16_t* xst = (const bf16_t*)(F.ws + WS_XST);
    const float* dtb = (const float*)(F.ws + WS_DT);
#define SCAN_DMA(dstbase, srcptr_row0, pitch_elems) do { _Pragma("unroll") for (int q_ = 0; q_ < 4; ++q_) { const int idx_ = tid + 512 * q_, row_ = idx_ >> 4, c16_ = (idx_ & 15) ^ (row_ & 15); \
        __builtin_amdgcn_global_load_lds((const unsigned*)((srcptr_row0) + (size_t)row_ * (pitch_elems) + c16_ * 8), (LAS unsigned*)((dstbase) + (w * 64 + 512 * q_) * 16), 16, 0, 0); } } while (0)
    for (int item = blockIdx.x; item < 256; item += F.G) {
        const int ph = item & 1, dir = (item >> 1) & 1, g = (item >> 2) & 7, b = item >> 5, h = g * 8 + w;
        const float a_h = -expf(F.in[I_ALOG][(j * 2 + dir) * NH + h]) * LOG2E;
        const float dtbias = F.in[I_DTB][(j * 2 + dir) * NH + h];
        const float dsk = dir == 0 ? F.in[I_DSK][(j * 2 + 0) * NH + h] + F.in[I_DSK][(j * 2 + 1) * NH + h] : 0.f;
        bf16_t* yout = dir == 0 ? (bf16_t*)(F.ws + WS_XBCP) : (bf16_t*)(F.ws + WS_YB);
        f32x4 hT[8][2];
#pragma unroll
        for (int nt = 0; nt < 8; ++nt) { hT[nt][0] = (f32x4){0.f, 0.f, 0.f, 0.f}; hT[nt][1] = (f32x4){0.f, 0.f, 0.f, 0.f}; }
        {
            const int tid0 = w * 64 + fresh_lane(); const int tid = tid0;
            const bool isctx0 = true; const int cc0 = dir == 0 ? 0 : 1; const int row00 = MLAT + b * LCTX + cc0 * 128;
            if (ctx_out && !(MODE & 8) && isctx0) { SCAN_DMA(CS, cm + (size_t)row00 * GNW + g * 128, GNW); SCAN_DMA(R0, bm + (size_t)row00 * GNW + g * 128, GNW); }
        }
        float dtr0, dtr1;
        { const int lane0 = fresh_lane(); const int cc0 = dir == 0 ? 0 : 1, row00 = MLAT + b * LCTX + cc0 * 128;
          dtr0 = dtb[(size_t)(row00 + lane0) * 128 + dir * 64 + h]; dtr1 = dtb[(size_t)(row00 + 64 + lane0) * 128 + dir * 64 + h]; }
        bf16x8 xf[2][4];
        { const int lane0 = fresh_lane(), fr0 = lane0 & 15, fq0 = lane0 >> 4; const int cc0 = dir == 0 ? 0 : 1;
          const bf16_t* xl0 = xst + (size_t)NB * DI * LSEQ + ((size_t)(b * DI + h * 64 + ph * 32)) * LCTX + cc0 * 128 + (size_t)fr0 * LCTX + 8 * fq0;
#pragma unroll
          for (int pt = 0; pt < 2; ++pt)
#pragma unroll
              for (int ks = 0; ks < 4; ++ks) xf[pt][ks] = *(const bf16x8*)(xl0 + (size_t)(16 * pt) * LCTX + 32 * ks); }
        for (int k = 0; k < 18; ++k) {
            const bool isctx = k < 2; const int cc = isctx ? (dir == 0 ? k : 1 - k) : (dir == 0 ? k - 2 : 17 - k);
            const int row0 = isctx ? MLAT + b * LCTX + cc * 128 : b * LSEQ + cc * 128, T = isctx ? LCTX : LSEQ;
            const bf16_t* xp = isctx ? xst + (size_t)NB * DI * LSEQ + ((size_t)(b * DI + h * 64 + ph * 32)) * LCTX + cc * 128 : xst + ((size_t)(b * DI + h * 64 + ph * 32)) * LSEQ + cc * 128;
            const bf16_t* btp = isctx ? bmt + (size_t)NB * GNW * LSEQ + ((size_t)(b * GNW + g * 128)) * LCTX + cc * 128 : bmt + ((size_t)(b * GNW + g * 128)) * LSEQ + cc * 128;
            const bool need_y = ctx_out || !isctx;
            LAS unsigned char* BS = (k & 1) ? R1 : R0; LAS unsigned char* GS = (k & 1) ? R0 : R1;
            const int lane = fresh_lane(), fr = lane & 15, fq = lane >> 4, tid = w * 64 + lane;
            const bf16_t* xl = xp + (size_t)fr * T + 8 * fq;
            float tot = -1.f;
            if (!(MODE & 16)) {
                const float dt0 = softplus_f(dtr0 + dtbias), dt1 = softplus_f(dtr1 + dtbias);
                const float dA0 = dt0 * a_h, dA1 = dt1 * a_h;
                const float p0 = incl_scan64(dA0, lane), tot0 = __builtin_bit_cast(float, __builtin_amdgcn_readlane(__builtin_bit_cast(int, p0), 63)), p1 = incl_scan64(dA1, lane) + tot0; tot = __builtin_bit_cast(float, __builtin_amdgcn_readlane(__builtin_bit_cast(int, p1), 63));
                const float c0 = dir == 0 ? p0 : tot - p0 + dA0, c1 = dir == 0 ? p1 : tot - p1 + dA1;
                tab[lane] = c0; tab[64 + lane] = c1; tab[128 + lane] = dt0; tab[192 + lane] = dt1;
                tab[256 + lane] = dt0 * exp2f(tot - c0); tab[320 + lane] = dt1 * exp2f(tot - c1);
                asm volatile("" ::: "memory");
                const int r0 = dir == 0 ? (lane | 31) : (lane & ~31);
                tab[384 + lane] = dt0 * __builtin_amdgcn_exp2f(tab[r0] - c0); tab[448 + lane] = dt1 * __builtin_amdgcn_exp2f(tab[64 + r0] - c1);
            }
            VM_WAIT(); __syncthreads();
            bf16x8 xs2[2][4];
#pragma unroll
            for (int ks = 0; ks < 4; ++ks) { const f32x4 fa = *(const LAS f32x4*)(tab + 384 + 32 * ks + 8 * fq), fb = *(const LAS f32x4*)(tab + 384 + 32 * ks + 8 * fq + 4);
#pragma unroll
                for (int pt = 0; pt < 2; ++pt) { float xv[8]; unpack8(__builtin_bit_cast(u32x4, xf[pt][ks]), xv);
                    xv[0] *= fa.x; xv[1] *= fa.y; xv[2] *= fa.z; xv[3] *= fa.w; xv[4] *= fb.x; xv[5] *= fb.y; xv[6] *= fb.z; xv[7] *= fb.w;
                    xs2[pt][ks] = __builtin_bit_cast(bf16x8, pack8(xv)); } }
            if (need_y && !(MODE & 2)) {
                bf16x8 cf[4];
#pragma unroll
                for (int ks = 0; ks < 4; ++ks) cf[ks] = *(const LAS bf16x8*)(CS + (16 * w + fr) * 256 + (((4 * ks + fq) ^ fr) << 4));
#pragma unroll 2
                for (int st = 0; st < 8; ++st) { f32x4 acc = (f32x4){0.f, 0.f, 0.f, 0.f};
#pragma unroll
                    for (int ks = 0; ks < 4; ++ks) { const bf16x8 bfr = *(const LAS bf16x8*)(BS + (16 * st + fr) * 256 + (((4 * ks + fq) ^ fr) << 4)); acc = __builtin_amdgcn_mfma_f32_16x16x32_bf16(bfr, cf[ks], acc, 0, 0, 0); }
                    u32x2 o; o.x = cvt_pk_bf16(acc[0], acc[1]); o.y = cvt_pk_bf16(acc[2], acc[3]);
                    *(LAS u32x2*)(GS + (16 * w + fr) * 256 + (((2 * st + (fq >> 1)) ^ fr) << 4) + (fq & 1) * 8) = o; }
            }
            __syncthreads();
            if (!(MODE & 8)) SCAN_DMA(BS, btp, T);
            if (need_y && !(MODE & 1)) {
                bf16x8 hf[2][4];
#pragma unroll
                for (int pt = 0; pt < 2; ++pt)
#pragma unroll
                    for (int q = 0; q < 4; ++q) { const f32x4 lo4 = hT[2 * q][pt], hi4 = hT[2 * q + 1][pt]; u32x4 o; o.x = cvt_pk_bf16(lo4[0], lo4[1]); o.y = cvt_pk_bf16(lo4[2], lo4[3]); o.z = cvt_pk_bf16(hi4[0], hi4[1]); o.w = cvt_pk_bf16(hi4[2], hi4[3]);
                        hf[pt][q] = __builtin_bit_cast(bf16x8, o); }
#pragma unroll 8
                for (int lt = 0; lt < 8; ++lt) {
                    const int l = 16 * lt + fr; const float cl = tab[l];
                    f32x4 accd[2], acco[2];
                    accd[0] = accd[1] = acco[0] = acco[1] = (f32x4){0.f, 0.f, 0.f, 0.f};
                    const int kd = lt >> 1;
                    const bf16x8 xa = *(const bf16x8*)(xl + 32 * kd), xb = *(const bf16x8*)(xl + (size_t)16 * T + 32 * kd);
#pragma unroll
                    for (int ks = 0; ks < 4; ++ks) {
                        const bool full = dir == 0 ? (ks < kd) : (ks > kd);
                        if (full) {
                            const bf16x8 gf = *(const LAS bf16x8*)(GS + l * 256 + (((4 * ks + fq) ^ fr) << 4));
                            const float f1 = __builtin_amdgcn_exp2f(cl - tab[dir == 0 ? 32 * ks + 31 : 32 * ks]);
                            const f32x4 z4 = (f32x4){0.f, 0.f, 0.f, 0.f};
                            const f32x4 t0 = __builtin_amdgcn_mfma_f32_16x16x32_bf16(xs2[0][ks], gf, z4, 0, 0, 0), t1 = __builtin_amdgcn_mfma_f32_16x16x32_bf16(xs2[1][ks], gf, z4, 0, 0, 0);
                            accd[0] += t0 * f1; accd[1] += t1 * f1;
                        }
                    }
#pragma unroll
                    for (int q = 0; q < 4; ++q) {
                        const u32x2 lo = *(const LAS u32x2*)(CS + l * 256 + (((4 * q + (fq >> 1)) ^ fr) << 4) + (fq & 1) * 8), hi = *(const LAS u32x2*)(CS + l * 256 + (((4 * q + 2 + (fq >> 1)) ^ fr) << 4) + (fq & 1) * 8);
                        u32x4 c4; c4.x = lo.x; c4.y = lo.y; c4.z = hi.x; c4.w = hi.y; const bf16x8 cfr = __builtin_bit_cast(bf16x8, c4);
                        acco[0] = __builtin_amdgcn_mfma_f32_16x16x32_bf16(hf[0][q], cfr, acco[0], 0, 0, 0);
                        acco[1] = __builtin_amdgcn_mfma_f32_16x16x32_bf16(hf[1][q], cfr, acco[1], 0, 0, 0);
                    }
                    {
                        float gg[8]; unpack8(*(const LAS u32x4*)(GS + l * 256 + (((4 * kd + fq) ^ fr) << 4)), gg);
                        const f32x4 ca = *(const LAS f32x4*)(tab + 32 * kd + 8 * fq), cb = *(const LAS f32x4*)(tab + 32 * kd + 8 * fq + 4);
                        const f32x4 da = *(const LAS f32x4*)(tab + 128 + 32 * kd + 8 * fq), db = *(const LAS f32x4*)(tab + 128 + 32 * kd + 8 * fq + 4);
                        const float cs[8] = {ca.x, ca.y, ca.z, ca.w, cb.x, cb.y, cb.z, cb.w}, ds[8] = {da.x, da.y, da.z, da.w, db.x, db.y, db.z, db.w};
                        float m[8];
#pragma unroll
                        for (int jj = 0; jj < 8; ++jj) { const int s = 32 * kd + 8 * fq + jj; const bool valid = dir == 0 ? (s <= l) : (s >= l);
                            const float e = valid ? __builtin_amdgcn_exp2f(cl - cs[jj]) : 0.f; m[jj] = gg[jj] * e * ds[jj]; if (dir == 0 && s == l) m[jj] += dsk; }
                        const bf16x8 mf = __builtin_bit_cast(bf16x8, pack8(m));
                        accd[0] = __builtin_amdgcn_mfma_f32_16x16x32_bf16(xa, mf, accd[0], 0, 0, 0);
                        accd[1] = __builtin_amdgcn_mfma_f32_16x16x32_bf16(xb, mf, accd[1], 0, 0, 0);
                    }
                    const float el = __builtin_amdgcn_exp2f(cl);
#pragma unroll
                    for (int pt = 0; pt < 2; ++pt) { const f32x4 y = accd[pt] + acco[pt] * el; u32x2 o; o.x = cvt_pk_bf16(y[0], y[1]); o.y = cvt_pk_bf16(y[2], y[3]);
                        *(u32x2*)(yout + (size_t)(row0 + l) * DI + h * 64 + ph * 32 + 16 * pt + 4 * fq) = o; }
                }
            }
            VM_WAIT(); __syncthreads();
            if (k + 1 < 18) {
                const int kn = k + 1; const bool isctxn = kn < 2; const int ccn = isctxn ? (dir == 0 ? kn : 1 - kn) : (dir == 0 ? kn - 2 : 17 - kn);
                const int row0n = isctxn ? MLAT + b * LCTX + ccn * 128 : b * LSEQ + ccn * 128;
                if ((ctx_out || !isctxn) && !(MODE & 8)) { SCAN_DMA(CS, cm + (size_t)row0n * GNW + g * 128, GNW); SCAN_DMA(GS, bm + (size_t)row0n * GNW + g * 128, GNW); }
                dtr0 = dtb[(size_t)(row0n + lane) * 128 + dir * 64 + h]; dtr1 = dtb[(size_t)(row0n + 64 + lane) * 128 + dir * 64 + h];

            }
            if (!(MODE & 4)) {
                const float dec = exp2f(tot);
#pragma unroll
                for (int nt = 0; nt < 8; ++nt) { hT[nt][0] *= dec; hT[nt][1] *= dec; }
                bf16x8 xw[2][4];
#pragma unroll
                for (int ks = 0; ks < 4; ++ks) { const float sck = __builtin_amdgcn_exp2f(tot - tab[dir == 0 ? 32 * ks + 31 : 32 * ks]);
#pragma unroll
                    for (int pt = 0; pt < 2; ++pt) { float xv[8]; unpack8(__builtin_bit_cast(u32x4, xs2[pt][ks]), xv);
#pragma unroll
                        for (int e = 0; e < 8; ++e) xv[e] *= sck;
                        xw[pt][ks] = __builtin_bit_cast(bf16x8, pack8(xv)); } }
                {
                    const int kn = k + 1 < 18 ? k + 1 : 17; const bool isctxn = kn < 2; const int ccn = isctxn ? (dir == 0 ? kn : 1 - kn) : (dir == 0 ? kn - 2 : 17 - kn); const int Tn = isctxn ? LCTX : LSEQ;
                    const bf16_t* xln = (isctxn ? xst + (size_t)NB * DI * LSEQ + ((size_t)(b * DI + h * 64 + ph * 32)) * LCTX + ccn * 128 : xst + ((size_t)(b * DI + h * 64 + ph * 32)) * LSEQ + ccn * 128) + (size_t)fr * Tn + 8 * fq;
#pragma unroll
                    for (int pt = 0; pt < 2; ++pt)
#pragma unroll
                        for (int ks = 0; ks < 4; ++ks) xf[pt][ks] = *(const bf16x8*)(xln + (size_t)(16 * pt) * Tn + 32 * ks); }
#pragma unroll
                for (int nt = 0; nt < 8; ++nt) {
#pragma unroll
                    for (int ks = 0; ks < 4; ++ks) { const bf16x8 bfr = *(const LAS bf16x8*)(BS + (16 * nt + fr) * 256 + (((4 * ks + fq) ^ fr) << 4));
                        hT[nt][0] = __builtin_amdgcn_mfma_f32_16x16x32_bf16(bfr, xw[0][ks], hT[nt][0], 0, 0, 0);
                        hT[nt][1] = __builtin_amdgcn_mfma_f32_16x16x32_bf16(bfr, xw[1][ks], hT[nt][1], 0, 0, 0); }
                    if (nt & 1) __builtin_amdgcn_sched_barrier(0);
                }
            }
        }
        __syncthreads();
    }
#undef SCAN_DMA
}

constexpr int N_PHASES = 43;
__host__ __device__ constexpr bool phase_exists(int p) {
    if (p < 2 || p == 42) return true;
    const int L = (p - 2) / 10, s = (p - 2) % 10;
    if (L & 1) return true;
    return s != 5;
}
__global__ void __launch_bounds__(NWAVES * 64, 2) trunk_fwd(Args args) {
    extern __shared__ __attribute__((aligned(16))) unsigned char lds_raw[];
    Frame F;
    F.lds = (LAS unsigned char*)lds_raw;
    F.tid = threadIdx.x; F.lane = F.tid & 63; F.wave = __builtin_amdgcn_readfirstlane(F.tid >> 6); F.G = gridDim.x;
    F.in = args.in; F.out = args.out; F.ws = args.ws;
    volatile LAS unsigned* MISC = (volatile LAS unsigned*)(F.lds + MISC_OFF);
    for (int u = F.tid; u < (LDS_BYTES - LDSCTL_OFF) / 4; u += NWAVES * 64) ((LAS unsigned*)(F.lds + LDSCTL_OFF))[u] = 0u;
    __syncthreads();
    const int lo = args.ph_lo, hi = args.ph_hi;
    XcdBarrier bar; bar.bar = (unsigned*)(F.ws + WS_CTL) + CW_BAR; bar.x = 0; bar.st = nullptr;
    if (hi - lo > 1) bar = xcd_barrier_post((unsigned*)(F.ws + WS_CTL) + CW_BAR, MISC + 8);
#ifndef ONLY_PHASE
#define ONLY_PHASE -1
#endif
#ifndef SKIP_PHASE
#define SKIP_PHASE -2
#endif
#ifndef REP_PHASE
#define REP_PHASE -3
#endif
#define PHON(id) ((id) != SKIP_PHASE && (ONLY_PHASE < 0 || ONLY_PHASE == (id)))
#define IN(k) (lo <= (k) && (k) < hi)
#define SEAM(k) do { if ((k) + 1 < hi) xcd_barrier(bar, F.wave == 0 && fresh_lane() == 0); } while (0)
    LAS unsigned char* ring = F.lds;

#define REPS(id) ((REP_PHASE == (id)) ? 2 : 1)
#define PHASE(id, k, ...) do { if (PHON(id) && IN(k)) { for (int rep_ = 0; rep_ < REPS(id); ++rep_) { __VA_ARGS__; if (rep_ + 1 < REPS(id)) xcd_barrier(bar, F.wave == 0 && fresh_lane() == 0); } SEAM(k); } } while (0)
    PHASE(0, 0, p0_prologue(F));
    PHASE(1, 1, p0b_modreduce(F));

    for (int L = 0; L < DEPTH; ++L) {
        const int pb = 2 + 10 * L; const bool ssd = (L & 1) != 0, last = (L == DEPTH - 1); const int j = L >> 1;
        if (hi <= pb || lo >= pb + 10) continue;
        const int nrows_ffn = last ? MLAT : MALL;
        PHASE(2, pb + 0, norm_mod_phase(F, L, F.in[I_NMIX] + (size_t)L * D, 0, MALL, L > 0 ? (const float*)(F.ws + WS_MOD) + (size_t)(L - 1) * 9 * MODW + 2 * D : nullptr, L > 0 ? (const float*)(F.ws + WS_MOD) + (size_t)(L - 1) * 9 * MODW + 5 * D : nullptr, L <= 1 ? F.in[I_X] : nullptr, L == 0 ? F.in[I_CTX] : nullptr));
        if (!ssd) {
            PHASE(3, pb + 1, { fresh_ids(F); SchedF1 S{F.ws}; pg8::EpiTile E; pg8::gemm_phase<pg8::EpiTile, SchedF1, false>(ring, F.wave, 256, D, 256, S, E); });
            PHASE(15, pb + 2, fft8_phase(F));
            PHASE(4, pb + 3, { fresh_ids(F); SchedF2 S{F.ws}; pg8::EpiTile E; pg8::gemm_phase<pg8::EpiTile, SchedF2, false>(ring, F.wave, 512, 512, 512, S, E);
                               tail_convert(F, 576, F.in[I_WDN] + (size_t)(L + 1) * DFF * D, (bf16_t*)(F.ws + WS_WDN) + (size_t)(L + 1) * D * DFF, DFF, D, 0, nullptr, nullptr, 64, 0); });
            PHASE(5, pb + 4, { fresh_ids(F); SchedAB<D, WS_Y> S{F.ws, WS_F, WS_WFOUR + (size_t)j * D * D * 2, 1};
                               pg8::EpiTile E; pg8::gemm_phase<pg8::EpiTile, SchedAB<D, WS_Y>, false>(ring, F.wave, D, D, D, S, E); });
        } else {
            PHASE(6, pb + 1, { fresh_ids(F); SchedIn S{F.ws, WS_WIN + (size_t)j * INP * D * 2, last ? 1 : 0}; pg8::EpiTile E; pg8::gemm_phase<pg8::EpiTile, SchedIn, false>(ring, F.wave, D, D, D, S, E);
                               if (!last) tail_convert(F, 64 * 41 + 8 * 41, F.in[I_WUP] + (size_t)L * D * 2 * DFF, (bf16_t*)(F.ws + WS_WUP) + (size_t)L * 2 * DFF * D, D, 2 * DFF, 0, nullptr, nullptr, 64, 0); });
            PHASE(7, pb + 2, ssd_conv_phase(F, j, last));
#ifndef SCAN_PROBE
#define SCAN_PROBE 0
#endif
            PHASE(8, pb + 3, { if (REPS(8) == 2 && rep_ == 0) ssd_scan_phase<SCAN_PROBE>(F, j, !last); else ssd_scan_phase<0>(F, j, !last); });
            PHASE(9, pb + 4, ssd_gate_norm_phase(F, j, last ? MLAT : MALL));
            PHASE(10, pb + 5, { fresh_ids(F); SchedAB<DI, WS_Y> S{F.ws, WS_XBCP, WS_WOUT + (size_t)j * D * DI * 2, last ? 0 : 1};
                                pg8::EpiTile E; pg8::gemm_phase<pg8::EpiTile, SchedAB<DI, WS_Y>, false>(ring, F.wave, DI, DI, DI, S, E); });
        }
        PHASE(2, pb + 6, norm_mod_phase(F, L, F.in[I_NFFN] + (size_t)L * D, 3, nrows_ffn, (const float*)(F.ws + WS_MOD) + (size_t)L * 9 * MODW + 2 * D, nullptr, L == 0 ? F.in[I_X] : nullptr, L == 0 ? F.in[I_CTX] : nullptr));
        PHASE(11, pb + 7, { fresh_ids(F); SchedUp S{F.ws, WS_WUP + (size_t)L * 2 * DFF * D * 2, nrows_ffn / 256}; pg8::EpiTile E; pg8::gemm_phase<pg8::EpiTile, SchedUp, false>(ring, F.wave, D, D, D, S, E);
                            if (L + 1 < DEPTH) { const int jn = (L + 1) >> 1;
                                if ((L + 1) & 1) tail_convert(F, (nrows_ffn / 256) * 44, F.in[I_WIN] + (size_t)jn * D * INW, (bf16_t*)(F.ws + WS_WIN) + (size_t)jn * INP * D, D, INW, 1,
                                                              F.in[I_WOUT] + (size_t)jn * DI * D, (bf16_t*)(F.ws + WS_WOUT) + (size_t)jn * D * DI, DI, D);
                                else tail_convert(F, (nrows_ffn / 256) * 44, F.in[I_FOURW] + (size_t)jn * D * D, (bf16_t*)(F.ws + WS_WFOUR) + (size_t)jn * D * D, D, D, 0,
                                                  F.in[I_WUP] + (size_t)(L + 1) * D * 2 * DFF, (bf16_t*)(F.ws + WS_WUP) + (size_t)(L + 1) * 2 * DFF * D, D, 2 * DFF); } });
        PHASE(12, pb + 8, ffn_conv_phase(F, L, nrows_ffn, REPS(12) == 2 && rep_ == 0));
        PHASE(13, pb + 9, { fresh_ids(F); SchedAB<DFF, WS_Y2> S{F.ws, WS_VAL, WS_WDN + (size_t)L * D * DFF * 2, last ? 0 : 1};
                            pg8::EpiTile E; pg8::gemm_phase<pg8::EpiTile, SchedAB<DFF, WS_Y2>, false>(ring, F.wave, DFF, DFF, DFF, S, E); });
    }
    PHASE(14, 42, final_norm_phase(F));
#undef PHASE
#undef REPS
#undef IN
#undef PHON
#undef SEAM
}

extern "C" void kernel_launch(void* const* d_in, const int* in_sizes, int n_in, void* d_out, int out_size, void* d_ws, size_t ws_size, hipStream_t stream) {
    static int grid = 0;
    if (grid == 0) {
        if (n_in != 22 || out_size != MLAT * D || ws_size < WS_END) { fprintf(stderr, "kernel_launch: unexpected problem (n_in %d, out %d, ws %zu < %zu)\n", n_in, out_size, ws_size, (size_t)WS_END); grid = -1; return; }
        int dev = 0, cus = 0, per_cu = 0;
        if (hipGetDevice(&dev) != hipSuccess || hipDeviceGetAttribute(&cus, hipDeviceAttributeMultiprocessorCount, dev) != hipSuccess) { grid = -1; return; }
        if (hipFuncSetAttribute((const void*)trunk_fwd, hipFuncAttributeMaxDynamicSharedMemorySize, LDS_BYTES) != hipSuccess) { fprintf(stderr, "kernel_launch: hipFuncSetAttribute failed\n"); grid = -1; return; }
        if (hipOccupancyMaxActiveBlocksPerMultiprocessor(&per_cu, (const void*)trunk_fwd, NWAVES * 64, LDS_BYTES) != hipSuccess || per_cu < 1) fprintf(stderr, "kernel_launch: occupancy query says %d\n", per_cu);
        (void)hipGetLastError();
        grid = cus;
    }
    if (grid < 0) return;
    (void)hipMemsetAsync((char*)d_ws + WS_CTL, 0, CTL_ZERO_BYTES, stream);
    Args a{};
    for (int i = 0; i < 22; ++i) a.in[i] = (const float*)d_in[i];
    a.out = (float*)d_out; a.ws = (unsigned char*)d_ws;
#if MK_N_LAUNCHES == 1
    a.ph_lo = 0; a.ph_hi = N_PHASES;
    hipLaunchKernelGGL(trunk_fwd, dim3(grid), dim3(NWAVES * 64), LDS_BYTES, stream, a);
#else
    for (int p = 0; p < N_PHASES; ++p) { if (!phase_exists(p)) continue; a.ph_lo = p; a.ph_hi = p + 1;
        hipLaunchKernelGGL(trunk_fwd, dim3(grid), dim3(NWAVES * 64), LDS_BYTES, stream, a); }
#endif
}
```
